# Optimizing an MI355X kernel written in HIP

```python
import jax, jax.numpy as jnp
from jax import lax
import numpy as np

D_MODEL = 1024
BATCH = 4
SEQ = 8192
DEPTH = 2

HEAD_DIM = 64
Q_BLOCK = 128
ROPE_THETA = 10000.0
NORM_EPS = 1e-6
NEG_INF = -1e30
N_BRANCHES = 4

FOX_HEADS = 4
FOX_W = FOX_HEADS * HEAD_DIM
FOX_BIAS_CENTER = 3.0
LRU_WIDTH = 256
LRU_BLOCKS = 4
LRU_BW = LRU_WIDTH // LRU_BLOCKS
LRU_CONV = 4
LRU_C = 8.0
DIL_PAIRS = ((128, 1), (512, 4), (2048, 16))
DIL_GROUPS = len(DIL_PAIRS)
DIL_HEADS_PER_GROUP = 2
DIL_HEADS = DIL_GROUPS * DIL_HEADS_PER_GROUP
DIL_W = DIL_HEADS * HEAD_DIM
DIL_OUT_W = DIL_HEADS_PER_GROUP * HEAD_DIM
DIL_KEYS = DIL_PAIRS[0][0] // DIL_PAIRS[0][1] + 1
NSA_HEADS = 4
NSA_KV_HEADS = 1
NSA_W = NSA_HEADS * HEAD_DIM
NSA_KV_W = NSA_KV_HEADS * HEAD_DIM
NSA_CMP_BLOCK = 32
NSA_CMP_STRIDE = 16
NSA_CMP_HIDDEN = 256
NSA_SLC_BLOCK = 64
NSA_TOP_N = 16
NSA_WINDOW = 512
NSA_FORCE_SCORE = 1e6
PEER_HEADS = 8
PEER_N_KEYS = 128
PEER_N_EXPERTS = PEER_N_KEYS * PEER_N_KEYS
PEER_TOPK = 16
PEER_D_KEY = 256
PEER_BLOCK = 128

IN_SPLITS = (FOX_W, FOX_W, FOX_W, FOX_HEADS,
             LRU_WIDTH, LRU_WIDTH,
             DIL_W, DIL_W, DIL_W,
             NSA_W, NSA_KV_W, NSA_KV_W, NSA_KV_W, NSA_KV_W, NSA_KV_W, NSA_KV_W, NSA_HEADS * 3,
             N_BRANCHES * D_MODEL)
IN_WIDTH = sum(IN_SPLITS)

kernel_name = "hybrid_fox_lru_dilated_nsa_peer"


def rms_norm(x, g):
    xf = x.astype(jnp.float32)
    y = xf * lax.rsqrt(jnp.mean(xf * xf, axis=-1, keepdims=True) + NORM_EPS)
    return (y * g.astype(jnp.float32)).astype(x.dtype)


def rope(x, pos):
    half = x.shape[-1] // 2
    freqs = ROPE_THETA ** (-jnp.arange(half, dtype=jnp.float32) / half)
    ang = pos.astype(jnp.float32)[:, None] * freqs[None, :]
    cos = jnp.cos(ang)[None, :, None, :]
    sin = jnp.sin(ang)[None, :, None, :]
    xf = x.astype(jnp.float32)
    x1, x2 = xf[..., :half], xf[..., half:]
    return jnp.concatenate([x1 * cos - x2 * sin, x2 * cos + x1 * sin], axis=-1).astype(x.dtype)


def _unblock(y):
    y = jnp.moveaxis(y, 0, 1)
    return y.reshape((y.shape[0], y.shape[1] * y.shape[2]) + y.shape[3:])


def masked_softmax(logits, mask):
    logits = jnp.where(mask, logits, NEG_INF)
    m = jnp.max(logits, axis=-1, keepdims=True)
    e = jnp.where(mask, jnp.exp(logits - m), 0.0)
    return e / jnp.maximum(jnp.sum(e, axis=-1, keepdims=True), 1e-30)


def fox_attention(q, k, v, f_logit, b_f):
    B, S, H, dh = q.shape
    log_f = jax.nn.log_sigmoid(f_logit.astype(jnp.float32) + b_f.astype(jnp.float32))
    cum = jnp.transpose(jnp.cumsum(log_f, axis=1), (0, 2, 1))
    scale = dh ** -0.5
    k_pos = jnp.arange(S)

    def block(i):
        s0 = i * Q_BLOCK
        qb = lax.dynamic_slice_in_dim(q, s0, Q_BLOCK, axis=1)
        cq = lax.dynamic_slice_in_dim(cum, s0, Q_BLOCK, axis=2)
        logits = jnp.einsum('bqhd,bkhd->bhqk', qb, k).astype(jnp.float32) * scale
        logits = logits + cq[..., None] - cum[:, :, None, :]
        q_pos = s0 + jnp.arange(Q_BLOCK)
        logits = jnp.where(k_pos[None, :] <= q_pos[:, None], logits, NEG_INF)
        p = jax.nn.softmax(logits, axis=-1)
        return jnp.einsum('bhqk,bkhd->bqhd', p.astype(v.dtype), v)

    return _unblock(lax.map(block, jnp.arange(S // Q_BLOCK)))


def rg_lru_branch(x_in, gate, conv_w, conv_b, w_a, b_a, w_x, b_x, lam):
    B, S, C = x_in.shape
    xc = lax.conv_general_dilated(x_in, conv_w[:, None, :], window_strides=(1,),
                                  padding=[(LRU_CONV - 1, 0)],
                                  dimension_numbers=('NWC', 'WIO', 'NWC'),
                                  feature_group_count=C) + conv_b
    xr = xc.reshape(B, S, LRU_BLOCKS, C // LRU_BLOCKS)
    r = jax.nn.sigmoid(jnp.einsum('bsnc,ncd->bsnd', xr, w_a).reshape(B, S, C) + b_a)
    i_g = jax.nn.sigmoid(jnp.einsum('bsnc,ncd->bsnd', xr, w_x).reshape(B, S, C) + b_x)
    log_a = -LRU_C * r.astype(jnp.float32) * jax.nn.softplus(-lam.astype(jnp.float32))
    a = jnp.exp(log_a)
    u = jnp.sqrt(-jnp.expm1(2.0 * log_a)) * (i_g * xc).astype(jnp.float32)

    def combine(left, right):
        a_l, b_l = left
        a_r, b_r = right
        return a_l * a_r, a_r * b_l + b_r

    _, h = lax.associative_scan(combine, (a, u), axis=1)
    return h.astype(x_in.dtype) * jax.nn.gelu(gate)


def dilated_attention(q, k, v):
    B, S, H, dh = q.shape
    G, Hg = DIL_GROUPS, DIL_HEADS_PER_GROUP
    qg = q.reshape(B, S, G, Hg, dh)
    kg = k.reshape(B, S, G, Hg, dh)
    vg = v.reshape(B, S, G, Hg, dh)
    dil = jnp.array([d for _, d in DIL_PAIRS], dtype=jnp.int32)
    steps = jnp.arange(DIL_KEYS)
    g_idx = jnp.arange(G)[:, None, None]
    scale = dh ** -0.5

    def block(i):
        s0 = i * Q_BLOCK
        q_pos = s0 + jnp.arange(Q_BLOCK)
        k_pos = q_pos[None, :, None] - dil[:, None, None] * steps[None, None, :]
        valid = k_pos >= 0
        k_idx = jnp.maximum(k_pos, 0)
        kb = kg[:, k_idx, g_idx]
        vb = vg[:, k_idx, g_idx]
        qb = lax.dynamic_slice_in_dim(qg, s0, Q_BLOCK, axis=1)
        logits = jnp.einsum('bqghd,bgqkhd->bgqhk', qb, kb).astype(jnp.float32) * scale
        logits = jnp.where(valid[None, :, :, None, :], logits, NEG_INF)
        m = jnp.max(logits, axis=-1, keepdims=True)
        e = jnp.exp(logits - m)
        l = jnp.sum(e, axis=-1)
        o = jnp.einsum('bgqhk,bgqkhd->bgqhd', e, vb.astype(jnp.float32)) / l[..., None]
        lse = m[..., 0] + jnp.log(l)
        w = jax.nn.softmax(lse, axis=1)
        return jnp.einsum('bgqh,bgqhd->bqhd', w, o).astype(v.dtype)

    return _unblock(lax.map(block, jnp.arange(S // Q_BLOCK)))


def nsa_attention(q, k_cmp, v_cmp, k_slc, v_slc, k_win, v_win, gate_logits,
                  pe_k, pe_v, w1_k, w2_k, w1_v, w2_v):
    B, S, H, dh = q.shape
    Hkv = k_cmp.shape[2]
    G = H // Hkv
    pos = jnp.arange(S)
    q_rot = rope(q, pos)
    k_slc = rope(k_slc, pos)
    k_win = rope(k_win, pos)
    gates = jax.nn.sigmoid(gate_logits).reshape(B, S, H, 3)
    scale = dh ** -0.5

    n_cmp = (S - NSA_CMP_BLOCK) // NSA_CMP_STRIDE + 1
    cmp_idx = jnp.arange(n_cmp)[:, None] * NSA_CMP_STRIDE + jnp.arange(NSA_CMP_BLOCK)[None, :]

    def compress(kv, pe, w1, w2):
        blocks = kv[:, cmp_idx] + pe[None, None, :, None, :]
        flat = jnp.moveaxis(blocks, 3, 2).reshape(B, n_cmp, Hkv, NSA_CMP_BLOCK * dh)
        return jax.nn.gelu(flat @ w1) @ w2

    kc = compress(k_cmp, pe_k, w1_k, w2_k)
    vc = compress(v_cmp, pe_v, w1_v, w2_v)
    cmp_start = jnp.arange(n_cmp) * NSA_CMP_STRIDE
    cmp_end = cmp_start + NSA_CMP_BLOCK - 1

    n_slc = S // NSA_SLC_BLOCK
    top_n = min(NSA_TOP_N, n_slc)
    slc_start = jnp.arange(n_slc) * NSA_SLC_BLOCK
    overlap = ((cmp_start[:, None] < slc_start[None, :] + NSA_SLC_BLOCK)
               & (cmp_start[:, None] + NSA_CMP_BLOCK > slc_start[None, :])).astype(jnp.float32)
    ks_blocks = jnp.transpose(k_slc.reshape(B, n_slc, NSA_SLC_BLOCK, Hkv, dh), (0, 3, 1, 2, 4))
    vs_blocks = jnp.transpose(v_slc.reshape(B, n_slc, NSA_SLC_BLOCK, Hkv, dh), (0, 3, 1, 2, 4))
    pad = ((0, 0), (NSA_WINDOW, 0), (0, 0), (0, 0))
    k_win_pad = jnp.pad(k_win, pad)
    v_win_pad = jnp.pad(v_win, pad)
    b_idx = jnp.arange(B)[:, None, None, None]
    h_idx = jnp.arange(Hkv)[None, :, None, None]
    blk_ids = jnp.arange(n_slc)

    def block(i):
        s0 = i * Q_BLOCK
        q_pos = s0 + jnp.arange(Q_BLOCK)
        qb = lax.dynamic_slice_in_dim(q, s0, Q_BLOCK, axis=1).reshape(B, Q_BLOCK, Hkv, G, dh)
        qrb = lax.dynamic_slice_in_dim(q_rot, s0, Q_BLOCK, axis=1).reshape(B, Q_BLOCK, Hkv, G, dh)
        lc = jnp.einsum('bqkgd,bckd->bkgqc', qb, kc).astype(jnp.float32) * scale
        p_c = masked_softmax(lc, (cmp_end[None, :] <= q_pos[:, None])[None, None, None])
        o_c = jnp.einsum('bkgqc,bckd->bqkgd', p_c, vc.astype(jnp.float32))
        imp = jnp.einsum('bkgqc,cn->bkqn', p_c, overlap)
        cur = q_pos // NSA_SLC_BLOCK
        forced = ((blk_ids[None, :] == 0) | (blk_ids[None, :] == cur[:, None])
                  | (blk_ids[None, :] == cur[:, None] - 1))
        imp = jnp.where(forced, NSA_FORCE_SCORE, imp)
        imp = jnp.where(blk_ids[None, :] <= cur[:, None], imp, NEG_INF)
        top_val, top_idx = lax.top_k(imp, top_n)
        sel_ok = top_val > 0.5 * NEG_INF
        ksel = ks_blocks[b_idx, h_idx, top_idx]
        vsel = vs_blocks[b_idx, h_idx, top_idx]
        sel_pos = top_idx[..., None] * NSA_SLC_BLOCK + jnp.arange(NSA_SLC_BLOCK)
        sel_mask = sel_ok[..., None] & (sel_pos <= q_pos[None, None, :, None, None])
        n_sel_keys = top_n * NSA_SLC_BLOCK
        ls = jnp.einsum('bqkgd,bkqnld->bkgqnl', qrb, ksel).astype(jnp.float32) * scale
        ls = ls.reshape(B, Hkv, G, Q_BLOCK, n_sel_keys)
        p_s = masked_softmax(ls, sel_mask.reshape(B, Hkv, 1, Q_BLOCK, n_sel_keys))
        o_s = jnp.einsum('bkgqm,bkqmd->bqkgd', p_s,
                         vsel.reshape(B, Hkv, Q_BLOCK, n_sel_keys, dh).astype(jnp.float32))
        kw = lax.dynamic_slice_in_dim(k_win_pad, s0, NSA_WINDOW + Q_BLOCK, axis=1)
        vw = lax.dynamic_slice_in_dim(v_win_pad, s0, NSA_WINDOW + Q_BLOCK, axis=1)
        w_pos = s0 - NSA_WINDOW + jnp.arange(NSA_WINDOW + Q_BLOCK)
        dist = q_pos[:, None] - w_pos[None, :]
        w_mask = (dist >= 0) & (dist < NSA_WINDOW) & (w_pos[None, :] >= 0)
        lw = jnp.einsum('bqkgd,bwkd->bkgqw', qrb, kw).astype(jnp.float32) * scale
        p_w = masked_softmax(lw, w_mask)
        o_w = jnp.einsum('bkgqw,bwkd->bqkgd', p_w, vw.astype(jnp.float32))
        gb = lax.dynamic_slice_in_dim(gates, s0, Q_BLOCK, axis=1).reshape(B, Q_BLOCK, Hkv, G, 3)
        gb = gb.astype(jnp.float32)
        out = gb[..., 0:1] * o_c + gb[..., 1:2] * o_s + gb[..., 2:3] * o_w
        return out.reshape(B, Q_BLOCK, H, dh).astype(q.dtype)

    return _unblock(lax.map(block, jnp.arange(S // Q_BLOCK)))


def peer_ffn(x, w_q, sub_keys, u, v):
    B, S, D = x.shape
    xt = x.reshape(B * S // PEER_BLOCK, PEER_BLOCK, D)
    k = PEER_TOPK

    def block(xb):
        q = (xb @ w_q).reshape(PEER_BLOCK, PEER_HEADS, 2, PEER_D_KEY // 2)
        s = jnp.einsum('thpd,pnd->thpn', q, sub_keys).astype(jnp.float32)
        v_half, i_half = lax.top_k(s, k)
        cand = v_half[:, :, 0, :, None] + v_half[:, :, 1, None, :]
        cand_idx = i_half[:, :, 0, :, None] * PEER_N_KEYS + i_half[:, :, 1, None, :]
        top_s, pos = lax.top_k(cand.reshape(PEER_BLOCK, PEER_HEADS, k * k), k)
        expert = jnp.take_along_axis(cand_idx.reshape(PEER_BLOCK, PEER_HEADS, k * k), pos, axis=-1)
        g = jax.nn.softmax(top_s, axis=-1)
        act = jax.nn.gelu(jnp.einsum('td,thkd->thk', xb, u[expert]))
        return jnp.einsum('thk,thkd->td', (g * act.astype(jnp.float32)).astype(x.dtype), v[expert])

    return lax.map(block, xt).reshape(B, S, D)


def setup_inputs(seed: int = 0) -> dict:
    key = jax.random.key(seed)
    keys = iter(jax.random.split(key, 40))
    L, D = DEPTH, D_MODEL
    f32 = jnp.float32

    def nrm(shape, scale):
        return jax.random.normal(next(keys), shape, f32) * scale

    a_c = jax.random.uniform(next(keys), (L, LRU_WIDTH), f32, 0.9, 0.999)
    a0 = a_c ** (1.0 / LRU_C)
    flat_cmp = NSA_CMP_BLOCK * HEAD_DIM
    return {
        "x": nrm((BATCH, SEQ, D), 1.0),
        "norm1_g": 1.0 + nrm((L, D), 0.02),
        "w_in": nrm((L, D, IN_WIDTH), D ** -0.5),
        "fox_b_f": FOX_BIAS_CENTER + nrm((L, FOX_HEADS), 0.5),
        "lru_conv_w": nrm((L, LRU_CONV, LRU_WIDTH), LRU_CONV ** -0.5),
        "lru_conv_b": nrm((L, LRU_WIDTH), 0.01),
        "lru_w_a": nrm((L, LRU_BLOCKS, LRU_BW, LRU_BW), LRU_BW ** -0.5),
        "lru_b_a": nrm((L, LRU_WIDTH), 0.01),
        "lru_w_x": nrm((L, LRU_BLOCKS, LRU_BW, LRU_BW), LRU_BW ** -0.5),
        "lru_b_x": nrm((L, LRU_WIDTH), 0.01),
        "lru_lambda": jnp.log(a0) - jnp.log1p(-a0),
        "nsa_pe_k": nrm((L, NSA_CMP_BLOCK, HEAD_DIM), 0.02),
        "nsa_pe_v": nrm((L, NSA_CMP_BLOCK, HEAD_DIM), 0.02),
        "nsa_w1_k": nrm((L, flat_cmp, NSA_CMP_HIDDEN), flat_cmp ** -0.5),
        "nsa_w2_k": nrm((L, NSA_CMP_HIDDEN, HEAD_DIM), NSA_CMP_HIDDEN ** -0.5),
        "nsa_w1_v": nrm((L, flat_cmp, NSA_CMP_HIDDEN), flat_cmp ** -0.5),
        "nsa_w2_v": nrm((L, NSA_CMP_HIDDEN, HEAD_DIM), NSA_CMP_HIDDEN ** -0.5),
        "w_br_fox": nrm((L, FOX_W, D), FOX_W ** -0.5),
        "w_br_lru": nrm((L, LRU_WIDTH, D), LRU_WIDTH ** -0.5),
        "w_br_dil": nrm((L, DIL_OUT_W, D), DIL_OUT_W ** -0.5),
        "w_br_nsa": nrm((L, NSA_W, D), NSA_W ** -0.5),
        "w_out": nrm((L, D, D), D ** -0.5),
        "norm2_g": 1.0 + nrm((L, D), 0.02),
        "peer_w_q": nrm((L, D, PEER_HEADS * PEER_D_KEY), D ** -0.5),
        "peer_sub_keys": nrm((L, 2, PEER_N_KEYS, PEER_D_KEY // 2), (PEER_D_KEY // 2) ** -0.5),
        "peer_u": nrm((L, PEER_N_EXPERTS, D), D ** -0.5),
        "peer_v": nrm((L, PEER_N_EXPERTS, D), PEER_HEADS ** -0.5),
        "final_g": 1.0 + nrm((D,), 0.02),
    }


def reference(x, norm1_g, w_in, fox_b_f, lru_conv_w, lru_conv_b, lru_w_a, lru_b_a,
              lru_w_x, lru_b_x, lru_lambda, nsa_pe_k, nsa_pe_v, nsa_w1_k, nsa_w2_k,
              nsa_w1_v, nsa_w2_v, w_br_fox, w_br_lru, w_br_dil, w_br_nsa, w_out,
              norm2_g, peer_w_q, peer_sub_keys, peer_u, peer_v, final_g):
    B, S, D = x.shape
    pos = jnp.arange(S)
    split_points = np.cumsum(IN_SPLITS)[:-1].tolist()

    def heads(t, n):
        return t.reshape(B, S, n, HEAD_DIM)

    for l in range(DEPTH):
        h = rms_norm(x, norm1_g[l])
        proj = h @ w_in[l]
        (fq, fk, fv, ff, lx, lg, dq, dk, dv, nq, nkc, nvc, nks, nvs, nkw, nvw, ng, mg) = \
            jnp.split(proj, split_points, axis=-1)

        o_fox = fox_attention(heads(fq, FOX_HEADS), heads(fk, FOX_HEADS), heads(fv, FOX_HEADS),
                              ff, fox_b_f[l]).reshape(B, S, FOX_W)
        o_lru = rg_lru_branch(lx, lg, lru_conv_w[l], lru_conv_b[l], lru_w_a[l], lru_b_a[l],
                              lru_w_x[l], lru_b_x[l], lru_lambda[l])
        o_dil = dilated_attention(rope(heads(dq, DIL_HEADS), pos), rope(heads(dk, DIL_HEADS), pos),
                                  heads(dv, DIL_HEADS)).reshape(B, S, DIL_OUT_W)
        o_nsa = nsa_attention(heads(nq, NSA_HEADS), heads(nkc, NSA_KV_HEADS), heads(nvc, NSA_KV_HEADS),
                              heads(nks, NSA_KV_HEADS), heads(nvs, NSA_KV_HEADS),
                              heads(nkw, NSA_KV_HEADS), heads(nvw, NSA_KV_HEADS), ng,
                              nsa_pe_k[l], nsa_pe_v[l], nsa_w1_k[l], nsa_w2_k[l],
                              nsa_w1_v[l], nsa_w2_v[l]).reshape(B, S, NSA_W)

        gates = jax.nn.sigmoid(mg).reshape(B, S, N_BRANCHES, D)
        merged = (gates[:, :, 0] * (o_fox @ w_br_fox[l])
                  + gates[:, :, 1] * (o_lru @ w_br_lru[l])
                  + gates[:, :, 2] * (o_dil @ w_br_dil[l])
                  + gates[:, :, 3] * (o_nsa @ w_br_nsa[l]))
        x = x + merged @ w_out[l]

        h2 = rms_norm(x, norm2_g[l])
        x = x + peer_ffn(h2, peer_w_q[l], peer_sub_keys[l], peer_u[l], peer_v[l])

    return rms_norm(x, final_g)
```

```cpp
#include <hip/hip_runtime.h>
#include <cstdio>
#include <cstdint>

typedef unsigned short u16;
typedef short s16x8 __attribute__((ext_vector_type(8)));
typedef short s16x4 __attribute__((ext_vector_type(4)));
typedef float f32x4 __attribute__((ext_vector_type(4)));
typedef float f32x2 __attribute__((ext_vector_type(2)));
typedef unsigned u32x4 __attribute__((ext_vector_type(4)));
typedef unsigned u32x2 __attribute__((ext_vector_type(2)));
typedef __bf16 bf16x2_t __attribute__((ext_vector_type(2)));
#define LAS __attribute__((address_space(3)))
#define DEVI __device__ __forceinline__

constexpr int NB = 4, SEQ = 8192, DM = 1024, NTOK = NB * SEQ, NLAYER = 2;
constexpr int PW = 3072;
constexpr int C_FQ = 0, C_FK = 256, C_FV = 512, C_LX = 768, C_LG = 1024, C_DQ = 1280, C_DK = 1664, C_DV = 2048,
              C_NQ = 2432, C_NKC = 2688, C_NVC = 2752, C_NKS = 2816, C_NVS = 2880, C_NKW = 2944, C_NVW = 3008;
constexpr int WIN_ROWS = 7296;
constexpr int WIN_GATE0 = 3200;
constexpr int IN_WIDTH = 7184;
constexpr int OW = 896;
constexpr int O_FOX = 0, O_LRU = 256, O_DIL = 512, O_NSA = 640;
constexpr int NEXP = 16384;

constexpr size_t SZ_WIN = (size_t)NLAYER * WIN_ROWS * 1024 * 2;
constexpr size_t SZ_WQ = (size_t)NLAYER * 2048 * 1024 * 2;
constexpr size_t SZ_WOUT = (size_t)NLAYER * 1024 * 1024 * 2;
constexpr size_t SZ_WBR = (size_t)NLAYER * 1024 * OW * 2;
constexpr size_t SZ_W1 = (size_t)NLAYER * 2 * 256 * 2048 * 2;
constexpr size_t SZ_W2 = (size_t)NLAYER * 2 * 64 * 256 * 2;
constexpr size_t SZ_B1 = (size_t)NLAYER * 2 * 256 * 4;
constexpr size_t SZ_SUBK = (size_t)NLAYER * 2 * 128 * 128 * 2;
constexpr size_t SZ_ROPE = (size_t)SEQ * 32 * 8;
constexpr size_t SZ_PUV = (size_t)2 * NEXP * 1024 * 2;
constexpr size_t SZ_H = (size_t)NTOK * 1024 * 2;
constexpr size_t SZ_P = (size_t)NTOK * PW * 2;
constexpr size_t SZ_FS = (size_t)NTOK * 16 * 4;
constexpr size_t SZ_NQR = (size_t)NTOK * 256 * 2;
constexpr size_t SZ_CUM = (size_t)NTOK * 4 * 4;
constexpr size_t SZ_LSUM = (size_t)2 * 512 * 256 * 4;
constexpr size_t SZ_HID = (size_t)2 * 2048 * 256 * 2;
constexpr size_t SZ_KVC = (size_t)2 * NB * 512 * 64 * 2;
constexpr size_t SZ_O = (size_t)NTOK * OW * 2;
constexpr size_t SZ_OC = (size_t)NTOK * 256 * 2;
constexpr size_t SZ_SEL = (size_t)NTOK * 4 * 4;

constexpr size_t OFF_WIN = 0;
constexpr size_t OFF_WQ = OFF_WIN + SZ_WIN;
constexpr size_t OFF_WOUT = OFF_WQ + SZ_WQ;
constexpr size_t OFF_WBR = OFF_WOUT + SZ_WOUT;
constexpr size_t OFF_W1 = OFF_WBR + SZ_WBR;
constexpr size_t OFF_W2 = OFF_W1 + SZ_W1;
constexpr size_t OFF_B1 = OFF_W2 + SZ_W2;
constexpr size_t OFF_SUBK = OFF_B1 + SZ_B1;
constexpr size_t OFF_ROPE = OFF_SUBK + SZ_SUBK;
constexpr size_t OFF_PUV = OFF_ROPE + SZ_ROPE;
constexpr size_t OFF_H = OFF_PUV + SZ_PUV;
constexpr size_t OFF_P = OFF_H + SZ_H;
constexpr size_t OFF_FS = OFF_P + SZ_P;
constexpr size_t OFF_NQR = OFF_FS + SZ_FS;
constexpr size_t OFF_CUM = OFF_NQR + SZ_NQR;
constexpr size_t OFF_LSUM = OFF_CUM + SZ_CUM;
constexpr size_t OFF_HID = OFF_LSUM + SZ_LSUM;
constexpr size_t OFF_KVC = OFF_HID + SZ_HID;
constexpr size_t OFF_O = OFF_KVC + SZ_KVC;
constexpr size_t OFF_OC = OFF_O + SZ_O;
constexpr size_t OFF_SEL = OFF_OC + SZ_OC;
constexpr size_t WS_NEED = OFF_SEL + SZ_SEL;
static_assert(WS_NEED <= (size_t)512 * 1024 * 1024, "workspace over 512 MiB");
constexpr size_t OFF_MERGED = OFF_P;
constexpr size_t OFF_QP = OFF_P + (size_t)NTOK * 1024 * 2;
static_assert(OFF_QP + (size_t)NTOK * 2048 * 2 <= OFF_P + SZ_P, "alias");
constexpr size_t OFF_PIDX = OFF_H;
constexpr size_t OFF_PGW = OFF_H + (size_t)NTOK * 128 * 4;
static_assert(OFF_PGW + (size_t)NTOK * 128 * 4 <= OFF_H + SZ_H, "alias");

struct Params {
    const float* x; const float* norm1_g; const float* w_in; const float* fox_b_f;
    const float* lru_conv_w; const float* lru_conv_b; const float* lru_w_a; const float* lru_b_a;
    const float* lru_w_x; const float* lru_b_x; const float* lru_lambda;
    const float* nsa_pe_k; const float* nsa_pe_v; const float* nsa_w1_k; const float* nsa_w2_k;
    const float* nsa_w1_v; const float* nsa_w2_v;
    const float* w_br_fox; const float* w_br_lru; const float* w_br_dil; const float* w_br_nsa;
    const float* w_out; const float* norm2_g; const float* peer_w_q; const float* peer_sub_keys;
    const float* peer_u; const float* peer_v; const float* final_g;
    float* out; char* ws;
};

DEVI unsigned pk2(float a, float b) { f32x2 v = {a, b}; bf16x2_t r = __builtin_convertvector(v, bf16x2_t); return __builtin_bit_cast(unsigned, r); }
DEVI u16 f2bf(float a) { return (u16)(pk2(a, 0.f) & 0xffffu); }
DEVI float bf2f(u16 h) { return __uint_as_float(((unsigned)h) << 16); }
DEVI float bflo(unsigned w) { return __uint_as_float(w << 16); }
DEVI float bfhi(unsigned w) { return __uint_as_float(w & 0xffff0000u); }
DEVI float sigmoidf_(float x) { return 1.f / (1.f + __expf(-x)); }
DEVI float gelu_tanh(float x) { float u = 0.7978845608028654f * (x + 0.044715f * x * x * x); return x / (1.f + __expf(-2.f * u)); }
DEVI f32x4 mfma16(s16x8 a, s16x8 b, f32x4 c) { return __builtin_amdgcn_mfma_f32_16x16x32_bf16(a, b, c, 0, 0, 0); }
DEVI float wave_sum(float v) {
#pragma unroll
    for (int o = 32; o > 0; o >>= 1) v += __shfl_xor(v, o);
    return v;
}
DEVI unsigned wave_max_u32(unsigned v) {
#pragma unroll
    for (int o = 32; o > 0; o >>= 1) { unsigned t = (unsigned)__shfl_xor((int)v, o); v = v > t ? v : t; }
    return v;
}

template <int BM, int BN>
DEVI void gemm_mainloop(const u16* __restrict__ A, size_t lda, size_t a_kstride, const u16* __restrict__ Bt, size_t ldb, int K,
                        int m0, int n0, char* smem, f32x4 (&acc)[BM / 32][BN / 32]) {
    constexpr int MT = BM / 32, NT = BN / 32, ACH = BM * 8 / 256, BCH = BN * 8 / 256;
    constexpr int A_BYTES = BM * 128, STAGE = (BM + BN) * 128;
    const int tid = threadIdx.x, lane = tid & 63, w = tid >> 6, wm = w >> 1, wn = w & 1, g = lane >> 4, c = lane & 15;
    u32x4 ra[ACH], rb[BCH];
    const int nk = K / 64;
#pragma unroll
    for (int i = 0; i < ACH; ++i) { int ch = tid + 256 * i, row = ch >> 3, cc = ch & 7; ra[i] = *(const u32x4*)(A + (size_t)(m0 + row) * lda + cc * 8); }
#pragma unroll
    for (int i = 0; i < BCH; ++i) { int ch = tid + 256 * i, row = ch >> 3, cc = ch & 7; rb[i] = *(const u32x4*)(Bt + (size_t)(n0 + row) * ldb + cc * 8); }
#pragma unroll
    for (int i = 0; i < ACH; ++i) { int ch = tid + 256 * i, row = ch >> 3, cc = ch & 7; *(u32x4*)(smem + row * 128 + ((cc ^ (row & 7)) << 4)) = ra[i]; }
#pragma unroll
    for (int i = 0; i < BCH; ++i) { int ch = tid + 256 * i, row = ch >> 3, cc = ch & 7; *(u32x4*)(smem + A_BYTES + row * 128 + ((cc ^ (row & 7)) << 4)) = rb[i]; }
    __syncthreads();
    for (int kt = 0; kt < nk; ++kt) {
        const bool more = kt + 1 < nk;
        if (more) {
#pragma unroll
            for (int i = 0; i < ACH; ++i) { int ch = tid + 256 * i, row = ch >> 3, cc = ch & 7; ra[i] = *(const u32x4*)(A + (size_t)(m0 + row) * lda + (size_t)(kt + 1) * a_kstride + cc * 8); }
#pragma unroll
            for (int i = 0; i < BCH; ++i) { int ch = tid + 256 * i, row = ch >> 3, cc = ch & 7; rb[i] = *(const u32x4*)(Bt + (size_t)(n0 + row) * ldb + (size_t)(kt + 1) * 64 + cc * 8); }
        }
        const char* sA = smem + (kt & 1) * STAGE; const char* sB = sA + A_BYTES;
#pragma unroll
        for (int ks = 0; ks < 2; ++ks) {
            s16x8 af[MT], bfr[NT];
#pragma unroll
            for (int mt = 0; mt < MT; ++mt) { int row = wm * (BM / 2) + 16 * mt + c; af[mt] = *(const s16x8*)(sA + row * 128 + (((4 * ks + g) ^ (row & 7)) << 4)); }
#pragma unroll
            for (int nt = 0; nt < NT; ++nt) { int row = wn * (BN / 2) + 16 * nt + c; bfr[nt] = *(const s16x8*)(sB + row * 128 + (((4 * ks + g) ^ (row & 7)) << 4)); }
#pragma unroll
            for (int mt = 0; mt < MT; ++mt)
#pragma unroll
                for (int nt = 0; nt < NT; ++nt) acc[mt][nt] = mfma16(bfr[nt], af[mt], acc[mt][nt]);
        }
        if (more) {
            char* dA = smem + ((kt + 1) & 1) * STAGE; char* dB = dA + A_BYTES;
#pragma unroll
            for (int i = 0; i < ACH; ++i) { int ch = tid + 256 * i, row = ch >> 3, cc = ch & 7; *(u32x4*)(dA + row * 128 + ((cc ^ (row & 7)) << 4)) = ra[i]; }
#pragma unroll
            for (int i = 0; i < BCH; ++i) { int ch = tid + 256 * i, row = ch >> 3, cc = ch & 7; *(u32x4*)(dB + row * 128 + ((cc ^ (row & 7)) << 4)) = rb[i]; }
        }
        __syncthreads();
    }
}
template <int MT, int NT> DEVI void acc_zero(f32x4 (&acc)[MT][NT]) {
#pragma unroll
    for (int i = 0; i < MT; ++i)
#pragma unroll
        for (int j = 0; j < NT; ++j) acc[i][j] = (f32x4){0.f, 0.f, 0.f, 0.f};
}
constexpr int GEMM_LDS_128 = 2 * (128 + 128) * 128;

DEVI int win_map(int n) {
    if (n < 768) return n;
    if (n < 3072) return n + 4;
    if (n < 3076) return 768 + (n - 3072);
    if (n < 3088) return n;
    if (n < WIN_GATE0) return -1;
    return n - (WIN_GATE0 - 3088);
}
__global__ void __launch_bounds__(256) k_tconv(const float* __restrict__ src, int src_ld, int K, u16* __restrict__ dst, int dst_ld, int ndst, int mode) {
    __shared__ float tile[64][65];
    const int tiles_n = ndst / 64;
    const int kt = blockIdx.x / tiles_n, nt = blockIdx.x % tiles_n;
    const int tx = threadIdx.x & 63, ty = threadIdx.x >> 6;
    const int n = nt * 64 + tx;
    const int sc = mode == 1 ? win_map(n) : n;
#pragma unroll
    for (int i = 0; i < 16; ++i) { int k = kt * 64 + ty * 16 + i; tile[ty * 16 + i][tx] = sc >= 0 ? src[(size_t)k * src_ld + sc] : 0.f; }
    __syncthreads();
#pragma unroll
    for (int i = 0; i < 16; ++i) { int nn = ty * 16 + i; dst[(size_t)(nt * 64 + nn) * dst_ld + kt * 64 + tx] = f2bf(tile[tx][nn]); }
}
__global__ void __launch_bounds__(256) k_cvt(const float* __restrict__ src, u16* __restrict__ dst, size_t n4) {
    for (size_t i = (size_t)blockIdx.x * 256 + threadIdx.x; i < n4; i += (size_t)gridDim.x * 256) {
        f32x4 v = *(const f32x4*)(src + i * 4);
        u32x2 o = {pk2(v[0], v[1]), pk2(v[2], v[3])};
        *(u32x2*)(dst + i * 4) = o;
    }
}
__global__ void __launch_bounds__(256) k_misc(Params p) {
    const int gid = blockIdx.x * 256 + threadIdx.x;
    if (gid < SEQ * 32) {
        const int s = gid >> 5, i = gid & 31;
        const float freq = powf(10000.0f, -(float)i / 32.0f);
        const float ang = (float)s * freq;
        const double rev = (double)ang * 0.15915494309189535;
        const float fr = (float)(rev - floor(rev));
        f32x2 cs = {__builtin_amdgcn_cosf(fr), __builtin_amdgcn_sinf(fr)};
        *(f32x2*)(p.ws + OFF_ROPE + (size_t)gid * 8) = cs;
    }
    if (gid < NLAYER * 2 * 256) {
        const int n = gid & 255, z = (gid >> 8) & 1, l = gid >> 9;
        const float* pe = (z ? p.nsa_pe_v : p.nsa_pe_k) + (size_t)l * 2048;
        const float* w1 = (z ? p.nsa_w1_v : p.nsa_w1_k) + (size_t)l * 2048 * 256;
        float a = 0.f;
        for (int k = 0; k < 2048; ++k) a += pe[k] * w1[(size_t)k * 256 + n];
        ((float*)(p.ws + OFF_B1))[gid] = a;
    }
}

template <bool FINAL>
__global__ void __launch_bounds__(256) k_rmsnorm(const float* __restrict__ x, const float* __restrict__ gam, u16* __restrict__ hout, float* __restrict__ fout) {
    const int lane = threadIdx.x & 63;
    for (int row = blockIdx.x * 4 + (threadIdx.x >> 6); row < NTOK; row += gridDim.x * 4) {
        const float* xr = x + (size_t)row * DM;
        f32x4 v[4]; float ss = 0.f;
#pragma unroll
        for (int i = 0; i < 4; ++i) { v[i] = *(const f32x4*)(xr + i * 256 + lane * 4); ss += v[i][0] * v[i][0] + v[i][1] * v[i][1] + v[i][2] * v[i][2] + v[i][3] * v[i][3]; }
        ss = wave_sum(ss);
        const float rs = rsqrtf(ss * (1.0f / DM) + 1e-6f);
#pragma unroll
        for (int i = 0; i < 4; ++i) {
            f32x4 gg = *(const f32x4*)(gam + i * 256 + lane * 4);
            f32x4 y = {v[i][0] * rs * gg[0], v[i][1] * rs * gg[1], v[i][2] * rs * gg[2], v[i][3] * rs * gg[3]};
            if (FINAL) *(f32x4*)(fout + (size_t)row * DM + i * 256 + lane * 4) = y;
            else { u32x2 o = {pk2(y[0], y[1]), pk2(y[2], y[3])}; *(u32x2*)(hout + (size_t)row * DM + i * 256 + lane * 4) = o; }
        }
    }
}

__global__ void __launch_bounds__(256) k_proj(Params p, int layer) {
    extern __shared__ __attribute__((aligned(16))) char smem[];
    const u16* H = (const u16*)(p.ws + OFF_H);
    const u16* Wt = (const u16*)(p.ws + OFF_WIN) + (size_t)layer * WIN_ROWS * 1024;
    u16* P = (u16*)(p.ws + OFF_P); float* FS = (float*)(p.ws + OFF_FS);
    const int ntn = 25, ntiles = (NTOK / 128) * ntn;
    const int lane = threadIdx.x & 63, w = threadIdx.x >> 6, wm = w >> 1, wn = w & 1, g = lane >> 4, c = lane & 15;
    for (int t = blockIdx.x; t < ntiles; t += gridDim.x) {
        const int tm = t / ntn, tn = t % ntn, m0 = tm * 128, n0 = tn * 128;
        f32x4 acc[4][4]; acc_zero(acc);
        gemm_mainloop<128, 128>(H, 1024, 64, Wt, 1024, 1024, m0, n0, smem, acc);
#pragma unroll
        for (int mt = 0; mt < 4; ++mt)
#pragma unroll
            for (int nt = 0; nt < 4; ++nt) {
                const int m = m0 + wm * 64 + 16 * mt + c, n = n0 + wn * 64 + 16 * nt + 4 * g;
                if (n < PW) { u32x2 o = {pk2(acc[mt][nt][0], acc[mt][nt][1]), pk2(acc[mt][nt][2], acc[mt][nt][3])}; *(u32x2*)(P + (size_t)m * PW + n) = o; }
                else if (n < PW + 16) *(f32x4*)(FS + (size_t)m * 16 + (n - PW)) = acc[mt][nt];
            }
    }
}

__global__ void __launch_bounds__(256) k_rope(Params p) {
    u16* P = (u16*)(p.ws + OFF_P); u16* NQR = (u16*)(p.ws + OFF_NQR);
    const f32x2* tab = (const f32x2*)(p.ws + OFF_ROPE);
    const int lane = threadIdx.x & 63, i = lane & 31, half = lane >> 5;
    for (int tok = blockIdx.x * 4 + (threadIdx.x >> 6); tok < NTOK; tok += gridDim.x * 4) {
        const int s = tok & (SEQ - 1);
        const f32x2 cs = tab[s * 32 + i];
        u16* row = P + (size_t)tok * PW;
#pragma unroll
        for (int j = 0; j < 9; ++j) {
            const int hd = 2 * j + half;
            int col;
            if (hd < 6) col = C_DQ + hd * 64; else if (hd < 12) col = C_DK + (hd - 6) * 64; else if (hd < 16) col = C_NQ + (hd - 12) * 64; else if (hd == 16) col = C_NKS; else col = C_NKW;
            const float x1 = bf2f(row[col + i]), x2 = bf2f(row[col + 32 + i]);
            const float y1 = x1 * cs[0] - x2 * cs[1], y2 = x2 * cs[0] + x1 * cs[1];
            if (hd >= 12 && hd < 16) { u16* d = NQR + (size_t)tok * 256 + (hd - 12) * 64; d[i] = f2bf(y1); d[32 + i] = f2bf(y2); }
            else { row[col + i] = f2bf(y1); row[col + 32 + i] = f2bf(y2); }
        }
    }
}

__global__ void __launch_bounds__(256) k_foxcum(Params p, int layer) {
    __shared__ float part[256];
    const int b = blockIdx.x >> 2, h = blockIdx.x & 3, tid = threadIdx.x;
    const float* FS = (const float*)(p.ws + OFF_FS); float* CUM = (float*)(p.ws + OFF_CUM);
    const float bf = p.fox_b_f[layer * 4 + h];
    float v[32]; float run = 0.f;
#pragma unroll
    for (int i = 0; i < 32; ++i) {
        const float z = FS[(size_t)(b * SEQ + tid * 32 + i) * 16 + h] + bf;
        const float ls = fminf(z, 0.f) - log1pf(__expf(-fabsf(z)));
        run += ls; v[i] = run;
    }
    part[tid] = run; __syncthreads();
    if (tid == 0) { float a = 0.f; for (int i = 0; i < 256; ++i) { float t = part[i]; part[i] = a; a += t; } }
    __syncthreads();
    const float base = part[tid];
#pragma unroll
    for (int i = 0; i < 32; ++i) CUM[(size_t)(b * SEQ + tid * 32 + i) * 4 + h] = base + v[i];
}

template <int MODE>
__global__ void __launch_bounds__(256) k_lru(Params p, int layer) {
    __shared__ __attribute__((aligned(16))) float sx[16][256];
    const int ch = threadIdx.x, nb = ch >> 6, d = ch & 63;
    const u16* P = (const u16*)(p.ws + OFF_P);
    float* SA = (float*)(p.ws + OFF_LSUM); float* SH = SA + 512 * 256;
    u16* O = (u16*)(p.ws + OFF_O);
    float wa[64], wx[64];
    const float* WA = p.lru_w_a + (size_t)layer * 4 * 64 * 64 + (size_t)nb * 64 * 64;
    const float* WX = p.lru_w_x + (size_t)layer * 4 * 64 * 64 + (size_t)nb * 64 * 64;
#pragma unroll
    for (int k = 0; k < 64; ++k) { wa[k] = WA[k * 64 + d]; wx[k] = WX[k * 64 + d]; }
    const float cw0 = p.lru_conv_w[(layer * 4 + 0) * 256 + ch], cw1 = p.lru_conv_w[(layer * 4 + 1) * 256 + ch],
                cw2 = p.lru_conv_w[(layer * 4 + 2) * 256 + ch], cw3 = p.lru_conv_w[(layer * 4 + 3) * 256 + ch];
    const float cb = p.lru_conv_b[layer * 256 + ch], ba = p.lru_b_a[layer * 256 + ch], bx = p.lru_b_x[layer * 256 + ch];
    const float lam = p.lru_lambda[layer * 256 + ch];
    const float sp = (lam > 0.f ? 0.f : -lam) + log1pf(__expf(-fabsf(lam)));
    for (int tile = blockIdx.x; tile < 512; tile += gridDim.x) {
        const int b = tile >> 7, k = tile & 127, t0 = b * SEQ + k * 64;
        float hst = 0.f, aprod = 1.f;
        if (MODE == 1) { for (int j = 0; j < k; ++j) { const int tj = (b << 7) + j; hst = SA[tj * 256 + ch] * hst + SH[tj * 256 + ch]; } }
        float x0 = 0.f, x1 = 0.f, x2 = 0.f;
        if (k > 0) { x0 = bf2f(P[(size_t)(t0 - 3) * PW + C_LX + ch]); x1 = bf2f(P[(size_t)(t0 - 2) * PW + C_LX + ch]); x2 = bf2f(P[(size_t)(t0 - 1) * PW + C_LX + ch]); }
        for (int sub = 0; sub < 4; ++sub) {
            float xc[16];
            __syncthreads();
#pragma unroll
            for (int i = 0; i < 16; ++i) {
                const float x3 = bf2f(P[(size_t)(t0 + sub * 16 + i) * PW + C_LX + ch]);
                xc[i] = cw0 * x0 + cw1 * x1 + cw2 * x2 + cw3 * x3 + cb;
                x0 = x1; x1 = x2; x2 = x3;
                sx[i][ch] = xc[i];
            }
            __syncthreads();
#pragma unroll
            for (int i = 0; i < 16; ++i) {
                float aa = ba, ax = bx;
#pragma unroll
                for (int kk = 0; kk < 64; kk += 4) {
                    const f32x4 xv = *(const f32x4*)&sx[i][nb * 64 + kk];
                    aa += xv[0] * wa[kk] + xv[1] * wa[kk + 1] + xv[2] * wa[kk + 2] + xv[3] * wa[kk + 3];
                    ax += xv[0] * wx[kk] + xv[1] * wx[kk + 1] + xv[2] * wx[kk + 2] + xv[3] * wx[kk + 3];
                }
                const float r = sigmoidf_(aa), ig = sigmoidf_(ax);
                const float log_a = -8.0f * r * sp;
                const float a = __expf(log_a);
                const float u = sqrtf(-expm1f(2.f * log_a)) * (ig * xc[i]);
                hst = a * hst + u;
                if (MODE == 0) aprod *= a;
                else {
                    const size_t tok = (size_t)(t0 + sub * 16 + i);
                    const float gate = bf2f(P[tok * PW + C_LG + ch]);
                    O[tok * OW + O_LRU + ch] = f2bf(hst * gelu_tanh(gate));
                }
            }
        }
        if (MODE == 0) { SA[tile * 256 + ch] = aprod; SH[tile * 256 + ch] = hst; }
    }
}

__global__ void __launch_bounds__(256) k_cmp1(Params p, int layer) {
    extern __shared__ __attribute__((aligned(16))) char smem[];
    const u16* P = (const u16*)(p.ws + OFF_P);
    const int lane = threadIdx.x & 63, w = threadIdx.x >> 6, wm = w >> 1, wn = w & 1, g = lane >> 4, c = lane & 15;
    for (int t = blockIdx.x; t < 2 * 16 * 2; t += gridDim.x) {
        const int z = t >> 5, tm = (t >> 1) & 15, tn = t & 1;
        const int b = tm >> 2, i0 = (tm & 3) * 128;
        const u16* A = P + (size_t)(b * SEQ) * PW + (z ? C_NVC : C_NKC);
        const u16* Wt = (const u16*)(p.ws + OFF_W1) + ((size_t)(layer * 2 + z) * 256) * 2048;
        f32x4 acc[4][4]; acc_zero(acc);
        gemm_mainloop<128, 128>(A, (size_t)16 * PW, (size_t)PW, Wt, 2048, 2048, i0, tn * 128, smem, acc);
        const float* b1 = (const float*)(p.ws + OFF_B1) + (layer * 2 + z) * 256;
        u16* HID = (u16*)(p.ws + OFF_HID) + (size_t)z * 2048 * 256;
#pragma unroll
        for (int mt = 0; mt < 4; ++mt)
#pragma unroll
            for (int nt = 0; nt < 4; ++nt) {
                const int m = b * 512 + i0 + wm * 64 + 16 * mt + c, n = tn * 128 + wn * 64 + 16 * nt + 4 * g;
                const f32x4 bb = *(const f32x4*)(b1 + n);
                u32x2 o = {pk2(gelu_tanh(acc[mt][nt][0] + bb[0]), gelu_tanh(acc[mt][nt][1] + bb[1])), pk2(gelu_tanh(acc[mt][nt][2] + bb[2]), gelu_tanh(acc[mt][nt][3] + bb[3]))};
                *(u32x2*)(HID + (size_t)m * 256 + n) = o;
            }
    }
}
__global__ void __launch_bounds__(256) k_cmp2(Params p, int layer) {
    extern __shared__ __attribute__((aligned(16))) char smem[];
    const int lane = threadIdx.x & 63, w = threadIdx.x >> 6, wm = w >> 1, wn = w & 1, g = lane >> 4, c = lane & 15;
    for (int t = blockIdx.x; t < 2 * 16; t += gridDim.x) {
        const int z = t >> 4, tm = t & 15;
        const u16* A = (const u16*)(p.ws + OFF_HID) + (size_t)z * 2048 * 256;
        const u16* Wt = (const u16*)(p.ws + OFF_W2) + ((size_t)(layer * 2 + z) * 64) * 256;
        f32x4 acc[4][2]; acc_zero(acc);
        gemm_mainloop<128, 64>(A, 256, 64, Wt, 256, 256, tm * 128, 0, smem, acc);
        u16* KVC = (u16*)(p.ws + OFF_KVC) + (size_t)z * NB * 512 * 64;
#pragma unroll
        for (int mt = 0; mt < 4; ++mt)
#pragma unroll
            for (int nt = 0; nt < 2; ++nt) {
                const int m = tm * 128 + wm * 64 + 16 * mt + c, n = wn * 32 + 16 * nt + 4 * g;
                u32x2 o = {pk2(acc[mt][nt][0], acc[mt][nt][1]), pk2(acc[mt][nt][2], acc[mt][nt][3])};
                if ((m & 511) == 511) o = (u32x2){0u, 0u};
                *(u32x2*)(KVC + (size_t)m * 64 + n) = o;
            }
    }
}

template <int NQT, class F>
DEVI void attn_tile64(const char* sK, const char* sV, const s16x8 (&qf)[NQT][2], float (&m)[NQT], float (&l)[NQT], f32x4 (&o)[NQT][4], int lane, F&& logit) {
    const int g = lane >> 4, c = lane & 15;
    f32x4 s[NQT][4];
#pragma unroll
    for (int T = 0; T < 4; ++T) {
        const int row = 16 * T + c;
        const s16x8 k0 = *(const s16x8*)(sK + row * 128 + ((g ^ (row & 7)) << 4));
        const s16x8 k1 = *(const s16x8*)(sK + row * 128 + (((4 + g) ^ (row & 7)) << 4));
#pragma unroll
        for (int qt = 0; qt < NQT; ++qt) { f32x4 z = {0.f, 0.f, 0.f, 0.f}; z = mfma16(k0, qf[qt][0], z); z = mfma16(k1, qf[qt][1], z); s[qt][T] = z; }
    }
#pragma unroll
    for (int qt = 0; qt < NQT; ++qt) {
        float mx = -INFINITY;
#pragma unroll
        for (int T = 0; T < 4; ++T) { logit(qt, T, s[qt][T]); mx = fmaxf(mx, fmaxf(fmaxf(s[qt][T][0], s[qt][T][1]), fmaxf(s[qt][T][2], s[qt][T][3]))); }
        mx = fmaxf(mx, __shfl_xor(mx, 16)); mx = fmaxf(mx, __shfl_xor(mx, 32));
        const float mn = fmaxf(m[qt], mx), alpha = __expf(m[qt] - mn);
        m[qt] = mn;
        float ps = 0.f;
#pragma unroll
        for (int T = 0; T < 4; ++T)
#pragma unroll
            for (int r = 0; r < 4; ++r) { const float pv = __expf(s[qt][T][r] - mn); s[qt][T][r] = pv; ps += pv; }
        l[qt] = l[qt] * alpha + ps;
#pragma unroll
        for (int dt = 0; dt < 4; ++dt) o[qt][dt] *= alpha;
    }
#pragma unroll
    for (int u = 0; u < 2; ++u) {
        s16x8 pb[NQT];
#pragma unroll
        for (int qt = 0; qt < NQT; ++qt) {
            u32x4 pk = {pk2(s[qt][2 * u][0], s[qt][2 * u][1]), pk2(s[qt][2 * u][2], s[qt][2 * u][3]), pk2(s[qt][2 * u + 1][0], s[qt][2 * u + 1][1]), pk2(s[qt][2 * u + 1][2], s[qt][2 * u + 1][3])};
            pb[qt] = __builtin_bit_cast(s16x8, pk);
        }
#pragma unroll
        for (int dt = 0; dt < 4; ++dt) {
            const char* a0 = sV + (32 * u + 4 * g + (c >> 2)) * 144 + (16 * dt + 4 * (c & 3)) * 2;
            const s16x4 v0 = __builtin_amdgcn_ds_read_tr16_b64_v4i16((LAS s16x4*)(a0));
            const s16x4 v1 = __builtin_amdgcn_ds_read_tr16_b64_v4i16((LAS s16x4*)(a0 + 16 * 144));
            const s16x8 vf = {v0[0], v0[1], v0[2], v0[3], v1[0], v1[1], v1[2], v1[3]};
#pragma unroll
            for (int qt = 0; qt < NQT; ++qt) o[qt][dt] = mfma16(vf, pb[qt], o[qt][dt]);
        }
    }
}
template <int NQT> DEVI void attn_init(float (&m)[NQT], float (&l)[NQT], f32x4 (&o)[NQT][4]) {
#pragma unroll
    for (int qt = 0; qt < NQT; ++qt) { m[qt] = -1e30f; l[qt] = 0.f;
#pragma unroll
        for (int dt = 0; dt < 4; ++dt) o[qt][dt] = (f32x4){0.f, 0.f, 0.f, 0.f}; }
}
DEVI float attn_ltot(float l) { l += __shfl_xor(l, 16); l += __shfl_xor(l, 32); return l; }
DEVI void stage_kv_block(char* sK, char* sV, const u16* kbase, const u16* vbase, size_t rstride) {
    const int tid = threadIdx.x;
#pragma unroll
    for (int i = 0; i < 2; ++i) {
        const int id = tid + 256 * i, key = id >> 3, cc = id & 7;
        const u32x4 kv = *(const u32x4*)(kbase + (size_t)key * rstride + cc * 8);
        const u32x4 vv = *(const u32x4*)(vbase + (size_t)key * rstride + cc * 8);
        *(u32x4*)(sK + key * 128 + ((cc ^ (key & 7)) << 4)) = kv;
        *(u32x4*)(sV + key * 144 + cc * 16) = vv;
    }
}
constexpr int ATT_SK = 8192, ATT_SV = 64 * 144;

__global__ void __launch_bounds__(256) k_fox(Params p) {
    __shared__ __attribute__((aligned(16))) char smem[ATT_SK + ATT_SV + 256];
    char* sK = smem; char* sV = smem + ATT_SK; float* sC = (float*)(smem + ATT_SK + ATT_SV);
    const u16* P = (const u16*)(p.ws + OFF_P); const float* CUM = (const float*)(p.ws + OFF_CUM); u16* O = (u16*)(p.ws + OFF_O);
    const int tid = threadIdx.x, lane = tid & 63, w = tid >> 6, g = lane >> 4, c = lane & 15;
    for (int item = blockIdx.x; item < NB * 4 * 64; item += gridDim.x) {
        const int qb = 63 - (item >> 4), bh = item & 15, b = bh >> 2, h = bh & 3;
        const int q0 = qb * 128, qw = q0 + 32 * w;
        s16x8 qf[2][2]; float cq[2];
#pragma unroll
        for (int qt = 0; qt < 2; ++qt) {
            const size_t tok = (size_t)b * SEQ + qw + 16 * qt + c;
            qf[qt][0] = *(const s16x8*)(P + tok * PW + C_FQ + h * 64 + 8 * g);
            qf[qt][1] = *(const s16x8*)(P + tok * PW + C_FQ + h * 64 + 32 + 8 * g);
            cq[qt] = CUM[tok * 4 + h];
        }
        float m[2], l[2]; f32x4 o[2][4]; attn_init<2>(m, l, o);
        const int ntile = (q0 + 128) / 64;
        for (int kt = 0; kt < ntile; ++kt) {
            __syncthreads();
            const size_t kt0 = (size_t)b * SEQ + kt * 64;
            stage_kv_block(sK, sV, P + kt0 * PW + C_FK + h * 64, P + kt0 * PW + C_FV + h * 64, PW);
            if (tid < 64) sC[tid] = CUM[(kt0 + tid) * 4 + h];
            __syncthreads();
            if (kt * 64 <= qw + 31) {
                attn_tile64<2>(sK, sV, qf, m, l, o, lane, [&](int qt, int T, f32x4& s) {
                    const f32x4 ck = *(const f32x4*)&sC[16 * T + 4 * g];
                    const int qpos = qw + 16 * qt + c, k0 = kt * 64 + 16 * T + 4 * g;
#pragma unroll
                    for (int r = 0; r < 4; ++r) s[r] = (k0 + r <= qpos) ? s[r] * 0.125f + (cq[qt] - ck[r]) : -INFINITY;
                });
            }
        }
#pragma unroll
        for (int qt = 0; qt < 2; ++qt) {
            const float inv = 1.f / attn_ltot(l[qt]);
            const size_t tok = (size_t)b * SEQ + qw + 16 * qt + c;
#pragma unroll
            for (int dt = 0; dt < 4; ++dt) {
                u32x2 ov = {pk2(o[qt][dt][0] * inv, o[qt][dt][1] * inv), pk2(o[qt][dt][2] * inv, o[qt][dt][3] * inv)};
                *(u32x2*)(O + tok * OW + O_FOX + h * 64 + 16 * dt + 4 * g) = ov;
            }
        }
    }
}

__global__ void __launch_bounds__(256) k_dil(Params p) {
    __shared__ __attribute__((aligned(16))) char smem[4 * (ATT_SK + ATT_SV)];
    const u16* P = (const u16*)(p.ws + OFF_P); u16* O = (u16*)(p.ws + OFF_O);
    const int tid = threadIdx.x, lane = tid & 63, w = tid >> 6, g = lane >> 4, c = lane & 15;
    char* sK = smem + w * (ATT_SK + ATT_SV); char* sV = sK + ATT_SK;
    for (int blk = blockIdx.x; blk < 512; blk += gridDim.x) {
        const int wt = blk * 4 + w, hg = wt & 1, t0r = (wt >> 1) & 15, span = (wt >> 5) & 15, b = wt >> 9;
        const int pbase = 512 * span + t0r;
        float m[2], l[2]; f32x4 o[2][4]; attn_init<2>(m, l, o);
#pragma unroll
        for (int gi = 0; gi < 3; ++gi) {
            const int dl = gi == 0 ? 1 : (gi == 1 ? 4 : 16), sh = gi == 0 ? 0 : (gi == 1 ? 2 : 4);
            const int head = 2 * gi + hg, rr = t0r & (dl - 1);
            s16x8 qf[2][2]; int uq[2];
#pragma unroll
            for (int qt = 0; qt < 2; ++qt) {
                const int pos = pbase + 16 * (16 * qt + c);
                const size_t tok = (size_t)b * SEQ + pos;
                qf[qt][0] = *(const s16x8*)(P + tok * PW + C_DQ + head * 64 + 8 * g);
                qf[qt][1] = *(const s16x8*)(P + tok * PW + C_DQ + head * 64 + 32 + 8 * g);
                uq[qt] = (pos - rr) >> sh;
            }
            int ulo = ((512 * span) >> sh) - 128; if (ulo < 0) ulo = 0;
            const int uhi = (512 * span + 15 + 496) >> sh;
            const int nt = (uhi - ulo) / 64 + 1;
            for (int kt = 0; kt < nt; ++kt) {
                __syncthreads();
#pragma unroll
                for (int i = 0; i < 8; ++i) {
                    const int id = lane + 64 * i, key = id >> 3, cc = id & 7;
                    int pos = rr + ((ulo + kt * 64 + key) << sh); if (pos > SEQ - 1) pos = SEQ - 1;
                    const size_t tok = (size_t)b * SEQ + pos;
                    const u32x4 kv = *(const u32x4*)(P + tok * PW + C_DK + head * 64 + cc * 8);
                    const u32x4 vv = *(const u32x4*)(P + tok * PW + C_DV + head * 64 + cc * 8);
                    *(u32x4*)(sK + key * 128 + ((cc ^ (key & 7)) << 4)) = kv;
                    *(u32x4*)(sV + key * 144 + cc * 16) = vv;
                }
                __syncthreads();
                attn_tile64<2>(sK, sV, qf, m, l, o, lane, [&](int qt, int T, f32x4& s) {
                    const int u0 = ulo + kt * 64 + 16 * T + 4 * g;
#pragma unroll
                    for (int r = 0; r < 4; ++r) { const int u = u0 + r; s[r] = (u <= uq[qt] && u >= uq[qt] - 128) ? s[r] * 0.125f : -INFINITY; }
                });
            }
        }
#pragma unroll
        for (int qt = 0; qt < 2; ++qt) {
            const float inv = 1.f / attn_ltot(l[qt]);
            const size_t tok = (size_t)b * SEQ + pbase + 16 * (16 * qt + c);
#pragma unroll
            for (int dt = 0; dt < 4; ++dt) {
                u32x2 ov = {pk2(o[qt][dt][0] * inv, o[qt][dt][1] * inv), pk2(o[qt][dt][2] * inv, o[qt][dt][3] * inv)};
                *(u32x2*)(O + tok * OW + O_DIL + hg * 64 + 16 * dt + 4 * g) = ov;
            }
        }
    }
}

__global__ void __launch_bounds__(256) k_nsacmp(Params p) {
    __shared__ __attribute__((aligned(16))) char smem[ATT_SK + ATT_SV + 64 * 128 * 4];
    char* sK = smem; char* sV = smem + ATT_SK; float* sImp = (float*)(smem + ATT_SK + ATT_SV);
    const u16* P = (const u16*)(p.ws + OFF_P);
    const u16* KC = (const u16*)(p.ws + OFF_KVC); const u16* VC = KC + (size_t)NB * 512 * 64;
    u16* OC = (u16*)(p.ws + OFF_OC); unsigned* SEL = (unsigned*)(p.ws + OFF_SEL);
    const int tid = threadIdx.x, lane = tid & 63, w = tid >> 6, g = lane >> 4, c = lane & 15;
    for (int blk = blockIdx.x; blk < NTOK / 64; blk += gridDim.x) {
        const int b = blk >> 7, s0 = (blk & 127) * 64;
        const int sq = s0 + 16 * w + c;
        const size_t tok = (size_t)b * SEQ + sq;
        __syncthreads();
        for (int i = tid; i < 64 * 128; i += 256) sImp[i] = 0.f;
        s16x8 qf[4][1][2];
#pragma unroll
        for (int h = 0; h < 4; ++h) { qf[h][0][0] = *(const s16x8*)(P + tok * PW + C_NQ + h * 64 + 8 * g); qf[h][0][1] = *(const s16x8*)(P + tok * PW + C_NQ + h * 64 + 32 + 8 * g); }
        float m[4][1], l[4][1]; f32x4 o[4][1][4];
#pragma unroll
        for (int h = 0; h < 4; ++h) attn_init<1>(m[h], l[h], o[h]);
        const int ntile = ((s0 + 32) / 16) / 64 + 1;
        const int cmax = (sq - 31) >> 4;
        for (int kt = 0; kt < ntile; ++kt) {
            __syncthreads();
            stage_kv_block(sK, sV, KC + ((size_t)b * 512 + kt * 64) * 64, VC + ((size_t)b * 512 + kt * 64) * 64, 64);
            __syncthreads();
#pragma unroll
            for (int h = 0; h < 4; ++h)
                attn_tile64<1>(sK, sV, qf[h], m[h], l[h], o[h], lane, [&](int, int T, f32x4& s) {
                    const int c0 = kt * 64 + 16 * T + 4 * g;
#pragma unroll
                    for (int r = 0; r < 4; ++r) s[r] = (c0 + r <= cmax) ? s[r] * 0.125f : -INFINITY;
                });
        }
        float linv[4];
#pragma unroll
        for (int h = 0; h < 4; ++h) {
            const float lt = attn_ltot(l[h][0]);
            linv[h] = lt > 0.f ? 1.f / lt : 0.f;
#pragma unroll
            for (int dt = 0; dt < 4; ++dt) {
                u32x2 ov = {pk2(o[h][0][dt][0] * linv[h], o[h][0][dt][1] * linv[h]), pk2(o[h][0][dt][2] * linv[h], o[h][0][dt][3] * linv[h])};
                *(u32x2*)(OC + tok * 256 + h * 64 + 16 * dt + 4 * g) = ov;
            }
        }
        float aprev[4] = {0.f, 0.f, 0.f, 0.f};
        for (int kt = 0; kt < ntile; ++kt) {
            __syncthreads();
            stage_kv_block(sK, sV, KC + ((size_t)b * 512 + kt * 64) * 64, VC + ((size_t)b * 512 + kt * 64) * 64, 64);
            __syncthreads();
            float imp[4] = {0.f, 0.f, 0.f, 0.f};
#pragma unroll
            for (int h = 0; h < 4; ++h) {
                float acur = aprev[h];
#pragma unroll
                for (int T = 0; T < 4; ++T) {
                    const int row = 16 * T + c;
                    const s16x8 k0 = *(const s16x8*)(sK + row * 128 + ((g ^ (row & 7)) << 4));
                    const s16x8 k1 = *(const s16x8*)(sK + row * 128 + (((4 + g) ^ (row & 7)) << 4));
                    f32x4 z = {0.f, 0.f, 0.f, 0.f}; z = mfma16(k0, qf[h][0][0], z); z = mfma16(k1, qf[h][0][1], z);
                    const int c0 = kt * 64 + 16 * T + 4 * g;
                    float pr[4];
#pragma unroll
                    for (int r = 0; r < 4; ++r) pr[r] = (c0 + r <= cmax) ? __expf(z[r] * 0.125f - m[h][0]) * linv[h] : 0.f;
                    const float a = __shfl(pr[3], (lane + 48) & 63);
                    const float prev = g > 0 ? a : acur;
                    acur = a;
                    imp[T] += pr[0] + pr[1] + pr[2] + pr[3] + prev;
                }
                aprev[h] = acur;
            }
#pragma unroll
            for (int T = 0; T < 4; ++T) sImp[(16 * w + c) * 128 + 16 * kt + 4 * T + g] = imp[T];
        }
        __syncthreads();
        for (int tl = 0; tl < 16; ++tl) {
            const int sp = s0 + 16 * w + tl, cur = sp >> 6;
            unsigned k0, k1; bool sel0 = false, sel1 = false;
            {
                const int n0 = lane, n1 = lane + 64;
                float v0 = sImp[(16 * w + tl) * 128 + n0], v1 = sImp[(16 * w + tl) * 128 + n1];
                if (n0 == 0 || n0 == cur || n0 == cur - 1) v0 = 1e6f;
                if (n1 == cur || n1 == cur - 1) v1 = 1e6f;
                k0 = n0 <= cur ? (((__float_as_uint(v0) | 0x80000000u) & ~127u) | (unsigned)(127 - n0)) : 0u;
                k1 = n1 <= cur ? (((__float_as_uint(v1) | 0x80000000u) & ~127u) | (unsigned)(127 - n1)) : 0u;
            }
            if (cur < 16) { sel0 = k0 != 0u; sel1 = k1 != 0u; }
            else {
                for (int it = 0; it < 16; ++it) {
                    const unsigned km = wave_max_u32(k0 > k1 ? k0 : k1);
                    if (k0 == km) { sel0 = true; k0 = 0u; } else if (k1 == km) { sel1 = true; k1 = 0u; }
                }
            }
            const unsigned long long b0 = __ballot(sel0), b1 = __ballot(sel1);
            if (lane == 0) { u32x4 mk = {(unsigned)b0, (unsigned)(b0 >> 32), (unsigned)b1, (unsigned)(b1 >> 32)}; *(u32x4*)(SEL + ((size_t)b * SEQ + sp) * 4) = mk; }
        }
    }
}

__global__ void __launch_bounds__(256) k_nsasw(Params p) {
    __shared__ __attribute__((aligned(16))) char smem[ATT_SK + ATT_SV];
    char* sK = smem; char* sV = smem + ATT_SK;
    const u16* P = (const u16*)(p.ws + OFF_P); const u16* NQR = (const u16*)(p.ws + OFF_NQR);
    const u16* OC = (const u16*)(p.ws + OFF_OC); const unsigned* SEL = (const unsigned*)(p.ws + OFF_SEL);
    const float* FS = (const float*)(p.ws + OFF_FS); u16* O = (u16*)(p.ws + OFF_O);
    const int tid = threadIdx.x, lane = tid & 63, h = tid >> 6, g = lane >> 4, c = lane & 15;
    for (int blk = blockIdx.x; blk < NTOK / 32; blk += gridDim.x) {
        const int b = blk >> 8, s0 = (blk & 255) * 32;
        s16x8 qf[2][2]; u32x4 msk[2];
#pragma unroll
        for (int qt = 0; qt < 2; ++qt) {
            const size_t tok = (size_t)b * SEQ + s0 + 16 * qt + c;
            qf[qt][0] = *(const s16x8*)(NQR + tok * 256 + h * 64 + 8 * g);
            qf[qt][1] = *(const s16x8*)(NQR + tok * 256 + h * 64 + 32 + 8 * g);
            msk[qt] = *(const u32x4*)(SEL + tok * 4);
        }
        float m[2], l[2]; f32x4 o[2][4]; attn_init<2>(m, l, o);
        int klo = s0 - 511; if (klo < 0) klo = 0; klo >>= 6;
        const int khi = (s0 + 31) >> 6;
        for (int kt = klo; kt <= khi; ++kt) {
            __syncthreads();
            const size_t kt0 = (size_t)b * SEQ + kt * 64;
            stage_kv_block(sK, sV, P + kt0 * PW + C_NKW, P + kt0 * PW + C_NVW, PW);
            __syncthreads();
            attn_tile64<2>(sK, sV, qf, m, l, o, lane, [&](int qt, int T, f32x4& s) {
                const int qpos = s0 + 16 * qt + c, k0 = kt * 64 + 16 * T + 4 * g;
#pragma unroll
                for (int r = 0; r < 4; ++r) s[r] = (k0 + r <= qpos && k0 + r > qpos - 512) ? s[r] * 0.125f : -INFINITY;
            });
        }
        f32x4 ow[2][4];
#pragma unroll
        for (int qt = 0; qt < 2; ++qt) {
            const float inv = 1.f / attn_ltot(l[qt]);
#pragma unroll
            for (int dt = 0; dt < 4; ++dt) ow[qt][dt] = o[qt][dt] * inv;
        }
        attn_init<2>(m, l, o);
        for (int n = 0; n <= khi; ++n) {
            const unsigned w0 = n < 32 ? msk[0][0] : (n < 64 ? msk[0][1] : (n < 96 ? msk[0][2] : msk[0][3]));
            const unsigned w1 = n < 32 ? msk[1][0] : (n < 64 ? msk[1][1] : (n < 96 ? msk[1][2] : msk[1][3]));
            const bool bit0 = (w0 >> (n & 31)) & 1u, bit1 = (w1 >> (n & 31)) & 1u;
            if (__ballot(bit0 || bit1) == 0ull) continue;
            __syncthreads();
            const size_t kt0 = (size_t)b * SEQ + n * 64;
            stage_kv_block(sK, sV, P + kt0 * PW + C_NKS, P + kt0 * PW + C_NVS, PW);
            __syncthreads();
            attn_tile64<2>(sK, sV, qf, m, l, o, lane, [&](int qt, int T, f32x4& s) {
                const int qpos = s0 + 16 * qt + c, k0 = n * 64 + 16 * T + 4 * g;
                const bool bit = qt == 0 ? bit0 : bit1;
#pragma unroll
                for (int r = 0; r < 4; ++r) s[r] = (bit && k0 + r <= qpos) ? s[r] * 0.125f : -INFINITY;
            });
        }
#pragma unroll
        for (int qt = 0; qt < 2; ++qt) {
            const float lt = attn_ltot(l[qt]); const float inv = lt > 0.f ? 1.f / lt : 0.f;
            const size_t tok = (size_t)b * SEQ + s0 + 16 * qt + c;
            const float g0 = sigmoidf_(FS[tok * 16 + 4 + h * 3 + 0]), g1 = sigmoidf_(FS[tok * 16 + 4 + h * 3 + 1]), g2 = sigmoidf_(FS[tok * 16 + 4 + h * 3 + 2]);
#pragma unroll
            for (int dt = 0; dt < 4; ++dt) {
                const u32x2 oc = *(const u32x2*)(OC + tok * 256 + h * 64 + 16 * dt + 4 * g);
                const float r0 = g0 * bflo(oc[0]) + g1 * o[qt][dt][0] * inv + g2 * ow[qt][dt][0];
                const float r1 = g0 * bfhi(oc[0]) + g1 * o[qt][dt][1] * inv + g2 * ow[qt][dt][1];
                const float r2 = g0 * bflo(oc[1]) + g1 * o[qt][dt][2] * inv + g2 * ow[qt][dt][2];
                const float r3 = g0 * bfhi(oc[1]) + g1 * o[qt][dt][3] * inv + g2 * ow[qt][dt][3];
                u32x2 ov = {pk2(r0, r1), pk2(r2, r3)};
                *(u32x2*)(O + tok * OW + O_NSA + h * 64 + 16 * dt + 4 * g) = ov;
            }
        }
    }
}

__global__ void __launch_bounds__(256) k_merge(Params p, int layer) {
    extern __shared__ __attribute__((aligned(16))) char smem[];
    const u16* H = (const u16*)(p.ws + OFF_H); const u16* O = (const u16*)(p.ws + OFF_O);
    const u16* Wg = (const u16*)(p.ws + OFF_WIN) + ((size_t)layer * WIN_ROWS + WIN_GATE0) * 1024;
    const u16* Wbr = (const u16*)(p.ws + OFF_WBR) + (size_t)layer * 1024 * OW;
    u16* MG = (u16*)(p.ws + OFF_MERGED);
    const int lane = threadIdx.x & 63, w = threadIdx.x >> 6, wm = w >> 1, wn = w & 1, g = lane >> 4, c = lane & 15;
    for (int t = blockIdx.x; t < (NTOK / 128) * 16; t += gridDim.x) {
        const int tm = t >> 4, tn = t & 15, m0 = tm * 128, n0 = tn * 64;
        f32x4 mg[4][2]; acc_zero(mg);
#pragma unroll
        for (int br = 0; br < 4; ++br) {
            const int kb = br == 2 ? 128 : 256, oc = br == 0 ? O_FOX : (br == 1 ? O_LRU : (br == 2 ? O_DIL : O_NSA));
            f32x4 ag[4][2]; acc_zero(ag);
            gemm_mainloop<128, 64>(H, 1024, 64, Wg + (size_t)br * 1024 * 1024, 1024, 1024, m0, n0, smem, ag);
            f32x4 ay[4][2]; acc_zero(ay);
            gemm_mainloop<128, 64>(O + oc, OW, 64, Wbr + oc, OW, kb, m0, n0, smem, ay);
#pragma unroll
            for (int mt = 0; mt < 4; ++mt)
#pragma unroll
                for (int nt = 0; nt < 2; ++nt)
#pragma unroll
                    for (int r = 0; r < 4; ++r) mg[mt][nt][r] += sigmoidf_(ag[mt][nt][r]) * ay[mt][nt][r];
        }
#pragma unroll
        for (int mt = 0; mt < 4; ++mt)
#pragma unroll
            for (int nt = 0; nt < 2; ++nt) {
                const int m = m0 + wm * 64 + 16 * mt + c, n = n0 + wn * 32 + 16 * nt + 4 * g;
                u32x2 ov = {pk2(mg[mt][nt][0], mg[mt][nt][1]), pk2(mg[mt][nt][2], mg[mt][nt][3])};
                *(u32x2*)(MG + (size_t)m * 1024 + n) = ov;
            }
    }
}
__global__ void __launch_bounds__(256) k_wout(Params p, int layer) {
    extern __shared__ __attribute__((aligned(16))) char smem[];
    const u16* MG = (const u16*)(p.ws + OFF_MERGED);
    const u16* Wt = (const u16*)(p.ws + OFF_WOUT) + (size_t)layer * 1024 * 1024;
    const float* xin = layer == 0 ? p.x : p.out;
    const int lane = threadIdx.x & 63, w = threadIdx.x >> 6, wm = w >> 1, wn = w & 1, g = lane >> 4, c = lane & 15;
    for (int t = blockIdx.x; t < (NTOK / 128) * 8; t += gridDim.x) {
        const int tm = t >> 3, tn = t & 7, m0 = tm * 128, n0 = tn * 128;
        f32x4 acc[4][4]; acc_zero(acc);
        gemm_mainloop<128, 128>(MG, 1024, 64, Wt, 1024, 1024, m0, n0, smem, acc);
#pragma unroll
        for (int mt = 0; mt < 4; ++mt)
#pragma unroll
            for (int nt = 0; nt < 4; ++nt) {
                const int m = m0 + wm * 64 + 16 * mt + c, n = n0 + wn * 64 + 16 * nt + 4 * g;
                const f32x4 xv = *(const f32x4*)(xin + (size_t)m * DM + n);
                *(f32x4*)(p.out + (size_t)m * DM + n) = xv + acc[mt][nt];
            }
    }
}
__global__ void __launch_bounds__(256) k_peerq(Params p, int layer) {
    extern __shared__ __attribute__((aligned(16))) char smem[];
    const u16* H = (const u16*)(p.ws + OFF_H);
    const u16* Wt = (const u16*)(p.ws + OFF_WQ) + (size_t)layer * 2048 * 1024;
    u16* QP = (u16*)(p.ws + OFF_QP);
    const int lane = threadIdx.x & 63, w = threadIdx.x >> 6, wm = w >> 1, wn = w & 1, g = lane >> 4, c = lane & 15;
    for (int t = blockIdx.x; t < (NTOK / 128) * 16; t += gridDim.x) {
        const int tm = t >> 4, tn = t & 15, m0 = tm * 128, n0 = tn * 128;
        f32x4 acc[4][4]; acc_zero(acc);
        gemm_mainloop<128, 128>(H, 1024, 64, Wt, 1024, 1024, m0, n0, smem, acc);
#pragma unroll
        for (int mt = 0; mt < 4; ++mt)
#pragma unroll
            for (int nt = 0; nt < 4; ++nt) {
                const int m = m0 + wm * 64 + 16 * mt + c, n = n0 + wn * 64 + 16 * nt + 4 * g;
                u32x2 ov = {pk2(acc[mt][nt][0], acc[mt][nt][1]), pk2(acc[mt][nt][2], acc[mt][nt][3])};
                *(u32x2*)(QP + (size_t)m * 2048 + n) = ov;
            }
    }
}

template <int N> DEVI void bitonic_sort_desc(unsigned (&k)[N]) {
#pragma unroll
    for (int sz = 2; sz <= N; sz <<= 1)
#pragma unroll
        for (int st = sz >> 1; st > 0; st >>= 1)
#pragma unroll
            for (int i = 0; i < N; ++i) {
                const int j = i ^ st;
                if (j > i) {
                    const bool desc = (i & sz) == 0;
                    const unsigned a = k[i], b = k[j], hi = a > b ? a : b, lo = a > b ? b : a;
                    k[i] = desc ? hi : lo; k[j] = desc ? lo : hi;
                }
            }
}
template <int N> DEVI void bitonic_merge_desc(unsigned (&k)[N]) {
#pragma unroll
    for (int st = N >> 1; st > 0; st >>= 1)
#pragma unroll
        for (int i = 0; i < N; ++i) {
            const int j = i ^ st;
            if (j > i) { const unsigned a = k[i], b = k[j]; k[i] = a > b ? a : b; k[j] = a > b ? b : a; }
        }
}
DEVI void merge_top16_xor(unsigned (&k)[16], int x) {
    unsigned t[16];
#pragma unroll
    for (int i = 0; i < 16; ++i) { const unsigned o = (unsigned)__shfl_xor((int)k[15 - i], x); t[i] = k[i] > o ? k[i] : o; }
    bitonic_merge_desc<16>(t);
#pragma unroll
    for (int i = 0; i < 16; ++i) k[i] = t[i];
}
DEVI unsigned f2ord(float f) { unsigned u = __float_as_uint(f); return u ^ ((u >> 31) ? 0xffffffffu : 0x80000000u); }
DEVI float ord2f(unsigned u) { return __uint_as_float(u ^ ((u >> 31) ? 0x80000000u : 0xffffffffu)); }

struct PairTab { unsigned char i[64], j[64]; };
__host__ __device__ constexpr PairTab make_pairs() {
    PairTab t{};
    int n = 0;
    for (int i = 0; i < 16; ++i) for (int j = 0; j < 16; ++j) if ((i + 1) * (j + 1) <= 16) { t.i[n] = (unsigned char)i; t.j[n] = (unsigned char)j; ++n; }
    for (; n < 64; ++n) { t.i[n] = 255; t.j[n] = 255; }
    return t;
}
constexpr PairTab kPairs = make_pairs();

__global__ void __launch_bounds__(256) k_peertop(Params p, int layer) {
    __shared__ unsigned char sIdx[4][16][2][16];
    const u16* QP = (const u16*)(p.ws + OFF_QP);
    const u16* SK = (const u16*)(p.ws + OFF_SUBK) + (size_t)layer * 2 * 128 * 128;
    int* PIDX = (int*)(p.ws + OFF_PIDX); float* PGW = (float*)(p.ws + OFF_PGW);
    const int tid = threadIdx.x, lane = tid & 63, w = tid >> 6, g = lane >> 4, c = lane & 15;
    for (int item = blockIdx.x * 4 + w; item < (NTOK / 16) * 8; item += gridDim.x * 4) {
        const int hd = item & 7, t0 = (item >> 3) * 16;
        const size_t tok = (size_t)t0 + c;
        unsigned top[2][16];
#pragma unroll
        for (int pp = 0; pp < 2; ++pp) {
            s16x8 qf[4];
#pragma unroll
            for (int ks = 0; ks < 4; ++ks) qf[ks] = *(const s16x8*)(QP + tok * 2048 + hd * 256 + pp * 128 + 32 * ks + 8 * g);
            unsigned key[32];
#pragma unroll
            for (int T = 0; T < 8; ++T) {
                f32x4 z = {0.f, 0.f, 0.f, 0.f};
#pragma unroll
                for (int ks = 0; ks < 4; ++ks) {
                    const s16x8 kf = *(const s16x8*)(SK + ((size_t)pp * 128 + 16 * T + c) * 128 + 32 * ks + 8 * g);
                    z = mfma16(kf, qf[ks], z);
                }
#pragma unroll
                for (int r = 0; r < 4; ++r) { const int n = 16 * T + 4 * g + r; key[4 * T + r] = (f2ord(z[r]) & ~127u) | (unsigned)(127 - n); }
            }
            bitonic_sort_desc<32>(key);
#pragma unroll
            for (int i = 0; i < 16; ++i) top[pp][i] = key[i];
            merge_top16_xor(top[pp], 16);
            merge_top16_xor(top[pp], 32);
#pragma unroll
            for (int i = 0; i < 16; ++i) if ((i >> 2) == g) sIdx[w][c][pp][i] = (unsigned char)(127 - (top[pp][i] & 127u));
        }
        float v0[16], v1[16];
#pragma unroll
        for (int i = 0; i < 16; ++i) { v0[i] = ord2f(top[0][i] & ~127u); v1[i] = ord2f(top[1][i] & ~127u); }
        unsigned ck[16];
#pragma unroll
        for (int e = 0; e < 16; ++e) {
            unsigned kk[4];
#pragma unroll
            for (int gg = 0; gg < 4; ++gg) {
                const int pi = kPairs.i[gg * 16 + e], pj = kPairs.j[gg * 16 + e];
                kk[gg] = pi < 16 ? ((f2ord(v0[pi < 16 ? pi : 0] + v1[pj < 16 ? pj : 0]) & ~255u) | (unsigned)(255 - (pi * 16 + pj))) : 0u;
            }
            ck[e] = g == 0 ? kk[0] : (g == 1 ? kk[1] : (g == 2 ? kk[2] : kk[3]));
        }
        bitonic_sort_desc<16>(ck);
        merge_top16_xor(ck, 16);
        merge_top16_xor(ck, 32);
        const float smax = ord2f(ck[0] & ~255u);
        float ex[16], den = 0.f;
#pragma unroll
        for (int i = 0; i < 16; ++i) { ex[i] = __expf(ord2f(ck[i] & ~255u) - smax); den += ex[i]; }
        const float rden = 1.f / den;
        int eidx[4]; float egw[4];
#pragma unroll
        for (int r = 0; r < 4; ++r) {
            const unsigned kq = g == 0 ? ck[r] : (g == 1 ? ck[4 + r] : (g == 2 ? ck[8 + r] : ck[12 + r]));
            const float eq = g == 0 ? ex[r] : (g == 1 ? ex[4 + r] : (g == 2 ? ex[8 + r] : ex[12 + r]));
            const int flat = 255 - (int)(kq & 255u), pi = flat >> 4, pj = flat & 15;
            eidx[r] = (int)sIdx[w][c][0][pi] * 128 + (int)sIdx[w][c][1][pj];
            egw[r] = eq * rden;
        }
        *(int4*)(PIDX + tok * 128 + hd * 16 + 4 * g) = make_int4(eidx[0], eidx[1], eidx[2], eidx[3]);
        *(f32x4*)(PGW + tok * 128 + hd * 16 + 4 * g) = (f32x4){egw[0], egw[1], egw[2], egw[3]};
    }
}

__global__ void __launch_bounds__(256) k_peergather(Params p, const float* __restrict__ g2) {
    __shared__ __attribute__((aligned(16))) u16 sh2[4][1024];
    const u16* PU = (const u16*)(p.ws + OFF_PUV); const u16* PV = PU + (size_t)NEXP * 1024;
    const int* PIDX = (const int*)(p.ws + OFF_PIDX); const float* PGW = (const float*)(p.ws + OFF_PGW);
    const int tid = threadIdx.x, lane = tid & 63, w = tid >> 6, g = lane >> 4, c = lane & 15;
    for (int tok = blockIdx.x * 4 + w; tok < NTOK; tok += gridDim.x * 4) {
        float* xr = p.out + (size_t)tok * DM;
        f32x4 xv[4]; float ss = 0.f;
#pragma unroll
        for (int i = 0; i < 4; ++i) { xv[i] = *(const f32x4*)(xr + i * 256 + lane * 4); ss += xv[i][0] * xv[i][0] + xv[i][1] * xv[i][1] + xv[i][2] * xv[i][2] + xv[i][3] * xv[i][3]; }
        ss = wave_sum(ss);
        const float rs = rsqrtf(ss * (1.0f / DM) + 1e-6f);
#pragma unroll
        for (int i = 0; i < 4; ++i) {
            const f32x4 gg = *(const f32x4*)(g2 + i * 256 + lane * 4);
            u32x2 hv = {pk2(xv[i][0] * rs * gg[0], xv[i][1] * rs * gg[1]), pk2(xv[i][2] * rs * gg[2], xv[i][3] * rs * gg[3])};
            *(u32x2*)(&sh2[w][i * 256 + lane * 4]) = hv;
        }
        float acc[16];
#pragma unroll
        for (int i = 0; i < 16; ++i) acc[i] = 0.f;
        for (int hd = 0; hd < 8; ++hd) {
            const int myidx = PIDX[(size_t)tok * 128 + hd * 16 + c];
            const float mygw = PGW[(size_t)tok * 128 + hd * 16 + c];
            const u16* urow = PU + (size_t)myidx * 1024 + 256 * g;
            f32x4 z = {0.f, 0.f, 0.f, 0.f};
#pragma unroll 8
            for (int s = 0; s < 32; ++s) {
                const s16x8 a = *(const s16x8*)(urow + 8 * s);
                const s16x8 bq = *(const s16x8*)(&sh2[w][256 * g + 8 * s]);
                z = mfma16(a, bq, z);
            }
#pragma unroll
            for (int e = 0; e < 16; ++e) {
                const float ze = __shfl(z[e & 3], 16 * (e >> 2));
                const float wgt = __shfl(mygw, e) * gelu_tanh(ze);
                const int ei = __shfl(myidx, e);
                const u16* vrow = PV + (size_t)ei * 1024;
                const u32x4 va = *(const u32x4*)(vrow + lane * 8);
                const u32x4 vb = *(const u32x4*)(vrow + 512 + lane * 8);
#pragma unroll
                for (int q = 0; q < 4; ++q) { acc[2 * q] += wgt * bflo(va[q]); acc[2 * q + 1] += wgt * bfhi(va[q]); acc[8 + 2 * q] += wgt * bflo(vb[q]); acc[8 + 2 * q + 1] += wgt * bfhi(vb[q]); }
            }
        }
#pragma unroll
        for (int hlf = 0; hlf < 2; ++hlf)
#pragma unroll
            for (int q = 0; q < 2; ++q) {
                float* d = xr + hlf * 512 + lane * 8 + q * 4;
                f32x4 v = *(const f32x4*)d;
                v[0] += acc[hlf * 8 + q * 4 + 0]; v[1] += acc[hlf * 8 + q * 4 + 1]; v[2] += acc[hlf * 8 + q * 4 + 2]; v[3] += acc[hlf * 8 + q * 4 + 3];
                *(f32x4*)d = v;
            }
    }
}

extern "C" void kernel_launch(void* const* d_in, const int* in_sizes, int n_in, void* d_out, int out_size, void* d_ws, size_t ws_size, hipStream_t stream) {
    (void)in_sizes; (void)n_in; (void)out_size;
    if (ws_size < WS_NEED) { fprintf(stderr, "workspace too small: %zu < %zu\n", ws_size, (size_t)WS_NEED); return; }
    Params p{};
    p.x = (const float*)d_in[0]; p.norm1_g = (const float*)d_in[1]; p.w_in = (const float*)d_in[2]; p.fox_b_f = (const float*)d_in[3];
    p.lru_conv_w = (const float*)d_in[4]; p.lru_conv_b = (const float*)d_in[5]; p.lru_w_a = (const float*)d_in[6]; p.lru_b_a = (const float*)d_in[7];
    p.lru_w_x = (const float*)d_in[8]; p.lru_b_x = (const float*)d_in[9]; p.lru_lambda = (const float*)d_in[10];
    p.nsa_pe_k = (const float*)d_in[11]; p.nsa_pe_v = (const float*)d_in[12]; p.nsa_w1_k = (const float*)d_in[13]; p.nsa_w2_k = (const float*)d_in[14];
    p.nsa_w1_v = (const float*)d_in[15]; p.nsa_w2_v = (const float*)d_in[16];
    p.w_br_fox = (const float*)d_in[17]; p.w_br_lru = (const float*)d_in[18]; p.w_br_dil = (const float*)d_in[19]; p.w_br_nsa = (const float*)d_in[20];
    p.w_out = (const float*)d_in[21]; p.norm2_g = (const float*)d_in[22]; p.peer_w_q = (const float*)d_in[23]; p.peer_sub_keys = (const float*)d_in[24];
    p.peer_u = (const float*)d_in[25]; p.peer_v = (const float*)d_in[26]; p.final_g = (const float*)d_in[27];
    p.out = (float*)d_out; p.ws = (char*)d_ws;
    char* ws = p.ws;
    for (int l = 0; l < NLAYER; ++l) {
        k_tconv<<<16 * (WIN_ROWS / 64), 256, 0, stream>>>(p.w_in + (size_t)l * 1024 * IN_WIDTH, IN_WIDTH, 1024, (u16*)(ws + OFF_WIN) + (size_t)l * WIN_ROWS * 1024, 1024, WIN_ROWS, 1);
        k_tconv<<<16 * 32, 256, 0, stream>>>(p.peer_w_q + (size_t)l * 1024 * 2048, 2048, 1024, (u16*)(ws + OFF_WQ) + (size_t)l * 2048 * 1024, 1024, 2048, 0);
        k_tconv<<<16 * 16, 256, 0, stream>>>(p.w_out + (size_t)l * 1024 * 1024, 1024, 1024, (u16*)(ws + OFF_WOUT) + (size_t)l * 1024 * 1024, 1024, 1024, 0);
        u16* wbr = (u16*)(ws + OFF_WBR) + (size_t)l * 1024 * OW;
        k_tconv<<<4 * 16, 256, 0, stream>>>(p.w_br_fox + (size_t)l * 256 * 1024, 1024, 256, wbr + O_FOX, OW, 1024, 0);
        k_tconv<<<4 * 16, 256, 0, stream>>>(p.w_br_lru + (size_t)l * 256 * 1024, 1024, 256, wbr + O_LRU, OW, 1024, 0);
        k_tconv<<<2 * 16, 256, 0, stream>>>(p.w_br_dil + (size_t)l * 128 * 1024, 1024, 128, wbr + O_DIL, OW, 1024, 0);
        k_tconv<<<4 * 16, 256, 0, stream>>>(p.w_br_nsa + (size_t)l * 256 * 1024, 1024, 256, wbr + O_NSA, OW, 1024, 0);
        for (int z = 0; z < 2; ++z) {
            const float* w1 = (z ? p.nsa_w1_v : p.nsa_w1_k) + (size_t)l * 2048 * 256;
            const float* w2 = (z ? p.nsa_w2_v : p.nsa_w2_k) + (size_t)l * 256 * 64;
            k_tconv<<<32 * 4, 256, 0, stream>>>(w1, 256, 2048, (u16*)(ws + OFF_W1) + (size_t)(l * 2 + z) * 256 * 2048, 2048, 256, 0);
            k_tconv<<<4 * 1, 256, 0, stream>>>(w2, 64, 256, (u16*)(ws + OFF_W2) + (size_t)(l * 2 + z) * 64 * 256, 256, 64, 0);
        }
    }
    k_cvt<<<64, 256, 0, stream>>>(p.peer_sub_keys, (u16*)(ws + OFF_SUBK), (size_t)NLAYER * 2 * 128 * 128 / 4);
    k_misc<<<SEQ * 32 / 256, 256, 0, stream>>>(p);
    for (int l = 0; l < NLAYER; ++l) {
        const float* xin = l == 0 ? p.x : p.out;
        k_cvt<<<2048, 256, 0, stream>>>(p.peer_u + (size_t)l * NEXP * 1024, (u16*)(ws + OFF_PUV), (size_t)NEXP * 1024 / 4);
        k_cvt<<<2048, 256, 0, stream>>>(p.peer_v + (size_t)l * NEXP * 1024, (u16*)(ws + OFF_PUV) + (size_t)NEXP * 1024, (size_t)NEXP * 1024 / 4);
        k_rmsnorm<false><<<2048, 256, 0, stream>>>(xin, p.norm1_g + l * 1024, (u16*)(ws + OFF_H), nullptr);
        k_proj<<<1024, 256, GEMM_LDS_128, stream>>>(p, l);
        k_rope<<<2048, 256, 0, stream>>>(p);
        k_foxcum<<<16, 256, 0, stream>>>(p, l);
        k_lru<0><<<512, 256, 0, stream>>>(p, l);
        k_cmp1<<<64, 256, GEMM_LDS_128, stream>>>(p, l);
        k_cmp2<<<32, 256, GEMM_LDS_128, stream>>>(p, l);
        k_fox<<<1024, 256, 0, stream>>>(p);
        k_dil<<<512, 256, 0, stream>>>(p);
        k_nsacmp<<<512, 256, 0, stream>>>(p);
        k_nsasw<<<1024, 256, 0, stream>>>(p);
        k_lru<1><<<512, 256, 0, stream>>>(p, l);
        k_merge<<<2048, 256, GEMM_LDS_128, stream>>>(p, l);
        k_wout<<<1024, 256, GEMM_LDS_128, stream>>>(p, l);
        k_rmsnorm<false><<<2048, 256, 0, stream>>>(p.out, p.norm2_g + l * 1024, (u16*)(ws + OFF_H), nullptr);
        k_peerq<<<2048, 256, GEMM_LDS_128, stream>>>(p, l);
        k_peertop<<<2048, 256, 0, stream>>>(p, l);
        k_peergather<<<2048, 256, 0, stream>>>(p, p.norm2_g + l * 1024);
    }
    k_rmsnorm<true><<<2048, 256, 0, stream>>>(p.out, p.final_g, nullptr, p.out);
}
```

```cpp
#include <hip/hip_runtime.h>
#include <cstdio>
#include <cstdint>
#include <hip/hip_cooperative_groups.h>
namespace cg = cooperative_groups;

typedef unsigned short u16;
typedef short s16x8 __attribute__((ext_vector_type(8)));
typedef short s16x4 __attribute__((ext_vector_type(4)));
typedef float f32x4 __attribute__((ext_vector_type(4)));
typedef float f32x2 __attribute__((ext_vector_type(2)));
typedef unsigned u32x4 __attribute__((ext_vector_type(4)));
typedef unsigned u32x2 __attribute__((ext_vector_type(2)));
typedef __bf16 bf16x2_t __attribute__((ext_vector_type(2)));
#define LAS __attribute__((address_space(3)))
#define DEVI __device__ __forceinline__

constexpr int NB = 4, SEQ = 8192, DM = 1024, NTOK = NB * SEQ, NLAYER = 2;
constexpr int PW = 3072;
constexpr int C_FQ = 0, C_FK = 256, C_FV = 512, C_LX = 768, C_LG = 1024, C_DQ = 1280, C_DK = 1664, C_DV = 2048,
              C_NQ = 2432, C_NKC = 2688, C_NVC = 2752, C_NKS = 2816, C_NVS = 2880, C_NKW = 2944, C_NVW = 3008;
constexpr int WIN_ROWS = 7296;
constexpr int WIN_GATE0 = 3200;
constexpr int IN_WIDTH = 7184;
constexpr int OW = 896;
constexpr int O_FOX = 0, O_LRU = 256, O_DIL = 512, O_NSA = 640;
constexpr int NEXP = 16384;

constexpr size_t SZ_WIN = (size_t)NLAYER * WIN_ROWS * 1024 * 2;
constexpr size_t SZ_WQ = (size_t)NLAYER * 2048 * 1024 * 2;
constexpr size_t SZ_WOUT = (size_t)NLAYER * 1024 * 1024 * 2;
constexpr size_t SZ_WBR = (size_t)NLAYER * 1024 * OW * 2;
constexpr size_t SZ_W1 = (size_t)NLAYER * 2 * 256 * 2048 * 2;
constexpr size_t SZ_W2 = (size_t)NLAYER * 2 * 64 * 256 * 2;
constexpr size_t SZ_B1 = (size_t)NLAYER * 2 * 256 * 4;
constexpr size_t SZ_SUBK = (size_t)NLAYER * 2 * 128 * 128 * 2;
constexpr size_t SZ_ROPE = (size_t)SEQ * 32 * 8;
constexpr size_t SZ_PUV = (size_t)2 * NEXP * 1024 * 2;
constexpr size_t SZ_H = (size_t)NTOK * 1024 * 2;
constexpr size_t SZ_P = (size_t)NTOK * PW * 2;
constexpr size_t SZ_FS = (size_t)NTOK * 16 * 4;
constexpr size_t SZ_NQR = (size_t)NTOK * 256 * 2;
constexpr size_t SZ_CUM = (size_t)NTOK * 4 * 4;
constexpr size_t SZ_LSUM = (size_t)2 * 512 * 256 * 4;
constexpr size_t SZ_HID = (size_t)2 * 2048 * 256 * 2;
constexpr size_t SZ_KVC = (size_t)2 * NB * 512 * 64 * 2;
constexpr size_t SZ_O = (size_t)NTOK * OW * 2;
constexpr size_t SZ_OC = (size_t)NTOK * 256 * 2;
constexpr size_t SZ_SEL = (size_t)NTOK * 4 * 4;

constexpr size_t OFF_WIN = 0;
constexpr size_t OFF_WQ = OFF_WIN + SZ_WIN;
constexpr size_t OFF_WOUT = OFF_WQ + SZ_WQ;
constexpr size_t OFF_WBR = OFF_WOUT + SZ_WOUT;
constexpr size_t OFF_W1 = OFF_WBR + SZ_WBR;
constexpr size_t OFF_W2 = OFF_W1 + SZ_W1;
constexpr size_t OFF_B1 = OFF_W2 + SZ_W2;
constexpr size_t OFF_SUBK = OFF_B1 + SZ_B1;
constexpr size_t OFF_ROPE = OFF_SUBK + SZ_SUBK;
constexpr size_t OFF_PUV = OFF_ROPE + SZ_ROPE;
constexpr size_t OFF_H = OFF_PUV + SZ_PUV;
constexpr size_t OFF_P = OFF_H + SZ_H;
constexpr size_t OFF_FS = OFF_P + SZ_P;
constexpr size_t OFF_NQR = OFF_FS + SZ_FS;
constexpr size_t OFF_CUM = OFF_NQR + SZ_NQR;
constexpr size_t OFF_LSUM = OFF_CUM + SZ_CUM;
constexpr size_t OFF_HID = OFF_LSUM + SZ_LSUM;
constexpr size_t OFF_KVC = OFF_HID + SZ_HID;
constexpr size_t OFF_O = OFF_KVC + SZ_KVC;
constexpr size_t OFF_OC = OFF_O + SZ_O;
constexpr size_t OFF_SEL = OFF_OC + SZ_OC;
constexpr size_t OFF_CTRL = OFF_SEL + SZ_SEL;
constexpr size_t WS_NEED = OFF_CTRL + 256;
static_assert(WS_NEED <= (size_t)512 * 1024 * 1024, "workspace over 512 MiB");
constexpr size_t OFF_MERGED = OFF_P;
constexpr size_t OFF_QP = OFF_P + (size_t)NTOK * 1024 * 2;
static_assert(OFF_QP + (size_t)NTOK * 2048 * 2 <= OFF_P + SZ_P, "alias");
constexpr size_t OFF_PIDX = OFF_H;
constexpr size_t OFF_PGW = OFF_H + (size_t)NTOK * 128 * 4;
static_assert(OFF_PGW + (size_t)NTOK * 128 * 4 <= OFF_H + SZ_H, "alias");

struct Params {
    const float* x; const float* norm1_g; const float* w_in; const float* fox_b_f;
    const float* lru_conv_w; const float* lru_conv_b; const float* lru_w_a; const float* lru_b_a;
    const float* lru_w_x; const float* lru_b_x; const float* lru_lambda;
    const float* nsa_pe_k; const float* nsa_pe_v; const float* nsa_w1_k; const float* nsa_w2_k;
    const float* nsa_w1_v; const float* nsa_w2_v;
    const float* w_br_fox; const float* w_br_lru; const float* w_br_dil; const float* w_br_nsa;
    const float* w_out; const float* norm2_g; const float* peer_w_q; const float* peer_sub_keys;
    const float* peer_u; const float* peer_v; const float* final_g;
    float* out; char* ws;
};

DEVI unsigned pk2(float a, float b) { f32x2 v = {a, b}; bf16x2_t r = __builtin_convertvector(v, bf16x2_t); return __builtin_bit_cast(unsigned, r); }
DEVI u16 f2bf(float a) { return (u16)(pk2(a, 0.f) & 0xffffu); }
DEVI float bf2f(u16 h) { return __uint_as_float(((unsigned)h) << 16); }
DEVI float bflo(unsigned w) { return __uint_as_float(w << 16); }
DEVI float bfhi(unsigned w) { return __uint_as_float(w & 0xffff0000u); }
DEVI float sigmoidf_(float x) { return 1.f / (1.f + __expf(-x)); }
DEVI float gelu_tanh(float x) { float u = 0.7978845608028654f * (x + 0.044715f * x * x * x); return x / (1.f + __expf(-2.f * u)); }
DEVI f32x4 mfma16(s16x8 a, s16x8 b, f32x4 c) { return __builtin_amdgcn_mfma_f32_16x16x32_bf16(a, b, c, 0, 0, 0); }
DEVI float wave_sum(float v) {
#pragma unroll
    for (int o = 32; o > 0; o >>= 1) v += __shfl_xor(v, o);
    return v;
}
DEVI unsigned wave_max_u32(unsigned v) {
#pragma unroll
    for (int o = 32; o > 0; o >>= 1) { unsigned t = (unsigned)__shfl_xor((int)v, o); v = v > t ? v : t; }
    return v;
}

template <int BM, int BN>
DEVI void gemm_mainloop(const u16* __restrict__ A, size_t lda, size_t a_kstride, const u16* __restrict__ Bt, size_t ldb, int K,
                        int m0, int n0, char* smem, f32x4 (&acc)[BM / 32][BN / 32]) {
    constexpr int MT = BM / 32, NT = BN / 32, ACH = BM * 8 / 256, BCH = BN * 8 / 256;
    constexpr int A_BYTES = BM * 128, STAGE = (BM + BN) * 128;
    const int tid = threadIdx.x, lane = tid & 63, w = tid >> 6, wm = w >> 1, wn = w & 1, g = lane >> 4, c = lane & 15;
    u32x4 ra[ACH], rb[BCH];
    const int nk = K / 64;
#pragma unroll
    for (int i = 0; i < ACH; ++i) { int ch = tid + 256 * i, row = ch >> 3, cc = ch & 7; ra[i] = *(const u32x4*)(A + (size_t)(m0 + row) * lda + cc * 8); }
#pragma unroll
    for (int i = 0; i < BCH; ++i) { int ch = tid + 256 * i, row = ch >> 3, cc = ch & 7; rb[i] = *(const u32x4*)(Bt + (size_t)(n0 + row) * ldb + cc * 8); }
#pragma unroll
    for (int i = 0; i < ACH; ++i) { int ch = tid + 256 * i, row = ch >> 3, cc = ch & 7; *(u32x4*)(smem + row * 128 + ((cc ^ (row & 7)) << 4)) = ra[i]; }
#pragma unroll
    for (int i = 0; i < BCH; ++i) { int ch = tid + 256 * i, row = ch >> 3, cc = ch & 7; *(u32x4*)(smem + A_BYTES + row * 128 + ((cc ^ (row & 7)) << 4)) = rb[i]; }
    __syncthreads();
    for (int kt = 0; kt < nk; ++kt) {
        const bool more = kt + 1 < nk;
        if (more) {
#pragma unroll
            for (int i = 0; i < ACH; ++i) { int ch = tid + 256 * i, row = ch >> 3, cc = ch & 7; ra[i] = *(const u32x4*)(A + (size_t)(m0 + row) * lda + (size_t)(kt + 1) * a_kstride + cc * 8); }
#pragma unroll
            for (int i = 0; i < BCH; ++i) { int ch = tid + 256 * i, row = ch >> 3, cc = ch & 7; rb[i] = *(const u32x4*)(Bt + (size_t)(n0 + row) * ldb + (size_t)(kt + 1) * 64 + cc * 8); }
        }
        const char* sA = smem + (kt & 1) * STAGE; const char* sB = sA + A_BYTES;
#pragma unroll
        for (int ks = 0; ks < 2; ++ks) {
            s16x8 af[MT], bfr[NT];
#pragma unroll
            for (int mt = 0; mt < MT; ++mt) { int row = wm * (BM / 2) + 16 * mt + c; af[mt] = *(const s16x8*)(sA + row * 128 + (((4 * ks + g) ^ (row & 7)) << 4)); }
#pragma unroll
            for (int nt = 0; nt < NT; ++nt) { int row = wn * (BN / 2) + 16 * nt + c; bfr[nt] = *(const s16x8*)(sB + row * 128 + (((4 * ks + g) ^ (row & 7)) << 4)); }
#pragma unroll
            for (int mt = 0; mt < MT; ++mt)
#pragma unroll
                for (int nt = 0; nt < NT; ++nt) acc[mt][nt] = mfma16(bfr[nt], af[mt], acc[mt][nt]);
        }
        if (more) {
            char* dA = smem + ((kt + 1) & 1) * STAGE; char* dB = dA + A_BYTES;
#pragma unroll
            for (int i = 0; i < ACH; ++i) { int ch = tid + 256 * i, row = ch >> 3, cc = ch & 7; *(u32x4*)(dA + row * 128 + ((cc ^ (row & 7)) << 4)) = ra[i]; }
#pragma unroll
            for (int i = 0; i < BCH; ++i) { int ch = tid + 256 * i, row = ch >> 3, cc = ch & 7; *(u32x4*)(dB + row * 128 + ((cc ^ (row & 7)) << 4)) = rb[i]; }
        }
        __syncthreads();
    }
}
template <int MT, int NT> DEVI void acc_zero(f32x4 (&acc)[MT][NT]) {
#pragma unroll
    for (int i = 0; i < MT; ++i)
#pragma unroll
        for (int j = 0; j < NT; ++j) acc[i][j] = (f32x4){0.f, 0.f, 0.f, 0.f};
}
constexpr int SMEM_BYTES = 69632;

DEVI void grid_bar(unsigned* bar, unsigned nblk, unsigned& epoch) {
    __syncthreads();
    epoch += 1;
    if (threadIdx.x == 0) {
        __builtin_amdgcn_fence(__ATOMIC_RELEASE, "agent");
        asm volatile("s_waitcnt vmcnt(0)" ::: "memory");
        __hip_atomic_fetch_add(bar, 1u, __ATOMIC_RELAXED, __HIP_MEMORY_SCOPE_AGENT);
        const unsigned target = epoch * nblk;
        unsigned spins = 0;
        while (__hip_atomic_load(bar, __ATOMIC_RELAXED, __HIP_MEMORY_SCOPE_AGENT) < target && spins < (1u << 26)) { __builtin_amdgcn_s_sleep(2); ++spins; }
        __builtin_amdgcn_fence(__ATOMIC_ACQUIRE, "agent");
        asm volatile("s_waitcnt vmcnt(0)" ::: "memory");
    }
    __syncthreads();
}

DEVI int win_map(int n) {
    if (n < 768) return n;
    if (n < 3072) return n + 4;
    if (n < 3076) return 768 + (n - 3072);
    if (n < 3088) return n;
    if (n < WIN_GATE0) return -1;
    return n - (WIN_GATE0 - 3088);
}
DEVI void tconv_tile(const float* __restrict__ src, int src_ld, int K, u16* __restrict__ dst, int dst_ld, int ndst, int mode, int tidx, char* smem) {
    float (*tile)[65] = (float (*)[65])smem;
    const int tiles_n = ndst / 64;
    const int kt = tidx / tiles_n, nt = tidx % tiles_n;
    const int tx = threadIdx.x & 63, ty = threadIdx.x >> 6;
    const int n = nt * 64 + tx;
    const int sc = mode == 1 ? win_map(n) : n;
    __syncthreads();
#pragma unroll
    for (int i = 0; i < 16; ++i) { int k = kt * 64 + ty * 16 + i; tile[ty * 16 + i][tx] = sc >= 0 ? src[(size_t)k * src_ld + sc] : 0.f; }
    __syncthreads();
#pragma unroll
    for (int i = 0; i < 16; ++i) { int nn = ty * 16 + i; dst[(size_t)(nt * 64 + nn) * dst_ld + kt * 64 + tx] = f2bf(tile[tx][nn]); }
}
constexpr int TC_WIN = 16 * (WIN_ROWS / 64), TC_WQ = 16 * 32, TC_WOUT = 16 * 16, TC_BR4 = 4 * 16, TC_BR2 = 2 * 16, TC_W1 = 32 * 4, TC_W2 = 4;
constexpr int TC_LAYER = TC_WIN + TC_WQ + TC_WOUT + 3 * TC_BR4 + TC_BR2 + 2 * TC_W1 + 2 * TC_W2;
DEVI void ph_tconv(const Params& p, char* smem, int bid, int nblk) {
    char* ws = p.ws;
    for (int it = bid; it < NLAYER * TC_LAYER; it += nblk) {
        const int l = it / TC_LAYER; int r = it % TC_LAYER;
        u16* wbr = (u16*)(ws + OFF_WBR) + (size_t)l * 1024 * OW;
        if (r < TC_WIN) { tconv_tile(p.w_in + (size_t)l * 1024 * IN_WIDTH, IN_WIDTH, 1024, (u16*)(ws + OFF_WIN) + (size_t)l * WIN_ROWS * 1024, 1024, WIN_ROWS, 1, r, smem); continue; }
        r -= TC_WIN;
        if (r < TC_WQ) { tconv_tile(p.peer_w_q + (size_t)l * 1024 * 2048, 2048, 1024, (u16*)(ws + OFF_WQ) + (size_t)l * 2048 * 1024, 1024, 2048, 0, r, smem); continue; }
        r -= TC_WQ;
        if (r < TC_WOUT) { tconv_tile(p.w_out + (size_t)l * 1024 * 1024, 1024, 1024, (u16*)(ws + OFF_WOUT) + (size_t)l * 1024 * 1024, 1024, 1024, 0, r, smem); continue; }
        r -= TC_WOUT;
        if (r < TC_BR4) { tconv_tile(p.w_br_fox + (size_t)l * 256 * 1024, 1024, 256, wbr + O_FOX, OW, 1024, 0, r, smem); continue; }
        r -= TC_BR4;
        if (r < TC_BR4) { tconv_tile(p.w_br_lru + (size_t)l * 256 * 1024, 1024, 256, wbr + O_LRU, OW, 1024, 0, r, smem); continue; }
        r -= TC_BR4;
        if (r < TC_BR2) { tconv_tile(p.w_br_dil + (size_t)l * 128 * 1024, 1024, 128, wbr + O_DIL, OW, 1024, 0, r, smem); continue; }
        r -= TC_BR2;
        if (r < TC_BR4) { tconv_tile(p.w_br_nsa + (size_t)l * 256 * 1024, 1024, 256, wbr + O_NSA, OW, 1024, 0, r, smem); continue; }
        r -= TC_BR4;
        if (r < 2 * TC_W1) { const int z = r / TC_W1; const float* w1 = (z ? p.nsa_w1_v : p.nsa_w1_k) + (size_t)l * 2048 * 256;
            tconv_tile(w1, 256, 2048, (u16*)(ws + OFF_W1) + (size_t)(l * 2 + z) * 256 * 2048, 2048, 256, 0, r % TC_W1, smem); continue; }
        r -= 2 * TC_W1;
        { const int z = r / TC_W2; const float* w2 = (z ? p.nsa_w2_v : p.nsa_w2_k) + (size_t)l * 256 * 64;
            tconv_tile(w2, 64, 256, (u16*)(ws + OFF_W2) + (size_t)(l * 2 + z) * 64 * 256, 256, 64, 0, r % TC_W2, smem); }
    }
}
DEVI void ph_cvt(const float* __restrict__ src, u16* __restrict__ dst, size_t n4, int bid, int nblk) {
    for (size_t i = (size_t)bid * 256 + threadIdx.x; i < n4; i += (size_t)nblk * 256) {
        f32x4 v = *(const f32x4*)(src + i * 4);
        u32x2 o = {pk2(v[0], v[1]), pk2(v[2], v[3])};
        *(u32x2*)(dst + i * 4) = o;
    }
}
DEVI void ph_misc(const Params& p, int bid, int nblk) {
    for (int gid = bid * 256 + threadIdx.x; gid < SEQ * 32; gid += nblk * 256) {
        const int s = gid >> 5, i = gid & 31;
        const float freq = powf(10000.0f, -(float)i / 32.0f);
        const float ang = (float)s * freq;
        const double rev = (double)ang * 0.15915494309189535;
        const float fr = (float)(rev - floor(rev));
        f32x2 cs = {__builtin_amdgcn_cosf(fr), __builtin_amdgcn_sinf(fr)};
        *(f32x2*)(p.ws + OFF_ROPE + (size_t)gid * 8) = cs;
        if (gid < NLAYER * 2 * 256) {
            const int n = gid & 255, z = (gid >> 8) & 1, l = gid >> 9;
            const float* pe = (z ? p.nsa_pe_v : p.nsa_pe_k) + (size_t)l * 2048;
            const float* w1 = (z ? p.nsa_w1_v : p.nsa_w1_k) + (size_t)l * 2048 * 256;
            float a = 0.f;
            for (int k = 0; k < 2048; ++k) a += pe[k] * w1[(size_t)k * 256 + n];
            ((float*)(p.ws + OFF_B1))[gid] = a;
        }
    }
}

template <bool FINAL>
DEVI void ph_rmsnorm(const float* __restrict__ x, const float* __restrict__ gam, u16* __restrict__ hout, float* __restrict__ fout, int bid, int nblk) {
    const int lane = threadIdx.x & 63;
    for (int row = bid * 4 + (threadIdx.x >> 6); row < NTOK; row += nblk * 4) {
        const float* xr = x + (size_t)row * DM;
        f32x4 v[4]; float ss = 0.f;
#pragma unroll
        for (int i = 0; i < 4; ++i) { v[i] = *(const f32x4*)(xr + i * 256 + lane * 4); ss += v[i][0] * v[i][0] + v[i][1] * v[i][1] + v[i][2] * v[i][2] + v[i][3] * v[i][3]; }
        ss = wave_sum(ss);
        const float rs = rsqrtf(ss * (1.0f / DM) + 1e-6f);
#pragma unroll
        for (int i = 0; i < 4; ++i) {
            f32x4 gg = *(const f32x4*)(gam + i * 256 + lane * 4);
            f32x4 y = {v[i][0] * rs * gg[0], v[i][1] * rs * gg[1], v[i][2] * rs * gg[2], v[i][3] * rs * gg[3]};
            if (FINAL) *(f32x4*)(fout + (size_t)row * DM + i * 256 + lane * 4) = y;
            else { u32x2 o = {pk2(y[0], y[1]), pk2(y[2], y[3])}; *(u32x2*)(hout + (size_t)row * DM + i * 256 + lane * 4) = o; }
        }
    }
}

DEVI void ph_proj(const Params& p, int layer, char* smem, int bid, int nblk) {
    const u16* H = (const u16*)(p.ws + OFF_H);
    const u16* Wt = (const u16*)(p.ws + OFF_WIN) + (size_t)layer * WIN_ROWS * 1024;
    u16* P = (u16*)(p.ws + OFF_P); float* FS = (float*)(p.ws + OFF_FS);
    const int ntn = 25, ntiles = (NTOK / 128) * ntn;
    const int lane = threadIdx.x & 63, w = threadIdx.x >> 6, wm = w >> 1, wn = w & 1, g = lane >> 4, c = lane & 15;
    for (int t = bid; t < ntiles; t += nblk) {
        const int tm = t / ntn, tn = t % ntn, m0 = tm * 128, n0 = tn * 128;
        f32x4 acc[4][4]; acc_zero(acc);
        gemm_mainloop<128, 128>(H, 1024, 64, Wt, 1024, 1024, m0, n0, smem, acc);
#pragma unroll
        for (int mt = 0; mt < 4; ++mt)
#pragma unroll
            for (int nt = 0; nt < 4; ++nt) {
                const int m = m0 + wm * 64 + 16 * mt + c, n = n0 + wn * 64 + 16 * nt + 4 * g;
                if (n < PW) { u32x2 o = {pk2(acc[mt][nt][0], acc[mt][nt][1]), pk2(acc[mt][nt][2], acc[mt][nt][3])}; *(u32x2*)(P + (size_t)m * PW + n) = o; }
                else if (n < PW + 16) *(f32x4*)(FS + (size_t)m * 16 + (n - PW)) = acc[mt][nt];
            }
    }
}

DEVI void ph_rope(const Params& p, int bid, int nblk) {
    u16* P = (u16*)(p.ws + OFF_P); u16* NQR = (u16*)(p.ws + OFF_NQR);
    const f32x2* tab = (const f32x2*)(p.ws + OFF_ROPE);
    const int lane = threadIdx.x & 63, i = lane & 31, half = lane >> 5;
    for (int tok = bid * 4 + (threadIdx.x >> 6); tok < NTOK; tok += nblk * 4) {
        const int s = tok & (SEQ - 1);
        const f32x2 cs = tab[s * 32 + i];
        u16* row = P + (size_t)tok * PW;
#pragma unroll
        for (int j = 0; j < 9; ++j) {
            const int hd = 2 * j + half;
            int col;
            if (hd < 6) col = C_DQ + hd * 64; else if (hd < 12) col = C_DK + (hd - 6) * 64; else if (hd < 16) col = C_NQ + (hd - 12) * 64; else if (hd == 16) col = C_NKS; else col = C_NKW;
            const float x1 = bf2f(row[col + i]), x2 = bf2f(row[col + 32 + i]);
            const float y1 = x1 * cs[0] - x2 * cs[1], y2 = x2 * cs[0] + x1 * cs[1];
            if (hd >= 12 && hd < 16) { u16* d = NQR + (size_t)tok * 256 + (hd - 12) * 64; d[i] = f2bf(y1); d[32 + i] = f2bf(y2); }
            else { row[col + i] = f2bf(y1); row[col + 32 + i] = f2bf(y2); }
        }
    }
}

DEVI void ph_foxcum(const Params& p, int layer, char* smem, int bid, int nblk) {
    float* part = (float*)smem;
    const int tid = threadIdx.x;
    const float* FS = (const float*)(p.ws + OFF_FS); float* CUM = (float*)(p.ws + OFF_CUM);
    for (int it = bid; it < 16; it += nblk) {
        const int b = it >> 2, h = it & 3;
        const float bf = p.fox_b_f[layer * 4 + h];
        float v[32]; float run = 0.f;
#pragma unroll
        for (int i = 0; i < 32; ++i) {
            const float z = FS[(size_t)(b * SEQ + tid * 32 + i) * 16 + h] + bf;
            const float ls = fminf(z, 0.f) - log1pf(__expf(-fabsf(z)));
            run += ls; v[i] = run;
        }
        __syncthreads();
        part[tid] = run; __syncthreads();
        if (tid == 0) { float a = 0.f; for (int i = 0; i < 256; ++i) { float t = part[i]; part[i] = a; a += t; } }
        __syncthreads();
        const float base = part[tid];
#pragma unroll
        for (int i = 0; i < 32; ++i) CUM[(size_t)(b * SEQ + tid * 32 + i) * 4 + h] = base + v[i];
    }
}

template <int MODE>
DEVI void ph_lru(const Params& p, int layer, char* smem, int bid, int nblk) {
    float (*sx)[256] = (float (*)[256])smem;
    const int ch = threadIdx.x, nb = ch >> 6, d = ch & 63;
    const u16* P = (const u16*)(p.ws + OFF_P);
    float* SA = (float*)(p.ws + OFF_LSUM); float* SH = SA + 512 * 256;
    u16* O = (u16*)(p.ws + OFF_O);
    if (bid >= 512) return;
    float wa[64], wx[64];
    const float* WA = p.lru_w_a + (size_t)layer * 4 * 64 * 64 + (size_t)nb * 64 * 64;
    const float* WX = p.lru_w_x + (size_t)layer * 4 * 64 * 64 + (size_t)nb * 64 * 64;
#pragma unroll
    for (int k = 0; k < 64; ++k) { wa[k] = WA[k * 64 + d]; wx[k] = WX[k * 64 + d]; }
    const float cw0 = p.lru_conv_w[(layer * 4 + 0) * 256 + ch], cw1 = p.lru_conv_w[(layer * 4 + 1) * 256 + ch],
                cw2 = p.lru_conv_w[(layer * 4 + 2) * 256 + ch], cw3 = p.lru_conv_w[(layer * 4 + 3) * 256 + ch];
    const float cb = p.lru_conv_b[layer * 256 + ch], ba = p.lru_b_a[layer * 256 + ch], bx = p.lru_b_x[layer * 256 + ch];
    const float lam = p.lru_lambda[layer * 256 + ch];
    const float sp = (lam > 0.f ? 0.f : -lam) + log1pf(__expf(-fabsf(lam)));
    for (int tile = bid; tile < 512; tile += nblk) {
        const int b = tile >> 7, k = tile & 127, t0 = b * SEQ + k * 64;
        float hst = 0.f, aprod = 1.f;
        if (MODE == 1) { for (int j = 0; j < k; ++j) { const int tj = (b << 7) + j; hst = SA[tj * 256 + ch] * hst + SH[tj * 256 + ch]; } }
        float x0 = 0.f, x1 = 0.f, x2 = 0.f;
        if (k > 0) { x0 = bf2f(P[(size_t)(t0 - 3) * PW + C_LX + ch]); x1 = bf2f(P[(size_t)(t0 - 2) * PW + C_LX + ch]); x2 = bf2f(P[(size_t)(t0 - 1) * PW + C_LX + ch]); }
        for (int sub = 0; sub < 4; ++sub) {
            float xc[16];
            __syncthreads();
#pragma unroll
            for (int i = 0; i < 16; ++i) {
                const float x3 = bf2f(P[(size_t)(t0 + sub * 16 + i) * PW + C_LX + ch]);
                xc[i] = cw0 * x0 + cw1 * x1 + cw2 * x2 + cw3 * x3 + cb;
                x0 = x1; x1 = x2; x2 = x3;
                sx[i][ch] = xc[i];
            }
            __syncthreads();
#pragma unroll
            for (int i = 0; i < 16; ++i) {
                float aa = ba, ax = bx;
#pragma unroll
                for (int kk = 0; kk < 64; kk += 4) {
                    const f32x4 xv = *(const f32x4*)&sx[i][nb * 64 + kk];
                    aa += xv[0] * wa[kk] + xv[1] * wa[kk + 1] + xv[2] * wa[kk + 2] + xv[3] * wa[kk + 3];
                    ax += xv[0] * wx[kk] + xv[1] * wx[kk + 1] + xv[2] * wx[kk + 2] + xv[3] * wx[kk + 3];
                }
                const float r = sigmoidf_(aa), ig = sigmoidf_(ax);
                const float log_a = -8.0f * r * sp;
                const float a = __expf(log_a);
                const float u = sqrtf(-expm1f(2.f * log_a)) * (ig * xc[i]);
                hst = a * hst + u;
                if (MODE == 0) aprod *= a;
                else {
                    const size_t tok = (size_t)(t0 + sub * 16 + i);
                    const float gate = bf2f(P[tok * PW + C_LG + ch]);
                    O[tok * OW + O_LRU + ch] = f2bf(hst * gelu_tanh(gate));
                }
            }
        }
        if (MODE == 0) { SA[tile * 256 + ch] = aprod; SH[tile * 256 + ch] = hst; }
    }
}

DEVI void ph_cmp(const Params& p, int layer, char* smem, int bid, int nblk) {
    const u16* P = (const u16*)(p.ws + OFF_P);
    const int lane = threadIdx.x & 63, w = threadIdx.x >> 6, wm = w >> 1, wn = w & 1, g = lane >> 4, c = lane & 15;
    for (int t = bid; t < 32; t += nblk) {
        const int z = t >> 4, tm = t & 15;
        const int b = tm >> 2, i0 = (tm & 3) * 128;
        const u16* A = P + (size_t)(b * SEQ) * PW + (z ? C_NVC : C_NKC);
        const u16* Wt = (const u16*)(p.ws + OFF_W1) + ((size_t)(layer * 2 + z) * 256) * 2048;
        const float* b1 = (const float*)(p.ws + OFF_B1) + (layer * 2 + z) * 256;
        u16* HID = (u16*)(p.ws + OFF_HID) + (size_t)z * 2048 * 256;
        for (int tn = 0; tn < 2; ++tn) {
            f32x4 acc[4][4]; acc_zero(acc);
            gemm_mainloop<128, 128>(A, (size_t)16 * PW, (size_t)PW, Wt, 2048, 2048, i0, tn * 128, smem, acc);
#pragma unroll
            for (int mt = 0; mt < 4; ++mt)
#pragma unroll
                for (int nt = 0; nt < 4; ++nt) {
                    const int m = b * 512 + i0 + wm * 64 + 16 * mt + c, n = tn * 128 + wn * 64 + 16 * nt + 4 * g;
                    const f32x4 bb = *(const f32x4*)(b1 + n);
                    u32x2 o = {pk2(gelu_tanh(acc[mt][nt][0] + bb[0]), gelu_tanh(acc[mt][nt][1] + bb[1])), pk2(gelu_tanh(acc[mt][nt][2] + bb[2]), gelu_tanh(acc[mt][nt][3] + bb[3]))};
                    *(u32x2*)(HID + (size_t)m * 256 + n) = o;
                }
        }
        __syncthreads();
        {
            const u16* W2 = (const u16*)(p.ws + OFF_W2) + ((size_t)(layer * 2 + z) * 64) * 256;
            f32x4 acc[4][2]; acc_zero(acc);
            gemm_mainloop<128, 64>(HID, 256, 64, W2, 256, 256, tm * 128, 0, smem, acc);
            u16* KVC = (u16*)(p.ws + OFF_KVC) + (size_t)z * NB * 512 * 64;
#pragma unroll
            for (int mt = 0; mt < 4; ++mt)
#pragma unroll
                for (int nt = 0; nt < 2; ++nt) {
                    const int m = tm * 128 + wm * 64 + 16 * mt + c, n = wn * 32 + 16 * nt + 4 * g;
                    u32x2 o = {pk2(acc[mt][nt][0], acc[mt][nt][1]), pk2(acc[mt][nt][2], acc[mt][nt][3])};
                    if ((m & 511) == 511) o = (u32x2){0u, 0u};
                    *(u32x2*)(KVC + (size_t)m * 64 + n) = o;
                }
        }
    }
}
template <int NQT, class F>
DEVI void attn_tile64(const char* sK, const char* sV, const s16x8 (&qf)[NQT][2], float (&m)[NQT], float (&l)[NQT], f32x4 (&o)[NQT][4], int lane, F&& logit) {
    const int g = lane >> 4, c = lane & 15;
    f32x4 s[NQT][4];
#pragma unroll
    for (int T = 0; T < 4; ++T) {
        const int row = 16 * T + c;
        const s16x8 k0 = *(const s16x8*)(sK + row * 128 + ((g ^ (row & 7)) << 4));
        const s16x8 k1 = *(const s16x8*)(sK + row * 128 + (((4 + g) ^ (row & 7)) << 4));
#pragma unroll
        for (int qt = 0; qt < NQT; ++qt) { f32x4 z = {0.f, 0.f, 0.f, 0.f}; z = mfma16(k0, qf[qt][0], z); z = mfma16(k1, qf[qt][1], z); s[qt][T] = z; }
    }
#pragma unroll
    for (int qt = 0; qt < NQT; ++qt) {
        float mx = -INFINITY;
#pragma unroll
        for (int T = 0; T < 4; ++T) { logit(qt, T, s[qt][T]); mx = fmaxf(mx, fmaxf(fmaxf(s[qt][T][0], s[qt][T][1]), fmaxf(s[qt][T][2], s[qt][T][3]))); }
        mx = fmaxf(mx, __shfl_xor(mx, 16)); mx = fmaxf(mx, __shfl_xor(mx, 32));
        const float mn = fmaxf(m[qt], mx), alpha = __expf(m[qt] - mn);
        m[qt] = mn;
        float ps = 0.f;
#pragma unroll
        for (int T = 0; T < 4; ++T)
#pragma unroll
            for (int r = 0; r < 4; ++r) { const float pv = __expf(s[qt][T][r] - mn); s[qt][T][r] = pv; ps += pv; }
        l[qt] = l[qt] * alpha + ps;
#pragma unroll
        for (int dt = 0; dt < 4; ++dt) o[qt][dt] *= alpha;
    }
#pragma unroll
    for (int u = 0; u < 2; ++u) {
        s16x8 pb[NQT];
#pragma unroll
        for (int qt = 0; qt < NQT; ++qt) {
            u32x4 pk = {pk2(s[qt][2 * u][0], s[qt][2 * u][1]), pk2(s[qt][2 * u][2], s[qt][2 * u][3]), pk2(s[qt][2 * u + 1][0], s[qt][2 * u + 1][1]), pk2(s[qt][2 * u + 1][2], s[qt][2 * u + 1][3])};
            pb[qt] = __builtin_bit_cast(s16x8, pk);
        }
#pragma unroll
        for (int dt = 0; dt < 4; ++dt) {
            const char* a0 = sV + (32 * u + 4 * g + (c >> 2)) * 144 + (16 * dt + 4 * (c & 3)) * 2;
            const s16x4 v0 = __builtin_amdgcn_ds_read_tr16_b64_v4i16((LAS s16x4*)(a0));
            const s16x4 v1 = __builtin_amdgcn_ds_read_tr16_b64_v4i16((LAS s16x4*)(a0 + 16 * 144));
            const s16x8 vf = {v0[0], v0[1], v0[2], v0[3], v1[0], v1[1], v1[2], v1[3]};
#pragma unroll
            for (int qt = 0; qt < NQT; ++qt) o[qt][dt] = mfma16(vf, pb[qt], o[qt][dt]);
        }
    }
}
template <int NQT> DEVI void attn_init(float (&m)[NQT], float (&l)[NQT], f32x4 (&o)[NQT][4]) {
#pragma unroll
    for (int qt = 0; qt < NQT; ++qt) { m[qt] = -1e30f; l[qt] = 0.f;
#pragma unroll
        for (int dt = 0; dt < 4; ++dt) o[qt][dt] = (f32x4){0.f, 0.f, 0.f, 0.f}; }
}
DEVI float attn_ltot(float l) { l += __shfl_xor(l, 16); l += __shfl_xor(l, 32); return l; }
DEVI void stage_kv_block(char* sK, char* sV, const u16* kbase, const u16* vbase, size_t rstride) {
    const int tid = threadIdx.x;
#pragma unroll
    for (int i = 0; i < 2; ++i) {
        const int id = tid + 256 * i, key = id >> 3, cc = id & 7;
        const u32x4 kv = *(const u32x4*)(kbase + (size_t)key * rstride + cc * 8);
        const u32x4 vv = *(const u32x4*)(vbase + (size_t)key * rstride + cc * 8);
        *(u32x4*)(sK + key * 128 + ((cc ^ (key & 7)) << 4)) = kv;
        *(u32x4*)(sV + key * 144 + cc * 16) = vv;
    }
}
constexpr int ATT_SK = 8192, ATT_SV = 64 * 144;

DEVI void fox_item(const Params& p, char* smem, int qb, int bh) {
    char* sK = smem; char* sV = smem + ATT_SK; float* sC = (float*)(smem + ATT_SK + ATT_SV);
    const u16* P = (const u16*)(p.ws + OFF_P); const float* CUM = (const float*)(p.ws + OFF_CUM); u16* O = (u16*)(p.ws + OFF_O);
    const int tid = threadIdx.x, lane = tid & 63, w = tid >> 6, g = lane >> 4, c = lane & 15;
    const int b = bh >> 2, h = bh & 3;
    const int q0 = qb * 128, qw = q0 + 32 * w;
    s16x8 qf[2][2]; float cq[2];
#pragma unroll
    for (int qt = 0; qt < 2; ++qt) {
        const size_t tok = (size_t)b * SEQ + qw + 16 * qt + c;
        qf[qt][0] = *(const s16x8*)(P + tok * PW + C_FQ + h * 64 + 8 * g);
        qf[qt][1] = *(const s16x8*)(P + tok * PW + C_FQ + h * 64 + 32 + 8 * g);
        cq[qt] = CUM[tok * 4 + h];
    }
    float m[2], l[2]; f32x4 o[2][4]; attn_init<2>(m, l, o);
    const int ntile = (q0 + 128) / 64;
    for (int kt = 0; kt < ntile; ++kt) {
        __syncthreads();
        const size_t kt0 = (size_t)b * SEQ + kt * 64;
        stage_kv_block(sK, sV, P + kt0 * PW + C_FK + h * 64, P + kt0 * PW + C_FV + h * 64, PW);
        if (tid < 64) sC[tid] = CUM[(kt0 + tid) * 4 + h];
        __syncthreads();
        if (kt * 64 <= qw + 31) {
            attn_tile64<2>(sK, sV, qf, m, l, o, lane, [&](int qt, int T, f32x4& s) {
                const f32x4 ck = *(const f32x4*)&sC[16 * T + 4 * g];
                const int qpos = qw + 16 * qt + c, k0 = kt * 64 + 16 * T + 4 * g;
#pragma unroll
                for (int r = 0; r < 4; ++r) s[r] = (k0 + r <= qpos) ? s[r] * 0.125f + (cq[qt] - ck[r]) : -INFINITY;
            });
        }
    }
#pragma unroll
    for (int qt = 0; qt < 2; ++qt) {
        const float inv = 1.f / attn_ltot(l[qt]);
        const size_t tok = (size_t)b * SEQ + qw + 16 * qt + c;
#pragma unroll
        for (int dt = 0; dt < 4; ++dt) {
            u32x2 ov = {pk2(o[qt][dt][0] * inv, o[qt][dt][1] * inv), pk2(o[qt][dt][2] * inv, o[qt][dt][3] * inv)};
            *(u32x2*)(O + tok * OW + O_FOX + h * 64 + 16 * dt + 4 * g) = ov;
        }
    }
}

DEVI void dil_item(const Params& p, char* smem, int blk) {
    const u16* P = (const u16*)(p.ws + OFF_P); u16* O = (u16*)(p.ws + OFF_O);
    const int tid = threadIdx.x, lane = tid & 63, w = tid >> 6, g = lane >> 4, c = lane & 15;
    char* sK = smem + w * (ATT_SK + ATT_SV); char* sV = sK + ATT_SK;
    const int wt = blk * 4 + w, hg = wt & 1, t0r = (wt >> 1) & 15, span = (wt >> 5) & 15, b = wt >> 9;
    const int pbase = 512 * span + t0r;
    float m[2], l[2]; f32x4 o[2][4]; attn_init<2>(m, l, o);
#pragma unroll
    for (int gi = 0; gi < 3; ++gi) {
        const int dl = gi == 0 ? 1 : (gi == 1 ? 4 : 16), sh = gi == 0 ? 0 : (gi == 1 ? 2 : 4);
        const int head = 2 * gi + hg, rr = t0r & (dl - 1);
        s16x8 qf[2][2]; int uq[2];
#pragma unroll
        for (int qt = 0; qt < 2; ++qt) {
            const int pos = pbase + 16 * (16 * qt + c);
            const size_t tok = (size_t)b * SEQ + pos;
            qf[qt][0] = *(const s16x8*)(P + tok * PW + C_DQ + head * 64 + 8 * g);
            qf[qt][1] = *(const s16x8*)(P + tok * PW + C_DQ + head * 64 + 32 + 8 * g);
            uq[qt] = (pos - rr) >> sh;
        }
        int ulo = ((512 * span) >> sh) - 128; if (ulo < 0) ulo = 0;
        const int uhi = (512 * span + 15 + 496) >> sh;
        const int nt = (uhi - ulo) / 64 + 1;
        for (int kt = 0; kt < nt; ++kt) {
            __syncthreads();
#pragma unroll
            for (int i = 0; i < 8; ++i) {
                const int id = lane + 64 * i, key = id >> 3, cc = id & 7;
                int pos = rr + ((ulo + kt * 64 + key) << sh); if (pos > SEQ - 1) pos = SEQ - 1;
                const size_t tok = (size_t)b * SEQ + pos;
                const u32x4 kv = *(const u32x4*)(P + tok * PW + C_DK + head * 64 + cc * 8);
                const u32x4 vv = *(const u32x4*)(P + tok * PW + C_DV + head * 64 + cc * 8);
                *(u32x4*)(sK + key * 128 + ((cc ^ (key & 7)) << 4)) = kv;
                *(u32x4*)(sV + key * 144 + cc * 16) = vv;
            }
            __syncthreads();
            attn_tile64<2>(sK, sV, qf, m, l, o, lane, [&](int qt, int T, f32x4& s) {
                const int u0 = ulo + kt * 64 + 16 * T + 4 * g;
#pragma unroll
                for (int r = 0; r < 4; ++r) { const int u = u0 + r; s[r] = (u <= uq[qt] && u >= uq[qt] - 128) ? s[r] * 0.125f : -INFINITY; }
            });
        }
    }
#pragma unroll
    for (int qt = 0; qt < 2; ++qt) {
        const float inv = 1.f / attn_ltot(l[qt]);
        const size_t tok = (size_t)b * SEQ + pbase + 16 * (16 * qt + c);
#pragma unroll
        for (int dt = 0; dt < 4; ++dt) {
            u32x2 ov = {pk2(o[qt][dt][0] * inv, o[qt][dt][1] * inv), pk2(o[qt][dt][2] * inv, o[qt][dt][3] * inv)};
            *(u32x2*)(O + tok * OW + O_DIL + hg * 64 + 16 * dt + 4 * g) = ov;
        }
    }
}

DEVI void nsa_item(const Params& p, char* smem, int blk) {
    char* sK = smem; char* sV = smem + ATT_SK; float* sImp = (float*)(smem + ATT_SK + ATT_SV);
    const u16* P = (const u16*)(p.ws + OFF_P); const u16* NQR = (const u16*)(p.ws + OFF_NQR);
    const u16* KC = (const u16*)(p.ws + OFF_KVC); const u16* VC = KC + (size_t)NB * 512 * 64;
    u16* OC = (u16*)(p.ws + OFF_OC); unsigned* SEL = (unsigned*)(p.ws + OFF_SEL);
    const float* FS = (const float*)(p.ws + OFF_FS); u16* O = (u16*)(p.ws + OFF_O);
    const int tid = threadIdx.x, lane = tid & 63, w = tid >> 6, g = lane >> 4, c = lane & 15;
    const int b = blk >> 7, s0 = (blk & 127) * 64;
    {
        const int sq = s0 + 16 * w + c;
        const size_t tok = (size_t)b * SEQ + sq;
        __syncthreads();
        for (int i = tid; i < 64 * 128; i += 256) sImp[i] = 0.f;
        const int ntile = ((s0 + 32) / 16) / 64 + 1;
        const int cmax = (sq - 31) >> 4;
#pragma unroll 1
        for (int h = 0; h < 4; ++h) {
            s16x8 qf[1][2];
            qf[0][0] = *(const s16x8*)(P + tok * PW + C_NQ + h * 64 + 8 * g); qf[0][1] = *(const s16x8*)(P + tok * PW + C_NQ + h * 64 + 32 + 8 * g);
            float m[1], l[1]; f32x4 o[1][4];
            attn_init<1>(m, l, o);
            for (int kt = 0; kt < ntile; ++kt) {
                __syncthreads();
                stage_kv_block(sK, sV, KC + ((size_t)b * 512 + kt * 64) * 64, VC + ((size_t)b * 512 + kt * 64) * 64, 64);
                __syncthreads();
                attn_tile64<1>(sK, sV, qf, m, l, o, lane, [&](int, int T, f32x4& s) {
                    const int c0 = kt * 64 + 16 * T + 4 * g;
#pragma unroll
                    for (int r = 0; r < 4; ++r) s[r] = (c0 + r <= cmax) ? s[r] * 0.125f : -INFINITY;
                });
            }
            const float lt = attn_ltot(l[0]);
            const float linv = lt > 0.f ? 1.f / lt : 0.f;
#pragma unroll
            for (int dt = 0; dt < 4; ++dt) {
                u32x2 ov = {pk2(o[0][dt][0] * linv, o[0][dt][1] * linv), pk2(o[0][dt][2] * linv, o[0][dt][3] * linv)};
                *(u32x2*)(OC + tok * 256 + h * 64 + 16 * dt + 4 * g) = ov;
            }
            float acur = 0.f;
            for (int kt = 0; kt < ntile; ++kt) {
                __syncthreads();
                stage_kv_block(sK, sV, KC + ((size_t)b * 512 + kt * 64) * 64, VC + ((size_t)b * 512 + kt * 64) * 64, 64);
                __syncthreads();
#pragma unroll
                for (int T = 0; T < 4; ++T) {
                    const int row = 16 * T + c;
                    const s16x8 k0 = *(const s16x8*)(sK + row * 128 + ((g ^ (row & 7)) << 4));
                    const s16x8 k1 = *(const s16x8*)(sK + row * 128 + (((4 + g) ^ (row & 7)) << 4));
                    f32x4 z = {0.f, 0.f, 0.f, 0.f}; z = mfma16(k0, qf[0][0], z); z = mfma16(k1, qf[0][1], z);
                    const int c0 = kt * 64 + 16 * T + 4 * g;
                    float pr[4];
#pragma unroll
                    for (int r = 0; r < 4; ++r) pr[r] = (c0 + r <= cmax) ? __expf(z[r] * 0.125f - m[0]) * linv : 0.f;
                    const float a = __shfl(pr[3], (lane + 48) & 63);
                    const float prev = g > 0 ? a : acur;
                    acur = a;
                    sImp[(16 * w + c) * 128 + 16 * kt + 4 * T + g] += pr[0] + pr[1] + pr[2] + pr[3] + prev;
                }
            }
        }
        __syncthreads();
        for (int tl = 0; tl < 16; ++tl) {
            const int sp = s0 + 16 * w + tl, cur = sp >> 6;
            unsigned k0, k1; bool sel0 = false, sel1 = false;
            {
                const int n0 = lane, n1 = lane + 64;
                float v0 = sImp[(16 * w + tl) * 128 + n0], v1 = sImp[(16 * w + tl) * 128 + n1];
                if (n0 == 0 || n0 == cur || n0 == cur - 1) v0 = 1e6f;
                if (n1 == cur || n1 == cur - 1) v1 = 1e6f;
                k0 = n0 <= cur ? (((__float_as_uint(v0) | 0x80000000u) & ~127u) | (unsigned)(127 - n0)) : 0u;
                k1 = n1 <= cur ? (((__float_as_uint(v1) | 0x80000000u) & ~127u) | (unsigned)(127 - n1)) : 0u;
            }
            if (cur < 16) { sel0 = k0 != 0u; sel1 = k1 != 0u; }
            else {
                for (int it = 0; it < 16; ++it) {
                    const unsigned km = wave_max_u32(k0 > k1 ? k0 : k1);
                    if (k0 == km) { sel0 = true; k0 = 0u; } else if (k1 == km) { sel1 = true; k1 = 0u; }
                }
            }
            const unsigned long long b0 = __ballot(sel0), b1 = __ballot(sel1);
            if (lane == 0) { u32x4 mk = {(unsigned)b0, (unsigned)(b0 >> 32), (unsigned)b1, (unsigned)(b1 >> 32)}; *(u32x4*)(SEL + ((size_t)b * SEQ + sp) * 4) = mk; }
        }
    }
    __syncthreads();
    const int h = w;
    for (int sub = 0; sub < 2; ++sub) {
        const int t0 = s0 + 32 * sub;
        s16x8 qf[2][2]; u32x4 msk[2];
#pragma unroll
        for (int qt = 0; qt < 2; ++qt) {
            const size_t tok = (size_t)b * SEQ + t0 + 16 * qt + c;
            qf[qt][0] = *(const s16x8*)(NQR + tok * 256 + h * 64 + 8 * g);
            qf[qt][1] = *(const s16x8*)(NQR + tok * 256 + h * 64 + 32 + 8 * g);
            msk[qt] = *(const u32x4*)(SEL + tok * 4);
        }
        float m[2], l[2]; f32x4 o[2][4]; attn_init<2>(m, l, o);
        int klo = t0 - 511; if (klo < 0) klo = 0; klo >>= 6;
        const int khi = (t0 + 31) >> 6;
        for (int kt = klo; kt <= khi; ++kt) {
            __syncthreads();
            const size_t kt0 = (size_t)b * SEQ + kt * 64;
            stage_kv_block(sK, sV, P + kt0 * PW + C_NKW, P + kt0 * PW + C_NVW, PW);
            __syncthreads();
            attn_tile64<2>(sK, sV, qf, m, l, o, lane, [&](int qt, int T, f32x4& s) {
                const int qpos = t0 + 16 * qt + c, k0 = kt * 64 + 16 * T + 4 * g;
#pragma unroll
                for (int r = 0; r < 4; ++r) s[r] = (k0 + r <= qpos && k0 + r > qpos - 512) ? s[r] * 0.125f : -INFINITY;
            });
        }
        f32x4 ow[2][4];
#pragma unroll
        for (int qt = 0; qt < 2; ++qt) {
            const float inv = 1.f / attn_ltot(l[qt]);
#pragma unroll
            for (int dt = 0; dt < 4; ++dt) ow[qt][dt] = o[qt][dt] * inv;
        }
        attn_init<2>(m, l, o);
        for (int n = 0; n <= khi; ++n) {
            const unsigned w0 = n < 32 ? msk[0][0] : (n < 64 ? msk[0][1] : (n < 96 ? msk[0][2] : msk[0][3]));
            const unsigned w1 = n < 32 ? msk[1][0] : (n < 64 ? msk[1][1] : (n < 96 ? msk[1][2] : msk[1][3]));
            const bool bit0 = (w0 >> (n & 31)) & 1u, bit1 = (w1 >> (n & 31)) & 1u;
            if (__ballot(bit0 || bit1) == 0ull) continue;
            __syncthreads();
            const size_t kt0 = (size_t)b * SEQ + n * 64;
            stage_kv_block(sK, sV, P + kt0 * PW + C_NKS, P + kt0 * PW + C_NVS, PW);
            __syncthreads();
            attn_tile64<2>(sK, sV, qf, m, l, o, lane, [&](int qt, int T, f32x4& s) {
                const int qpos = t0 + 16 * qt + c, k0 = n * 64 + 16 * T + 4 * g;
                const bool bit = qt == 0 ? bit0 : bit1;
#pragma unroll
                for (int r = 0; r < 4; ++r) s[r] = (bit && k0 + r <= qpos) ? s[r] * 0.125f : -INFINITY;
            });
        }
#pragma unroll
        for (int qt = 0; qt < 2; ++qt) {
            const float lt = attn_ltot(l[qt]); const float inv = lt > 0.f ? 1.f / lt : 0.f;
            const size_t tok = (size_t)b * SEQ + t0 + 16 * qt + c;
            const float g0 = sigmoidf_(FS[tok * 16 + 4 + h * 3 + 0]), g1 = sigmoidf_(FS[tok * 16 + 4 + h * 3 + 1]), g2 = sigmoidf_(FS[tok * 16 + 4 + h * 3 + 2]);
#pragma unroll
            for (int dt = 0; dt < 4; ++dt) {
                const u32x2 oc = *(const u32x2*)(OC + tok * 256 + h * 64 + 16 * dt + 4 * g);
                const float r0 = g0 * bflo(oc[0]) + g1 * o[qt][dt][0] * inv + g2 * ow[qt][dt][0];
                const float r1 = g0 * bfhi(oc[0]) + g1 * o[qt][dt][1] * inv + g2 * ow[qt][dt][1];
                const float r2 = g0 * bflo(oc[1]) + g1 * o[qt][dt][2] * inv + g2 * ow[qt][dt][2];
                const float r3 = g0 * bfhi(oc[1]) + g1 * o[qt][dt][3] * inv + g2 * ow[qt][dt][3];
                u32x2 ov = {pk2(r0, r1), pk2(r2, r3)};
                *(u32x2*)(O + tok * OW + O_NSA + h * 64 + 16 * dt + 4 * g) = ov;
            }
        }
    }
}

DEVI void ph_branches(const Params& p, int layer, char* smem, int bid, int nblk, unsigned* qctr) {
    int* sItem = (int*)(smem + 65536);
    for (;;) {
        __syncthreads();
        if (threadIdx.x == 0) *sItem = (int)__hip_atomic_fetch_add(qctr, 1u, __ATOMIC_RELAXED, __HIP_MEMORY_SCOPE_AGENT);
        __syncthreads();
        const int it = *sItem;
        if (it >= 64 * 24) break;
        const int lvl = it / 24, j = it % 24, qb = 63 - lvl;
        if (j < 16) fox_item(p, smem, qb, j);
        else { const int jj = j - 16, b = jj >> 1; nsa_item(p, smem, b * 128 + qb * 2 + (jj & 1)); }
    }
    for (int it = bid; it < 512; it += nblk) dil_item(p, smem, it);
    ph_lru<1>(p, layer, smem, bid, nblk);
}

DEVI void ph_merge(const Params& p, int layer, char* smem, int bid, int nblk) {
    const u16* H = (const u16*)(p.ws + OFF_H); const u16* O = (const u16*)(p.ws + OFF_O);
    const u16* Wg = (const u16*)(p.ws + OFF_WIN) + ((size_t)layer * WIN_ROWS + WIN_GATE0) * 1024;
    const u16* Wbr = (const u16*)(p.ws + OFF_WBR) + (size_t)layer * 1024 * OW;
    u16* MG = (u16*)(p.ws + OFF_MERGED);
    const int lane = threadIdx.x & 63, w = threadIdx.x >> 6, wm = w >> 1, wn = w & 1, g = lane >> 4, c = lane & 15;
    for (int t = bid; t < (NTOK / 128) * 16; t += nblk) {
        const int tm = t >> 4, tn = t & 15, m0 = tm * 128, n0 = tn * 64;
        f32x4 mg[4][2]; acc_zero(mg);
        f32x4 sg[4][2]; acc_zero(sg);
#pragma unroll 1
        for (int job = 0; job < 8; ++job) {
            const int br = job >> 1; const bool isy = job & 1;
            const int kb = br == 2 ? 128 : 256, oc = br == 0 ? O_FOX : (br == 1 ? O_LRU : (br == 2 ? O_DIL : O_NSA));
            const u16* Aj = isy ? O + oc : H; const size_t ldaj = isy ? (size_t)OW : (size_t)1024;
            const u16* Bj = isy ? Wbr + oc : Wg + (size_t)br * 1024 * 1024; const size_t ldbj = isy ? (size_t)OW : (size_t)1024;
            const int Kj = isy ? kb : 1024;
            f32x4 acc[4][2]; acc_zero(acc);
            gemm_mainloop<128, 64>(Aj, ldaj, 64, Bj, ldbj, Kj, m0, n0, smem, acc);
#pragma unroll
            for (int mt = 0; mt < 4; ++mt)
#pragma unroll
                for (int nt = 0; nt < 2; ++nt)
#pragma unroll
                    for (int r = 0; r < 4; ++r) {
                        if (isy) mg[mt][nt][r] += sg[mt][nt][r] * acc[mt][nt][r];
                        else sg[mt][nt][r] = sigmoidf_(acc[mt][nt][r]);
                    }
        }
#pragma unroll
        for (int mt = 0; mt < 4; ++mt)
#pragma unroll
            for (int nt = 0; nt < 2; ++nt) {
                const int m = m0 + wm * 64 + 16 * mt + c, n = n0 + wn * 32 + 16 * nt + 4 * g;
                u32x2 ov = {pk2(mg[mt][nt][0], mg[mt][nt][1]), pk2(mg[mt][nt][2], mg[mt][nt][3])};
                *(u32x2*)(MG + (size_t)m * 1024 + n) = ov;
            }
    }
}
DEVI void ph_wout(const Params& p, int layer, char* smem, int bid, int nblk) {
    const u16* MG = (const u16*)(p.ws + OFF_MERGED);
    const u16* Wt = (const u16*)(p.ws + OFF_WOUT) + (size_t)layer * 1024 * 1024;
    const float* xin = layer == 0 ? p.x : p.out;
    const int lane = threadIdx.x & 63, w = threadIdx.x >> 6, wm = w >> 1, wn = w & 1, g = lane >> 4, c = lane & 15;
    for (int t = bid; t < (NTOK / 128) * 8; t += nblk) {
        const int tm = t >> 3, tn = t & 7, m0 = tm * 128, n0 = tn * 128;
        f32x4 acc[4][4]; acc_zero(acc);
        gemm_mainloop<128, 128>(MG, 1024, 64, Wt, 1024, 1024, m0, n0, smem, acc);
#pragma unroll
        for (int mt = 0; mt < 4; ++mt)
#pragma unroll
            for (int nt = 0; nt < 4; ++nt) {
                const int m = m0 + wm * 64 + 16 * mt + c, n = n0 + wn * 64 + 16 * nt + 4 * g;
                const f32x4 xv = *(const f32x4*)(xin + (size_t)m * DM + n);
                *(f32x4*)(p.out + (size_t)m * DM + n) = xv + acc[mt][nt];
            }
    }
}
DEVI void ph_peerq(const Params& p, int layer, char* smem, int bid, int nblk) {
    const u16* H = (const u16*)(p.ws + OFF_H);
    const u16* Wt = (const u16*)(p.ws + OFF_WQ) + (size_t)layer * 2048 * 1024;
    u16* QP = (u16*)(p.ws + OFF_QP);
    const int lane = threadIdx.x & 63, w = threadIdx.x >> 6, wm = w >> 1, wn = w & 1, g = lane >> 4, c = lane & 15;
    for (int t = bid; t < (NTOK / 128) * 16; t += nblk) {
        const int tm = t >> 4, tn = t & 15, m0 = tm * 128, n0 = tn * 128;
        f32x4 acc[4][4]; acc_zero(acc);
        gemm_mainloop<128, 128>(H, 1024, 64, Wt, 1024, 1024, m0, n0, smem, acc);
#pragma unroll
        for (int mt = 0; mt < 4; ++mt)
#pragma unroll
            for (int nt = 0; nt < 4; ++nt) {
                const int m = m0 + wm * 64 + 16 * mt + c, n = n0 + wn * 64 + 16 * nt + 4 * g;
                u32x2 ov = {pk2(acc[mt][nt][0], acc[mt][nt][1]), pk2(acc[mt][nt][2], acc[mt][nt][3])};
                *(u32x2*)(QP + (size_t)m * 2048 + n) = ov;
            }
    }
}
template <int N> DEVI void bitonic_sort_desc(unsigned (&k)[N]) {
#pragma unroll
    for (int sz = 2; sz <= N; sz <<= 1)
#pragma unroll
        for (int st = sz >> 1; st > 0; st >>= 1)
#pragma unroll
            for (int i = 0; i < N; ++i) {
                const int j = i ^ st;
                if (j > i) {
                    const bool desc = (i & sz) == 0;
                    const unsigned a = k[i], b = k[j], hi = a > b ? a : b, lo = a > b ? b : a;
                    k[i] = desc ? hi : lo; k[j] = desc ? lo : hi;
                }
            }
}
template <int N> DEVI void bitonic_merge_desc(unsigned (&k)[N]) {
#pragma unroll
    for (int st = N >> 1; st > 0; st >>= 1)
#pragma unroll
        for (int i = 0; i < N; ++i) {
            const int j = i ^ st;
            if (j > i) { const unsigned a = k[i], b = k[j]; k[i] = a > b ? a : b; k[j] = a > b ? b : a; }
        }
}
DEVI void merge_top16_xor(unsigned (&k)[16], int x) {
    unsigned t[16];
#pragma unroll
    for (int i = 0; i < 16; ++i) { const unsigned o = (unsigned)__shfl_xor((int)k[15 - i], x); t[i] = k[i] > o ? k[i] : o; }
    bitonic_merge_desc<16>(t);
#pragma unroll
    for (int i = 0; i < 16; ++i) k[i] = t[i];
}
DEVI unsigned f2ord(float f) { unsigned u = __float_as_uint(f); return u ^ ((u >> 31) ? 0xffffffffu : 0x80000000u); }
DEVI float ord2f(unsigned u) { return __uint_as_float(u ^ ((u >> 31) ? 0x80000000u : 0xffffffffu)); }

struct PairTab { unsigned char i[64], j[64]; };
__host__ __device__ constexpr PairTab make_pairs() {
    PairTab t{};
    int n = 0;
    for (int i = 0; i < 16; ++i) for (int j = 0; j < 16; ++j) if ((i + 1) * (j + 1) <= 16) { t.i[n] = (unsigned char)i; t.j[n] = (unsigned char)j; ++n; }
    for (; n < 64; ++n) { t.i[n] = 255; t.j[n] = 255; }
    return t;
}
constexpr PairTab kPairs = make_pairs();

DEVI void ph_peertop(const Params& p, int layer, char* smem, int bid, int nblk) {
    unsigned char (*sIdx)[16][2][16] = (unsigned char (*)[16][2][16])smem;
    const u16* QP = (const u16*)(p.ws + OFF_QP);
    const u16* SK = (const u16*)(p.ws + OFF_SUBK) + (size_t)layer * 2 * 128 * 128;
    int* PIDX = (int*)(p.ws + OFF_PIDX); float* PGW = (float*)(p.ws + OFF_PGW);
    const int tid = threadIdx.x, lane = tid & 63, w = tid >> 6, g = lane >> 4, c = lane & 15;
    for (int item = bid * 4 + w; item < (NTOK / 16) * 8; item += nblk * 4) {
        const int hd = item & 7, t0 = (item >> 3) * 16;
        const size_t tok = (size_t)t0 + c;
        unsigned top[2][16];
#pragma unroll
        for (int pp = 0; pp < 2; ++pp) {
            s16x8 qf[4];
#pragma unroll
            for (int ks = 0; ks < 4; ++ks) qf[ks] = *(const s16x8*)(QP + tok * 2048 + hd * 256 + pp * 128 + 32 * ks + 8 * g);
            unsigned key[32];
#pragma unroll
            for (int T = 0; T < 8; ++T) {
                f32x4 z = {0.f, 0.f, 0.f, 0.f};
#pragma unroll
                for (int ks = 0; ks < 4; ++ks) {
                    const s16x8 kf = *(const s16x8*)(SK + ((size_t)pp * 128 + 16 * T + c) * 128 + 32 * ks + 8 * g);
                    z = mfma16(kf, qf[ks], z);
                }
#pragma unroll
                for (int r = 0; r < 4; ++r) { const int n = 16 * T + 4 * g + r; key[4 * T + r] = (f2ord(z[r]) & ~127u) | (unsigned)(127 - n); }
            }
            bitonic_sort_desc<32>(key);
#pragma unroll
            for (int i = 0; i < 16; ++i) top[pp][i] = key[i];
            merge_top16_xor(top[pp], 16);
            merge_top16_xor(top[pp], 32);
#pragma unroll
            for (int i = 0; i < 16; ++i) if ((i >> 2) == g) sIdx[w][c][pp][i] = (unsigned char)(127 - (top[pp][i] & 127u));
        }
        float v0[16], v1[16];
#pragma unroll
        for (int i = 0; i < 16; ++i) { v0[i] = ord2f(top[0][i] & ~127u); v1[i] = ord2f(top[1][i] & ~127u); }
        unsigned ck[16];
#pragma unroll
        for (int e = 0; e < 16; ++e) {
            unsigned kk[4];
#pragma unroll
            for (int gg = 0; gg < 4; ++gg) {
                const int pi = kPairs.i[gg * 16 + e], pj = kPairs.j[gg * 16 + e];
                kk[gg] = pi < 16 ? ((f2ord(v0[pi < 16 ? pi : 0] + v1[pj < 16 ? pj : 0]) & ~255u) | (unsigned)(255 - (pi * 16 + pj))) : 0u;
            }
            ck[e] = g == 0 ? kk[0] : (g == 1 ? kk[1] : (g == 2 ? kk[2] : kk[3]));
        }
        bitonic_sort_desc<16>(ck);
        merge_top16_xor(ck, 16);
        merge_top16_xor(ck, 32);
        const float smax = ord2f(ck[0] & ~255u);
        float ex[16], den = 0.f;
#pragma unroll
        for (int i = 0; i < 16; ++i) { ex[i] = __expf(ord2f(ck[i] & ~255u) - smax); den += ex[i]; }
        const float rden = 1.f / den;
        int eidx[4]; float egw[4];
#pragma unroll
        for (int r = 0; r < 4; ++r) {
            const unsigned kq = g == 0 ? ck[r] : (g == 1 ? ck[4 + r] : (g == 2 ? ck[8 + r] : ck[12 + r]));
            const float eq = g == 0 ? ex[r] : (g == 1 ? ex[4 + r] : (g == 2 ? ex[8 + r] : ex[12 + r]));
            const int flat = 255 - (int)(kq & 255u), pi = flat >> 4, pj = flat & 15;
            eidx[r] = (int)sIdx[w][c][0][pi] * 128 + (int)sIdx[w][c][1][pj];
            egw[r] = eq * rden;
        }
        *(int4*)(PIDX + tok * 128 + hd * 16 + 4 * g) = make_int4(eidx[0], eidx[1], eidx[2], eidx[3]);
        *(f32x4*)(PGW + tok * 128 + hd * 16 + 4 * g) = (f32x4){egw[0], egw[1], egw[2], egw[3]};
    }
}

DEVI void ph_peergather(const Params& p, const float* __restrict__ g2, char* smem, int bid, int nblk) {
    u16 (*sh2)[1024] = (u16 (*)[1024])smem;
    const u16* PU = (const u16*)(p.ws + OFF_PUV); const u16* PV = PU + (size_t)NEXP * 1024;
    const int* PIDX = (const int*)(p.ws + OFF_PIDX); const float* PGW = (const float*)(p.ws + OFF_PGW);
    const int tid = threadIdx.x, lane = tid & 63, w = tid >> 6, g = lane >> 4, c = lane & 15;
    for (int tok = bid * 4 + w; tok < NTOK; tok += nblk * 4) {
        float* xr = p.out + (size_t)tok * DM;
        f32x4 xv[4]; float ss = 0.f;
#pragma unroll
        for (int i = 0; i < 4; ++i) { xv[i] = *(const f32x4*)(xr + i * 256 + lane * 4); ss += xv[i][0] * xv[i][0] + xv[i][1] * xv[i][1] + xv[i][2] * xv[i][2] + xv[i][3] * xv[i][3]; }
        ss = wave_sum(ss);
        const float rs = rsqrtf(ss * (1.0f / DM) + 1e-6f);
#pragma unroll
        for (int i = 0; i < 4; ++i) {
            const f32x4 gg = *(const f32x4*)(g2 + i * 256 + lane * 4);
            u32x2 hv = {pk2(xv[i][0] * rs * gg[0], xv[i][1] * rs * gg[1]), pk2(xv[i][2] * rs * gg[2], xv[i][3] * rs * gg[3])};
            *(u32x2*)(&sh2[w][i * 256 + lane * 4]) = hv;
        }
        float acc[16];
#pragma unroll
        for (int i = 0; i < 16; ++i) acc[i] = 0.f;
        for (int hd = 0; hd < 8; ++hd) {
            const int myidx = PIDX[(size_t)tok * 128 + hd * 16 + c];
            const float mygw = PGW[(size_t)tok * 128 + hd * 16 + c];
            const u16* urow = PU + (size_t)myidx * 1024 + 256 * g;
            f32x4 z = {0.f, 0.f, 0.f, 0.f};
#pragma unroll 8
            for (int s = 0; s < 32; ++s) {
                const s16x8 a = *(const s16x8*)(urow + 8 * s);
                const s16x8 bq = *(const s16x8*)(&sh2[w][256 * g + 8 * s]);
                z = mfma16(a, bq, z);
            }
#pragma unroll
            for (int e = 0; e < 16; ++e) {
                const float ze = __shfl(z[e & 3], 16 * (e >> 2));
                const float wgt = __shfl(mygw, e) * gelu_tanh(ze);
                const int ei = __shfl(myidx, e);
                const u16* vrow = PV + (size_t)ei * 1024;
                const u32x4 va = *(const u32x4*)(vrow + lane * 8);
                const u32x4 vb = *(const u32x4*)(vrow + 512 + lane * 8);
#pragma unroll
                for (int q = 0; q < 4; ++q) { acc[2 * q] += wgt * bflo(va[q]); acc[2 * q + 1] += wgt * bfhi(va[q]); acc[8 + 2 * q] += wgt * bflo(vb[q]); acc[8 + 2 * q + 1] += wgt * bfhi(vb[q]); }
            }
        }
#pragma unroll
        for (int hlf = 0; hlf < 2; ++hlf)
#pragma unroll
            for (int q = 0; q < 2; ++q) {
                float* d = xr + hlf * 512 + lane * 8 + q * 4;
                f32x4 v = *(const f32x4*)d;
                v[0] += acc[hlf * 8 + q * 4 + 0]; v[1] += acc[hlf * 8 + q * 4 + 1]; v[2] += acc[hlf * 8 + q * 4 + 2]; v[3] += acc[hlf * 8 + q * 4 + 3];
                *(f32x4*)d = v;
            }
    }
}


template <int l>
DEVI void layer_body(const Params& p, char* smem, int bid, int nblk, unsigned* ctrl, unsigned& epoch) {
    char* ws = p.ws;
        ph_proj(p, l, smem, bid, nblk);
        grid_bar(ctrl, nblk, epoch);
        ph_rope(p, bid, nblk);
        ph_foxcum(p, l, smem, (bid + nblk - 64) % nblk, nblk);
        ph_cmp(p, l, smem, (bid + nblk - 128) % nblk, nblk);
        ph_lru<0>(p, l, smem, bid, nblk);
        grid_bar(ctrl, nblk, epoch);
        ph_branches(p, l, smem, bid, nblk, ctrl + 8 + l);
        grid_bar(ctrl, nblk, epoch);
        ph_merge(p, l, smem, bid, nblk);
        grid_bar(ctrl, nblk, epoch);
        ph_wout(p, l, smem, bid, nblk);
        grid_bar(ctrl, nblk, epoch);
        ph_rmsnorm<false>(p.out, p.norm2_g + l * 1024, (u16*)(ws + OFF_H), nullptr, bid, nblk);
        grid_bar(ctrl, nblk, epoch);
        ph_peerq(p, l, smem, bid, nblk);
        grid_bar(ctrl, nblk, epoch);
        ph_peertop(p, l, smem, bid, nblk);
        grid_bar(ctrl, nblk, epoch);
        ph_peergather(p, p.norm2_g + l * 1024, smem, bid, nblk);
        grid_bar(ctrl, nblk, epoch);
        if (l + 1 < NLAYER) {
            ph_cvt(p.peer_u + (size_t)(l + 1) * NEXP * 1024, (u16*)(ws + OFF_PUV), (size_t)NEXP * 1024 / 4, bid, nblk);
            ph_cvt(p.peer_v + (size_t)(l + 1) * NEXP * 1024, (u16*)(ws + OFF_PUV) + (size_t)NEXP * 1024, (size_t)NEXP * 1024 / 4, bid, nblk);
            ph_rmsnorm<false>(p.out, p.norm1_g + (l + 1) * 1024, (u16*)(ws + OFF_H), nullptr, bid, nblk);
            grid_bar(ctrl, nblk, epoch);
        }
    }

__global__ void __launch_bounds__(256) mega(Params p) {
    extern __shared__ __attribute__((aligned(16))) char smem[];
    cg::grid_group grid = cg::this_grid();
    const int bid = blockIdx.x, nblk = gridDim.x;
    unsigned* ctrl = (unsigned*)(p.ws + OFF_CTRL);
    unsigned epoch = 0;
    char* ws = p.ws;
    ph_tconv(p, smem, bid, nblk);
    ph_cvt(p.peer_sub_keys, (u16*)(ws + OFF_SUBK), (size_t)NLAYER * 2 * 128 * 128 / 4, bid, nblk);
    ph_misc(p, bid, nblk);
    ph_cvt(p.peer_u, (u16*)(ws + OFF_PUV), (size_t)NEXP * 1024 / 4, bid, nblk);
    ph_cvt(p.peer_v, (u16*)(ws + OFF_PUV) + (size_t)NEXP * 1024, (size_t)NEXP * 1024 / 4, bid, nblk);
    ph_rmsnorm<false>(p.x, p.norm1_g, (u16*)(ws + OFF_H), nullptr, bid, nblk);
    grid.sync();
    layer_body<0>(p, smem, bid, nblk, ctrl, epoch);
    layer_body<1>(p, smem, bid, nblk, ctrl, epoch);
    ph_rmsnorm<true>(p.out, p.final_g, nullptr, p.out, bid, nblk);
}

extern "C" void kernel_launch(void* const* d_in, const int* in_sizes, int n_in, void* d_out, int out_size, void* d_ws, size_t ws_size, hipStream_t stream) {
    (void)in_sizes; (void)n_in; (void)out_size;
    if (ws_size < WS_NEED) { fprintf(stderr, "workspace too small: %zu < %zu\n", ws_size, (size_t)WS_NEED); return; }
    Params p{};
    p.x = (const float*)d_in[0]; p.norm1_g = (const float*)d_in[1]; p.w_in = (const float*)d_in[2]; p.fox_b_f = (const float*)d_in[3];
    p.lru_conv_w = (const float*)d_in[4]; p.lru_conv_b = (const float*)d_in[5]; p.lru_w_a = (const float*)d_in[6]; p.lru_b_a = (const float*)d_in[7];
    p.lru_w_x = (const float*)d_in[8]; p.lru_b_x = (const float*)d_in[9]; p.lru_lambda = (const float*)d_in[10];
    p.nsa_pe_k = (const float*)d_in[11]; p.nsa_pe_v = (const float*)d_in[12]; p.nsa_w1_k = (const float*)d_in[13]; p.nsa_w2_k = (const float*)d_in[14];
    p.nsa_w1_v = (const float*)d_in[15]; p.nsa_w2_v = (const float*)d_in[16];
    p.w_br_fox = (const float*)d_in[17]; p.w_br_lru = (const float*)d_in[18]; p.w_br_dil = (const float*)d_in[19]; p.w_br_nsa = (const float*)d_in[20];
    p.w_out = (const float*)d_in[21]; p.norm2_g = (const float*)d_in[22]; p.peer_w_q = (const float*)d_in[23]; p.peer_sub_keys = (const float*)d_in[24];
    p.peer_u = (const float*)d_in[25]; p.peer_v = (const float*)d_in[26]; p.final_g = (const float*)d_in[27];
    p.out = (float*)d_out; p.ws = (char*)d_ws;
    static int grid_blocks = 0;
    if (!grid_blocks) {
        int dev = 0, cus = 0, per_cu = 0;
        hipGetDevice(&dev);
        hipDeviceGetAttribute(&cus, hipDeviceAttributeMultiprocessorCount, dev);
        hipFuncSetAttribute((const void*)mega, hipFuncAttributeMaxDynamicSharedMemorySize, SMEM_BYTES);
        hipOccupancyMaxActiveBlocksPerMultiprocessor(&per_cu, mega, 256, SMEM_BYTES);
        if (per_cu > 2) per_cu = 2;
        if (per_cu < 1) per_cu = 1;
        grid_blocks = cus * per_cu;
    }
    hipMemsetAsync((char*)d_ws + OFF_CTRL, 0, 256, stream);
    void* args[] = {&p};
    hipError_t e = hipLaunchCooperativeKernel((void*)mega, dim3(grid_blocks), dim3(256), args, SMEM_BYTES, stream);
    if (e != hipSuccess) fprintf(stderr, "cooperative launch failed: %s (grid %d)\n", hipGetErrorString(e), grid_blocks);
}
```

```cpp
#include <hip/hip_runtime.h>
#include <cstdio>
#include <cstdint>
#include <hip/hip_cooperative_groups.h>
namespace cg = cooperative_groups;

typedef unsigned short u16;
typedef short s16x8 __attribute__((ext_vector_type(8)));
typedef short s16x4 __attribute__((ext_vector_type(4)));
typedef float f32x4 __attribute__((ext_vector_type(4)));
typedef float f32x2 __attribute__((ext_vector_type(2)));
typedef unsigned u32x4 __attribute__((ext_vector_type(4)));
typedef unsigned u32x2 __attribute__((ext_vector_type(2)));
typedef __bf16 bf16x2_t __attribute__((ext_vector_type(2)));
#define LAS __attribute__((address_space(3)))
#define DEVI __device__ __forceinline__

constexpr int NB = 4, SEQ = 8192, DM = 1024, NTOK = NB * SEQ, NLAYER = 2;
constexpr int PW = 3072;
constexpr int C_FQ = 0, C_FK = 256, C_FV = 512, C_LX = 768, C_LG = 1024, C_DQ = 1280, C_DK = 1664, C_DV = 2048,
              C_NQ = 2432, C_NKC = 2688, C_NVC = 2752, C_NKS = 2816, C_NVS = 2880, C_NKW = 2944, C_NVW = 3008;
constexpr int WIN_ROWS = 7296;
constexpr int WIN_GATE0 = 3200;
constexpr int IN_WIDTH = 7184;
constexpr int OW = 896;
constexpr int O_FOX = 0, O_LRU = 256, O_DIL = 512, O_NSA = 640;
constexpr int NEXP = 16384;

constexpr size_t SZ_WIN = (size_t)NLAYER * WIN_ROWS * 1024 * 2;
constexpr size_t SZ_WQ = (size_t)NLAYER * 2048 * 1024 * 2;
constexpr size_t SZ_WOUT = (size_t)NLAYER * 1024 * 1024 * 2;
constexpr size_t SZ_WBR = (size_t)NLAYER * 1024 * OW * 2;
constexpr size_t SZ_W1 = (size_t)NLAYER * 2 * 256 * 2048 * 2;
constexpr size_t SZ_W2 = (size_t)NLAYER * 2 * 64 * 256 * 2;
constexpr size_t SZ_B1 = (size_t)NLAYER * 2 * 256 * 4;
constexpr size_t SZ_SUBK = (size_t)NLAYER * 2 * 128 * 128 * 2;
constexpr size_t SZ_ROPE = (size_t)SEQ * 32 * 8;
constexpr size_t SZ_PUV = (size_t)2 * NEXP * 1024 * 2;
constexpr size_t SZ_H = (size_t)NTOK * 1024 * 2;
constexpr size_t SZ_P = (size_t)NTOK * PW * 2;
constexpr size_t SZ_FS = (size_t)NTOK * 16 * 4;
constexpr size_t SZ_NQR = (size_t)NTOK * 256 * 2;
constexpr size_t SZ_CUM = (size_t)NTOK * 4 * 4;
constexpr size_t SZ_LSUM = (size_t)2 * 512 * 256 * 4;
constexpr size_t SZ_HID = (size_t)2 * 2048 * 256 * 2;
constexpr size_t SZ_KVC = (size_t)2 * NB * 512 * 64 * 2;
constexpr size_t SZ_O = (size_t)NTOK * OW * 2;
constexpr size_t SZ_OC = (size_t)NTOK * 256 * 2;
constexpr size_t SZ_SEL = (size_t)NTOK * 4 * 4;

constexpr size_t OFF_WIN = 0;
constexpr size_t OFF_WQ = OFF_WIN + SZ_WIN;
constexpr size_t OFF_WOUT = OFF_WQ + SZ_WQ;
constexpr size_t OFF_WBR = OFF_WOUT + SZ_WOUT;
constexpr size_t OFF_W1 = OFF_WBR + SZ_WBR;
constexpr size_t OFF_W2 = OFF_W1 + SZ_W1;
constexpr size_t OFF_B1 = OFF_W2 + SZ_W2;
constexpr size_t OFF_SUBK = OFF_B1 + SZ_B1;
constexpr size_t OFF_ROPE = OFF_SUBK + SZ_SUBK;
constexpr size_t OFF_PUV = OFF_ROPE + SZ_ROPE;
constexpr size_t OFF_H = OFF_PUV + SZ_PUV;
constexpr size_t OFF_P = OFF_H + SZ_H;
constexpr size_t OFF_FS = OFF_P + SZ_P;
constexpr size_t OFF_NQR = OFF_FS + SZ_FS;
constexpr size_t OFF_CUM = OFF_NQR + SZ_NQR;
constexpr size_t OFF_LSUM = OFF_CUM + SZ_CUM;
constexpr size_t OFF_HID = OFF_LSUM + SZ_LSUM;
constexpr size_t OFF_KVC = OFF_HID + SZ_HID;
constexpr size_t OFF_O = OFF_KVC + SZ_KVC;
constexpr size_t OFF_OC = OFF_O + SZ_O;
constexpr size_t OFF_SEL = OFF_OC + SZ_OC;
constexpr size_t OFF_CTRL = OFF_SEL + SZ_SEL;
constexpr size_t WS_NEED = OFF_CTRL + 256;
static_assert(WS_NEED <= (size_t)512 * 1024 * 1024, "workspace over 512 MiB");
constexpr size_t OFF_MERGED = OFF_P;
constexpr size_t OFF_QP = OFF_P + (size_t)NTOK * 1024 * 2;
static_assert(OFF_QP + (size_t)NTOK * 2048 * 2 <= OFF_P + SZ_P, "alias");
constexpr size_t OFF_PIDX = OFF_H;
constexpr size_t OFF_PGW = OFF_H + (size_t)NTOK * 128 * 4;
static_assert(OFF_PGW + (size_t)NTOK * 128 * 4 <= OFF_H + SZ_H, "alias");

struct Params {
    const float* x; const float* norm1_g; const float* w_in; const float* fox_b_f;
    const float* lru_conv_w; const float* lru_conv_b; const float* lru_w_a; const float* lru_b_a;
    const float* lru_w_x; const float* lru_b_x; const float* lru_lambda;
    const float* nsa_pe_k; const float* nsa_pe_v; const float* nsa_w1_k; const float* nsa_w2_k;
    const float* nsa_w1_v; const float* nsa_w2_v;
    const float* w_br_fox; const float* w_br_lru; const float* w_br_dil; const float* w_br_nsa;
    const float* w_out; const float* norm2_g; const float* peer_w_q; const float* peer_sub_keys;
    const float* peer_u; const float* peer_v; const float* final_g;
    float* out; char* ws;
};

typedef const __attribute__((address_space(4))) Params* KP;
DEVI KP kp_get() { unsigned long long a = (unsigned long long)__builtin_amdgcn_kernarg_segment_ptr(); asm volatile("" : "+s"(a)); return (KP)a; }
DEVI Params kp_load(KP k) { Params r;
    r.x = k->x;
    r.norm1_g = k->norm1_g;
    r.w_in = k->w_in;
    r.fox_b_f = k->fox_b_f;
    r.lru_conv_w = k->lru_conv_w;
    r.lru_conv_b = k->lru_conv_b;
    r.lru_w_a = k->lru_w_a;
    r.lru_b_a = k->lru_b_a;
    r.lru_w_x = k->lru_w_x;
    r.lru_b_x = k->lru_b_x;
    r.lru_lambda = k->lru_lambda;
    r.nsa_pe_k = k->nsa_pe_k;
    r.nsa_pe_v = k->nsa_pe_v;
    r.nsa_w1_k = k->nsa_w1_k;
    r.nsa_w2_k = k->nsa_w2_k;
    r.nsa_w1_v = k->nsa_w1_v;
    r.nsa_w2_v = k->nsa_w2_v;
    r.w_br_fox = k->w_br_fox;
    r.w_br_lru = k->w_br_lru;
    r.w_br_dil = k->w_br_dil;
    r.w_br_nsa = k->w_br_nsa;
    r.w_out = k->w_out;
    r.norm2_g = k->norm2_g;
    r.peer_w_q = k->peer_w_q;
    r.peer_sub_keys = k->peer_sub_keys;
    r.peer_u = k->peer_u;
    r.peer_v = k->peer_v;
    r.final_g = k->final_g;
    r.out = k->out;
    r.ws = k->ws;
    return r; }
DEVI int tid_opaque() { int t = threadIdx.x; asm volatile("" : "+v"(t)); return t; }
DEVI unsigned pk2(float a, float b) { f32x2 v = {a, b}; bf16x2_t r = __builtin_convertvector(v, bf16x2_t); return __builtin_bit_cast(unsigned, r); }
DEVI u16 f2bf(float a) { return (u16)(pk2(a, 0.f) & 0xffffu); }
DEVI float bf2f(u16 h) { return __uint_as_float(((unsigned)h) << 16); }
DEVI float bflo(unsigned w) { return __uint_as_float(w << 16); }
DEVI float bfhi(unsigned w) { return __uint_as_float(w & 0xffff0000u); }
DEVI float sigmoidf_(float x) { return 1.f / (1.f + __expf(-x)); }
DEVI float gelu_tanh(float x) { float u = 0.7978845608028654f * (x + 0.044715f * x * x * x); return x / (1.f + __expf(-2.f * u)); }
DEVI f32x4 mfma16(s16x8 a, s16x8 b, f32x4 c) { return __builtin_amdgcn_mfma_f32_16x16x32_bf16(a, b, c, 0, 0, 0); }
DEVI float wave_sum(float v) {
#pragma unroll
    for (int o = 32; o > 0; o >>= 1) v += __shfl_xor(v, o);
    return v;
}
DEVI unsigned wave_max_u32(unsigned v) {
#pragma unroll
    for (int o = 32; o > 0; o >>= 1) { unsigned t = (unsigned)__shfl_xor((int)v, o); v = v > t ? v : t; }
    return v;
}

template <int BM, int BN>
DEVI void gemm_mainloop(const u16* __restrict__ A, size_t lda, size_t a_kstride, const u16* __restrict__ Bt, size_t ldb, int K,
                        int m0, int n0, char* smem, f32x4 (&acc)[BM / 32][BN / 32]) {
    constexpr int MT = BM / 32, NT = BN / 32, ACH = BM * 8 / 256, BCH = BN * 8 / 256;
    constexpr int A_BYTES = BM * 128, STAGE = (BM + BN) * 128;
    const int tid = tid_opaque(), lane = tid & 63, w = tid >> 6, wm = w >> 1, wn = w & 1, g = lane >> 4, c = lane & 15;
    u32x4 ra[ACH], rb[BCH];
    const int nk = K / 64;
#pragma unroll
    for (int i = 0; i < ACH; ++i) { int ch = tid + 256 * i, row = ch >> 3, cc = ch & 7; ra[i] = *(const u32x4*)(A + (size_t)(m0 + row) * lda + cc * 8); }
#pragma unroll
    for (int i = 0; i < BCH; ++i) { int ch = tid + 256 * i, row = ch >> 3, cc = ch & 7; rb[i] = *(const u32x4*)(Bt + (size_t)(n0 + row) * ldb + cc * 8); }
#pragma unroll
    for (int i = 0; i < ACH; ++i) { int ch = tid + 256 * i, row = ch >> 3, cc = ch & 7; *(u32x4*)(smem + row * 128 + ((cc ^ (row & 7)) << 4)) = ra[i]; }
#pragma unroll
    for (int i = 0; i < BCH; ++i) { int ch = tid + 256 * i, row = ch >> 3, cc = ch & 7; *(u32x4*)(smem + A_BYTES + row * 128 + ((cc ^ (row & 7)) << 4)) = rb[i]; }
    __syncthreads();
    for (int kt = 0; kt < nk; ++kt) {
        const bool more = kt + 1 < nk;
        if (more) {
#pragma unroll
            for (int i = 0; i < ACH; ++i) { int ch = tid + 256 * i, row = ch >> 3, cc = ch & 7; ra[i] = *(const u32x4*)(A + (size_t)(m0 + row) * lda + (size_t)(kt + 1) * a_kstride + cc * 8); }
#pragma unroll
            for (int i = 0; i < BCH; ++i) { int ch = tid + 256 * i, row = ch >> 3, cc = ch & 7; rb[i] = *(const u32x4*)(Bt + (size_t)(n0 + row) * ldb + (size_t)(kt + 1) * 64 + cc * 8); }
        }
        const char* sA = smem + (kt & 1) * STAGE; const char* sB = sA + A_BYTES;
#pragma unroll
        for (int ks = 0; ks < 2; ++ks) {
            s16x8 af[MT], bfr[NT];
#pragma unroll
            for (int mt = 0; mt < MT; ++mt) { int row = wm * (BM / 2) + 16 * mt + c; af[mt] = *(const s16x8*)(sA + row * 128 + (((4 * ks + g) ^ (row & 7)) << 4)); }
#pragma unroll
            for (int nt = 0; nt < NT; ++nt) { int row = wn * (BN / 2) + 16 * nt + c; bfr[nt] = *(const s16x8*)(sB + row * 128 + (((4 * ks + g) ^ (row & 7)) << 4)); }
#pragma unroll
            for (int mt = 0; mt < MT; ++mt)
#pragma unroll
                for (int nt = 0; nt < NT; ++nt) acc[mt][nt] = mfma16(bfr[nt], af[mt], acc[mt][nt]);
        }
        if (more) {
            char* dA = smem + ((kt + 1) & 1) * STAGE; char* dB = dA + A_BYTES;
#pragma unroll
            for (int i = 0; i < ACH; ++i) { int ch = tid + 256 * i, row = ch >> 3, cc = ch & 7; *(u32x4*)(dA + row * 128 + ((cc ^ (row & 7)) << 4)) = ra[i]; }
#pragma unroll
            for (int i = 0; i < BCH; ++i) { int ch = tid + 256 * i, row = ch >> 3, cc = ch & 7; *(u32x4*)(dB + row * 128 + ((cc ^ (row & 7)) << 4)) = rb[i]; }
        }
        __syncthreads();
    }
}
template <int MT, int NT> DEVI void acc_zero(f32x4 (&acc)[MT][NT]) {
#pragma unroll
    for (int i = 0; i < MT; ++i)
#pragma unroll
        for (int j = 0; j < NT; ++j) acc[i][j] = (f32x4){0.f, 0.f, 0.f, 0.f};
}
constexpr int SMEM_BYTES = 69632;

DEVI void grid_bar(unsigned* bar, unsigned nblk, unsigned& epoch) {
    __syncthreads();
    epoch += 1;
    if (threadIdx.x == 0) {
        __builtin_amdgcn_fence(__ATOMIC_RELEASE, "agent");
        asm volatile("s_waitcnt vmcnt(0)" ::: "memory");
        __hip_atomic_fetch_add(bar, 1u, __ATOMIC_RELAXED, __HIP_MEMORY_SCOPE_AGENT);
        const unsigned target = epoch * nblk;
        unsigned spins = 0;
        while (__hip_atomic_load(bar, __ATOMIC_RELAXED, __HIP_MEMORY_SCOPE_AGENT) < target && spins < (1u << 26)) { __builtin_amdgcn_s_sleep(2); ++spins; }
        __builtin_amdgcn_fence(__ATOMIC_ACQUIRE, "agent");
        asm volatile("s_waitcnt vmcnt(0)" ::: "memory");
    }
    __syncthreads();
}

DEVI int win_map(int n) {
    if (n < 768) return n;
    if (n < 3072) return n + 4;
    if (n < 3076) return 768 + (n - 3072);
    if (n < 3088) return n;
    if (n < WIN_GATE0) return -1;
    return n - (WIN_GATE0 - 3088);
}
DEVI void tconv_tile(const float* __restrict__ src, int src_ld, int K, u16* __restrict__ dst, int dst_ld, int ndst, int mode, int tidx, char* smem) {
    float (*tile)[65] = (float (*)[65])smem;
    const int tiles_n = ndst / 64;
    const int kt = tidx / tiles_n, nt = tidx % tiles_n;
    const int tx = threadIdx.x & 63, ty = threadIdx.x >> 6;
    const int n = nt * 64 + tx;
    const int sc = mode == 1 ? win_map(n) : n;
    __syncthreads();
#pragma unroll
    for (int i = 0; i < 16; ++i) { int k = kt * 64 + ty * 16 + i; tile[ty * 16 + i][tx] = sc >= 0 ? src[(size_t)k * src_ld + sc] : 0.f; }
    __syncthreads();
#pragma unroll
    for (int i = 0; i < 16; ++i) { int nn = ty * 16 + i; dst[(size_t)(nt * 64 + nn) * dst_ld + kt * 64 + tx] = f2bf(tile[tx][nn]); }
}
constexpr int TC_WIN = 16 * (WIN_ROWS / 64), TC_WQ = 16 * 32, TC_WOUT = 16 * 16, TC_BR4 = 4 * 16, TC_BR2 = 2 * 16, TC_W1 = 32 * 4, TC_W2 = 4;
constexpr int TC_LAYER = TC_WIN + TC_WQ + TC_WOUT + 3 * TC_BR4 + TC_BR2 + 2 * TC_W1 + 2 * TC_W2;
DEVI void ph_tconv(const Params& p, char* smem, int bid, int nblk) {
    char* ws = p.ws;
    for (int it = bid; it < NLAYER * TC_LAYER; it += nblk) {
        const int l = it / TC_LAYER; int r = it % TC_LAYER;
        u16* wbr = (u16*)(ws + OFF_WBR) + (size_t)l * 1024 * OW;
        if (r < TC_WIN) { tconv_tile(p.w_in + (size_t)l * 1024 * IN_WIDTH, IN_WIDTH, 1024, (u16*)(ws + OFF_WIN) + (size_t)l * WIN_ROWS * 1024, 1024, WIN_ROWS, 1, r, smem); continue; }
        r -= TC_WIN;
        if (r < TC_WQ) { tconv_tile(p.peer_w_q + (size_t)l * 1024 * 2048, 2048, 1024, (u16*)(ws + OFF_WQ) + (size_t)l * 2048 * 1024, 1024, 2048, 0, r, smem); continue; }
        r -= TC_WQ;
        if (r < TC_WOUT) { tconv_tile(p.w_out + (size_t)l * 1024 * 1024, 1024, 1024, (u16*)(ws + OFF_WOUT) + (size_t)l * 1024 * 1024, 1024, 1024, 0, r, smem); continue; }
        r -= TC_WOUT;
        if (r < TC_BR4) { tconv_tile(p.w_br_fox + (size_t)l * 256 * 1024, 1024, 256, wbr + O_FOX, OW, 1024, 0, r, smem); continue; }
        r -= TC_BR4;
        if (r < TC_BR4) { tconv_tile(p.w_br_lru + (size_t)l * 256 * 1024, 1024, 256, wbr + O_LRU, OW, 1024, 0, r, smem); continue; }
        r -= TC_BR4;
        if (r < TC_BR2) { tconv_tile(p.w_br_dil + (size_t)l * 128 * 1024, 1024, 128, wbr + O_DIL, OW, 1024, 0, r, smem); continue; }
        r -= TC_BR2;
        if (r < TC_BR4) { tconv_tile(p.w_br_nsa + (size_t)l * 256 * 1024, 1024, 256, wbr + O_NSA, OW, 1024, 0, r, smem); continue; }
        r -= TC_BR4;
        if (r < 2 * TC_W1) { const int z = r / TC_W1; const float* w1 = (z ? p.nsa_w1_v : p.nsa_w1_k) + (size_t)l * 2048 * 256;
            tconv_tile(w1, 256, 2048, (u16*)(ws + OFF_W1) + (size_t)(l * 2 + z) * 256 * 2048, 2048, 256, 0, r % TC_W1, smem); continue; }
        r -= 2 * TC_W1;
        { const int z = r / TC_W2; const float* w2 = (z ? p.nsa_w2_v : p.nsa_w2_k) + (size_t)l * 256 * 64;
            tconv_tile(w2, 64, 256, (u16*)(ws + OFF_W2) + (size_t)(l * 2 + z) * 64 * 256, 256, 64, 0, r % TC_W2, smem); }
    }
}
DEVI void ph_cvt(const float* __restrict__ src, u16* __restrict__ dst, size_t n4, int bid, int nblk) {
    for (size_t i = (size_t)bid * 256 + threadIdx.x; i < n4; i += (size_t)nblk * 256) {
        f32x4 v = *(const f32x4*)(src + i * 4);
        u32x2 o = {pk2(v[0], v[1]), pk2(v[2], v[3])};
        *(u32x2*)(dst + i * 4) = o;
    }
}
DEVI void ph_misc(const Params& p, int bid, int nblk) {
    for (int gid = bid * 256 + threadIdx.x; gid < SEQ * 32; gid += nblk * 256) {
        const int s = gid >> 5, i = gid & 31;
        const float freq = powf(10000.0f, -(float)i / 32.0f);
        const float ang = (float)s * freq;
        const double rev = (double)ang * 0.15915494309189535;
        const float fr = (float)(rev - floor(rev));
        f32x2 cs = {__builtin_amdgcn_cosf(fr), __builtin_amdgcn_sinf(fr)};
        *(f32x2*)(p.ws + OFF_ROPE + (size_t)gid * 8) = cs;
        if (gid < NLAYER * 2 * 256) {
            const int n = gid & 255, z = (gid >> 8) & 1, l = gid >> 9;
            const float* pe = (z ? p.nsa_pe_v : p.nsa_pe_k) + (size_t)l * 2048;
            const float* w1 = (z ? p.nsa_w1_v : p.nsa_w1_k) + (size_t)l * 2048 * 256;
            float a = 0.f;
            for (int k = 0; k < 2048; ++k) a += pe[k] * w1[(size_t)k * 256 + n];
            ((float*)(p.ws + OFF_B1))[gid] = a;
        }
    }
}

template <bool FINAL>
DEVI void ph_rmsnorm(const float* __restrict__ x, const float* __restrict__ gam, u16* __restrict__ hout, float* __restrict__ fout, int bid, int nblk) {
    const int lane = threadIdx.x & 63;
    for (int row = bid * 4 + (threadIdx.x >> 6); row < NTOK; row += nblk * 4) {
        const float* xr = x + (size_t)row * DM;
        f32x4 v[4]; float ss = 0.f;
#pragma unroll
        for (int i = 0; i < 4; ++i) { v[i] = *(const f32x4*)(xr + i * 256 + lane * 4); ss += v[i][0] * v[i][0] + v[i][1] * v[i][1] + v[i][2] * v[i][2] + v[i][3] * v[i][3]; }
        ss = wave_sum(ss);
        const float rs = rsqrtf(ss * (1.0f / DM) + 1e-6f);
#pragma unroll
        for (int i = 0; i < 4; ++i) {
            f32x4 gg = *(const f32x4*)(gam + i * 256 + lane * 4);
            f32x4 y = {v[i][0] * rs * gg[0], v[i][1] * rs * gg[1], v[i][2] * rs * gg[2], v[i][3] * rs * gg[3]};
            if (FINAL) *(f32x4*)(fout + (size_t)row * DM + i * 256 + lane * 4) = y;
            else { u32x2 o = {pk2(y[0], y[1]), pk2(y[2], y[3])}; *(u32x2*)(hout + (size_t)row * DM + i * 256 + lane * 4) = o; }
        }
    }
}

DEVI void ph_proj(const Params& p, int layer, char* smem, int bid, int nblk) {
    const u16* H = (const u16*)(p.ws + OFF_H);
    const u16* Wt = (const u16*)(p.ws + OFF_WIN) + (size_t)layer * WIN_ROWS * 1024;
    u16* P = (u16*)(p.ws + OFF_P); float* FS = (float*)(p.ws + OFF_FS);
    const int ntn = 25, ntiles = (NTOK / 128) * ntn;
    const int tid_ = tid_opaque(), lane = tid_ & 63, w = tid_ >> 6, wm = w >> 1, wn = w & 1, g = lane >> 4, c = lane & 15;
    for (int t = bid; t < ntiles; t += nblk) {
        const int tm = t / ntn, tn = t % ntn, m0 = tm * 128, n0 = tn * 128;
        f32x4 acc[4][4]; acc_zero(acc);
        gemm_mainloop<128, 128>(H, 1024, 64, Wt, 1024, 1024, m0, n0, smem, acc);
#pragma unroll
        for (int mt = 0; mt < 4; ++mt)
#pragma unroll
            for (int nt = 0; nt < 4; ++nt) {
                const int m = m0 + wm * 64 + 16 * mt + c, n = n0 + wn * 64 + 16 * nt + 4 * g;
                if (n < PW) { u32x2 o = {pk2(acc[mt][nt][0], acc[mt][nt][1]), pk2(acc[mt][nt][2], acc[mt][nt][3])}; *(u32x2*)(P + (size_t)m * PW + n) = o; }
                else if (n < PW + 16) *(f32x4*)(FS + (size_t)m * 16 + (n - PW)) = acc[mt][nt];
            }
    }
}

DEVI void ph_rope(const Params& p, int bid, int nblk) {
    u16* P = (u16*)(p.ws + OFF_P); u16* NQR = (u16*)(p.ws + OFF_NQR);
    const f32x2* tab = (const f32x2*)(p.ws + OFF_ROPE);
    const int lane = threadIdx.x & 63, i = lane & 31, half = lane >> 5;
    for (int tok = bid * 4 + (threadIdx.x >> 6); tok < NTOK; tok += nblk * 4) {
        const int s = tok & (SEQ - 1);
        const f32x2 cs = tab[s * 32 + i];
        u16* row = P + (size_t)tok * PW;
#pragma unroll
        for (int j = 0; j < 9; ++j) {
            const int hd = 2 * j + half;
            int col;
            if (hd < 6) col = C_DQ + hd * 64; else if (hd < 12) col = C_DK + (hd - 6) * 64; else if (hd < 16) col = C_NQ + (hd - 12) * 64; else if (hd == 16) col = C_NKS; else col = C_NKW;
            const float x1 = bf2f(row[col + i]), x2 = bf2f(row[col + 32 + i]);
            const float y1 = x1 * cs[0] - x2 * cs[1], y2 = x2 * cs[0] + x1 * cs[1];
            if (hd >= 12 && hd < 16) { u16* d = NQR + (size_t)tok * 256 + (hd - 12) * 64; d[i] = f2bf(y1); d[32 + i] = f2bf(y2); }
            else { row[col + i] = f2bf(y1); row[col + 32 + i] = f2bf(y2); }
        }
    }
}

DEVI void ph_foxcum(const Params& p, int layer, char* smem, int bid, int nblk) {
    float* part = (float*)smem;
    const int tid = threadIdx.x;
    const float* FS = (const float*)(p.ws + OFF_FS); float* CUM = (float*)(p.ws + OFF_CUM);
    for (int it = bid; it < 16; it += nblk) {
        const int b = it >> 2, h = it & 3;
        const float bf = p.fox_b_f[layer * 4 + h];
        float v[32]; float run = 0.f;
#pragma unroll
        for (int i = 0; i < 32; ++i) {
            const float z = FS[(size_t)(b * SEQ + tid * 32 + i) * 16 + h] + bf;
            const float ls = fminf(z, 0.f) - log1pf(__expf(-fabsf(z)));
            run += ls; v[i] = run;
        }
        __syncthreads();
        part[tid] = run; __syncthreads();
        if (tid == 0) { float a = 0.f; for (int i = 0; i < 256; ++i) { float t = part[i]; part[i] = a; a += t; } }
        __syncthreads();
        const float base = part[tid];
#pragma unroll
        for (int i = 0; i < 32; ++i) CUM[(size_t)(b * SEQ + tid * 32 + i) * 4 + h] = base + v[i];
    }
}

template <int MODE>
DEVI void ph_lru(const Params& p, int layer, char* smem, int bid, int nblk) {
    char* sXC = smem;
    float* sA = (float*)(smem + 16 * 528);
    float* sG = sA + 16 * 256;
    const int tid = tid_opaque(), ch = tid, lane = tid & 63, nb = tid >> 6, g = lane >> 4, c = lane & 15;
    const u16* P = (const u16*)(p.ws + OFF_P);
    float* SA = (float*)(p.ws + OFF_LSUM); float* SH = SA + 512 * 256;
    u16* O = (u16*)(p.ws + OFF_O);
    if (bid >= 512) return;
    s16x8 wfa[4][2], wfx[4][2];
    {
        const float* WA = p.lru_w_a + (size_t)layer * 4 * 64 * 64 + (size_t)nb * 64 * 64;
        const float* WX = p.lru_w_x + (size_t)layer * 4 * 64 * 64 + (size_t)nb * 64 * 64;
#pragma unroll
        for (int nt = 0; nt < 4; ++nt)
#pragma unroll
            for (int ks = 0; ks < 2; ++ks) {
                const int k0 = 32 * ks + 8 * g, dd = 16 * nt + c;
                u32x4 fa = {pk2(WA[(k0 + 0) * 64 + dd], WA[(k0 + 1) * 64 + dd]), pk2(WA[(k0 + 2) * 64 + dd], WA[(k0 + 3) * 64 + dd]), pk2(WA[(k0 + 4) * 64 + dd], WA[(k0 + 5) * 64 + dd]), pk2(WA[(k0 + 6) * 64 + dd], WA[(k0 + 7) * 64 + dd])};
                u32x4 fx = {pk2(WX[(k0 + 0) * 64 + dd], WX[(k0 + 1) * 64 + dd]), pk2(WX[(k0 + 2) * 64 + dd], WX[(k0 + 3) * 64 + dd]), pk2(WX[(k0 + 4) * 64 + dd], WX[(k0 + 5) * 64 + dd]), pk2(WX[(k0 + 6) * 64 + dd], WX[(k0 + 7) * 64 + dd])};
                wfa[nt][ks] = __builtin_bit_cast(s16x8, fa); wfx[nt][ks] = __builtin_bit_cast(s16x8, fx);
            }
    }
    float gba[4], gbx[4], gsp[4];
#pragma unroll
    for (int nt = 0; nt < 4; ++nt) {
        const int cc = layer * 256 + nb * 64 + 16 * nt + c;
        gba[nt] = p.lru_b_a[cc]; gbx[nt] = p.lru_b_x[cc];
        const float lam = p.lru_lambda[cc];
        gsp[nt] = (lam > 0.f ? 0.f : -lam) + log1pf(__expf(-fabsf(lam)));
    }
    const float cw0 = p.lru_conv_w[(layer * 4 + 0) * 256 + ch], cw1 = p.lru_conv_w[(layer * 4 + 1) * 256 + ch],
                cw2 = p.lru_conv_w[(layer * 4 + 2) * 256 + ch], cw3 = p.lru_conv_w[(layer * 4 + 3) * 256 + ch];
    const float cb = p.lru_conv_b[layer * 256 + ch];
    for (int tile = bid; tile < 512; tile += nblk) {
        const int b = tile >> 7, k = tile & 127, t0 = b * SEQ + k * 64;
        float hst = 0.f, aprod = 1.f;
        if (MODE == 1) { for (int j = 0; j < k; ++j) { const int tj = (b << 7) + j; hst = SA[tj * 256 + ch] * hst + SH[tj * 256 + ch]; } }
        float x0 = 0.f, x1 = 0.f, x2 = 0.f;
        if (k > 0) { x0 = bf2f(P[(size_t)(t0 - 3) * PW + C_LX + ch]); x1 = bf2f(P[(size_t)(t0 - 2) * PW + C_LX + ch]); x2 = bf2f(P[(size_t)(t0 - 1) * PW + C_LX + ch]); }
        for (int sub = 0; sub < 4; ++sub) {
            float xc[16];
            __syncthreads();
#pragma unroll
            for (int i = 0; i < 16; ++i) {
                const float x3 = bf2f(P[(size_t)(t0 + sub * 16 + i) * PW + C_LX + ch]);
                xc[i] = cw0 * x0 + cw1 * x1 + cw2 * x2 + cw3 * x3 + cb;
                x0 = x1; x1 = x2; x2 = x3;
                *(u16*)(sXC + i * 528 + ch * 2) = f2bf(xc[i]);
            }
            __syncthreads();
            {
                const s16x8 a0 = *(const s16x8*)(sXC + c * 528 + (nb * 64 + 8 * g) * 2);
                const s16x8 a1 = *(const s16x8*)(sXC + c * 528 + (nb * 64 + 32 + 8 * g) * 2);
#pragma unroll
                for (int nt = 0; nt < 4; ++nt) {
                    f32x4 za = {0.f, 0.f, 0.f, 0.f}, zx = {0.f, 0.f, 0.f, 0.f};
                    za = mfma16(a0, wfa[nt][0], za); za = mfma16(a1, wfa[nt][1], za);
                    zx = mfma16(a0, wfx[nt][0], zx); zx = mfma16(a1, wfx[nt][1], zx);
#pragma unroll
                    for (int r = 0; r < 4; ++r) {
                        const float rr = sigmoidf_(za[r] + gba[nt]), ig = sigmoidf_(zx[r] + gbx[nt]);
                        const float log_a = -8.0f * rr * gsp[nt];
                        sA[(4 * g + r) * 256 + nb * 64 + 16 * nt + c] = __expf(log_a);
                        sG[(4 * g + r) * 256 + nb * 64 + 16 * nt + c] = sqrtf(-expm1f(2.f * log_a)) * ig;
                    }
                }
            }
            __syncthreads();
#pragma unroll
            for (int i = 0; i < 16; ++i) {
                const float a = sA[i * 256 + ch];
                hst = a * hst + sG[i * 256 + ch] * xc[i];
                if (MODE == 0) aprod *= a;
                else {
                    const size_t tok = (size_t)(t0 + sub * 16 + i);
                    const float gate = bf2f(P[tok * PW + C_LG + ch]);
                    O[tok * OW + O_LRU + ch] = f2bf(hst * gelu_tanh(gate));
                }
            }
        }
        if (MODE == 0) { SA[tile * 256 + ch] = aprod; SH[tile * 256 + ch] = hst; }
    }
}

DEVI void ph_cmp(const Params& p, int layer, char* smem, int bid, int nblk) {
    const u16* P = (const u16*)(p.ws + OFF_P);
    const int tid_ = tid_opaque(), lane = tid_ & 63, w = tid_ >> 6, wm = w >> 1, wn = w & 1, g = lane >> 4, c = lane & 15;
    for (int t = bid; t < 32; t += nblk) {
        const int z = t >> 4, tm = t & 15;
        const int b = tm >> 2, i0 = (tm & 3) * 128;
        const u16* A = P + (size_t)(b * SEQ) * PW + (z ? C_NVC : C_NKC);
        const u16* Wt = (const u16*)(p.ws + OFF_W1) + ((size_t)(layer * 2 + z) * 256) * 2048;
        const float* b1 = (const float*)(p.ws + OFF_B1) + (layer * 2 + z) * 256;
        u16* HID = (u16*)(p.ws + OFF_HID) + (size_t)z * 2048 * 256;
        for (int tn = 0; tn < 2; ++tn) {
            f32x4 acc[4][4]; acc_zero(acc);
            gemm_mainloop<128, 128>(A, (size_t)16 * PW, (size_t)PW, Wt, 2048, 2048, i0, tn * 128, smem, acc);
#pragma unroll
            for (int mt = 0; mt < 4; ++mt)
#pragma unroll
                for (int nt = 0; nt < 4; ++nt) {
                    const int m = b * 512 + i0 + wm * 64 + 16 * mt + c, n = tn * 128 + wn * 64 + 16 * nt + 4 * g;
                    const f32x4 bb = *(const f32x4*)(b1 + n);
                    u32x2 o = {pk2(gelu_tanh(acc[mt][nt][0] + bb[0]), gelu_tanh(acc[mt][nt][1] + bb[1])), pk2(gelu_tanh(acc[mt][nt][2] + bb[2]), gelu_tanh(acc[mt][nt][3] + bb[3]))};
                    *(u32x2*)(HID + (size_t)m * 256 + n) = o;
                }
        }
        __syncthreads();
        {
            const u16* W2 = (const u16*)(p.ws + OFF_W2) + ((size_t)(layer * 2 + z) * 64) * 256;
            f32x4 acc[4][2]; acc_zero(acc);
            gemm_mainloop<128, 64>(HID, 256, 64, W2, 256, 256, tm * 128, 0, smem, acc);
            u16* KVC = (u16*)(p.ws + OFF_KVC) + (size_t)z * NB * 512 * 64;
#pragma unroll
            for (int mt = 0; mt < 4; ++mt)
#pragma unroll
                for (int nt = 0; nt < 2; ++nt) {
                    const int m = tm * 128 + wm * 64 + 16 * mt + c, n = wn * 32 + 16 * nt + 4 * g;
                    u32x2 o = {pk2(acc[mt][nt][0], acc[mt][nt][1]), pk2(acc[mt][nt][2], acc[mt][nt][3])};
                    if ((m & 511) == 511) o = (u32x2){0u, 0u};
                    *(u32x2*)(KVC + (size_t)m * 64 + n) = o;
                }
        }
    }
}
template <int NQT, class F>
DEVI void attn_tile64(const char* sK, const char* sV, const s16x8 (&qf)[NQT][2], float (&m)[NQT], float (&l)[NQT], f32x4 (&o)[NQT][4], int lane, F&& logit) {
    const int g = lane >> 4, c = lane & 15;
    f32x4 s[NQT][4];
#pragma unroll
    for (int T = 0; T < 4; ++T) {
        const int row = 16 * T + c;
        const s16x8 k0 = *(const s16x8*)(sK + row * 128 + ((g ^ (row & 7)) << 4));
        const s16x8 k1 = *(const s16x8*)(sK + row * 128 + (((4 + g) ^ (row & 7)) << 4));
#pragma unroll
        for (int qt = 0; qt < NQT; ++qt) { f32x4 z = {0.f, 0.f, 0.f, 0.f}; z = mfma16(k0, qf[qt][0], z); z = mfma16(k1, qf[qt][1], z); s[qt][T] = z; }
    }
#pragma unroll
    for (int qt = 0; qt < NQT; ++qt) {
        float mx = -INFINITY;
#pragma unroll
        for (int T = 0; T < 4; ++T) { logit(qt, T, s[qt][T]); mx = fmaxf(mx, fmaxf(fmaxf(s[qt][T][0], s[qt][T][1]), fmaxf(s[qt][T][2], s[qt][T][3]))); }
        mx = fmaxf(mx, __shfl_xor(mx, 16)); mx = fmaxf(mx, __shfl_xor(mx, 32));
        const float mn = fmaxf(m[qt], mx), alpha = __expf(m[qt] - mn);
        m[qt] = mn;
        float ps = 0.f;
#pragma unroll
        for (int T = 0; T < 4; ++T)
#pragma unroll
            for (int r = 0; r < 4; ++r) { const float pv = __expf(s[qt][T][r] - mn); s[qt][T][r] = pv; ps += pv; }
        l[qt] = l[qt] * alpha + ps;
#pragma unroll
        for (int dt = 0; dt < 4; ++dt) o[qt][dt] *= alpha;
    }
#pragma unroll
    for (int u = 0; u < 2; ++u) {
        s16x8 pb[NQT];
#pragma unroll
        for (int qt = 0; qt < NQT; ++qt) {
            u32x4 pk = {pk2(s[qt][2 * u][0], s[qt][2 * u][1]), pk2(s[qt][2 * u][2], s[qt][2 * u][3]), pk2(s[qt][2 * u + 1][0], s[qt][2 * u + 1][1]), pk2(s[qt][2 * u + 1][2], s[qt][2 * u + 1][3])};
            pb[qt] = __builtin_bit_cast(s16x8, pk);
        }
#pragma unroll
        for (int dt = 0; dt < 4; ++dt) {
            const char* a0 = sV + (32 * u + 4 * g + (c >> 2)) * 144 + (16 * dt + 4 * (c & 3)) * 2;
            const s16x4 v0 = __builtin_amdgcn_ds_read_tr16_b64_v4i16((LAS s16x4*)(a0));
            const s16x4 v1 = __builtin_amdgcn_ds_read_tr16_b64_v4i16((LAS s16x4*)(a0 + 16 * 144));
            const s16x8 vf = {v0[0], v0[1], v0[2], v0[3], v1[0], v1[1], v1[2], v1[3]};
#pragma unroll
            for (int qt = 0; qt < NQT; ++qt) o[qt][dt] = mfma16(vf, pb[qt], o[qt][dt]);
        }
    }
}
template <int NQT> DEVI void attn_init(float (&m)[NQT], float (&l)[NQT], f32x4 (&o)[NQT][4]) {
#pragma unroll
    for (int qt = 0; qt < NQT; ++qt) { m[qt] = -1e30f; l[qt] = 0.f;
#pragma unroll
        for (int dt = 0; dt < 4; ++dt) o[qt][dt] = (f32x4){0.f, 0.f, 0.f, 0.f}; }
}
DEVI float attn_ltot(float l) { l += __shfl_xor(l, 16); l += __shfl_xor(l, 32); return l; }
DEVI void stage_kv_block(char* sK, char* sV, const u16* kbase, const u16* vbase, size_t rstride) {
    const int tid = tid_opaque();
#pragma unroll
    for (int i = 0; i < 2; ++i) {
        const int id = tid + 256 * i, key = id >> 3, cc = id & 7;
        const u32x4 kv = *(const u32x4*)(kbase + (size_t)key * rstride + cc * 8);
        const u32x4 vv = *(const u32x4*)(vbase + (size_t)key * rstride + cc * 8);
        *(u32x4*)(sK + key * 128 + ((cc ^ (key & 7)) << 4)) = kv;
        *(u32x4*)(sV + key * 144 + cc * 16) = vv;
    }
}
constexpr int ATT_SK = 8192, ATT_SV = 64 * 144;

DEVI void fox_item(const Params& p, char* smem, int qb, int bh) {
    char* sK = smem; char* sV = smem + ATT_SK; float* sC = (float*)(smem + ATT_SK + ATT_SV);
    const u16* P = (const u16*)(p.ws + OFF_P); const float* CUM = (const float*)(p.ws + OFF_CUM); u16* O = (u16*)(p.ws + OFF_O);
    const int tid = tid_opaque(), lane = tid & 63, w = tid >> 6, g = lane >> 4, c = lane & 15;
    const int b = bh >> 2, h = bh & 3;
    const int q0 = qb * 128, qw = q0 + 32 * w;
    s16x8 qf[2][2]; float cq[2];
#pragma unroll
    for (int qt = 0; qt < 2; ++qt) {
        const size_t tok = (size_t)b * SEQ + qw + 16 * qt + c;
        qf[qt][0] = *(const s16x8*)(P + tok * PW + C_FQ + h * 64 + 8 * g);
        qf[qt][1] = *(const s16x8*)(P + tok * PW + C_FQ + h * 64 + 32 + 8 * g);
        cq[qt] = CUM[tok * 4 + h];
    }
    float m[2], l[2]; f32x4 o[2][4]; attn_init<2>(m, l, o);
    const int ntile = (q0 + 128) / 64;
    for (int kt = 0; kt < ntile; ++kt) {
        __syncthreads();
        const size_t kt0 = (size_t)b * SEQ + kt * 64;
        stage_kv_block(sK, sV, P + kt0 * PW + C_FK + h * 64, P + kt0 * PW + C_FV + h * 64, PW);
        if (tid < 64) sC[tid] = CUM[(kt0 + tid) * 4 + h];
        __syncthreads();
        if (kt * 64 <= qw + 31) {
            attn_tile64<2>(sK, sV, qf, m, l, o, lane, [&](int qt, int T, f32x4& s) {
                const f32x4 ck = *(const f32x4*)&sC[16 * T + 4 * g];
                const int qpos = qw + 16 * qt + c, k0 = kt * 64 + 16 * T + 4 * g;
#pragma unroll
                for (int r = 0; r < 4; ++r) s[r] = (k0 + r <= qpos) ? s[r] * 0.125f + (cq[qt] - ck[r]) : -INFINITY;
            });
        }
    }
#pragma unroll
    for (int qt = 0; qt < 2; ++qt) {
        const float inv = 1.f / attn_ltot(l[qt]);
        const size_t tok = (size_t)b * SEQ + qw + 16 * qt + c;
#pragma unroll
        for (int dt = 0; dt < 4; ++dt) {
            u32x2 ov = {pk2(o[qt][dt][0] * inv, o[qt][dt][1] * inv), pk2(o[qt][dt][2] * inv, o[qt][dt][3] * inv)};
            *(u32x2*)(O + tok * OW + O_FOX + h * 64 + 16 * dt + 4 * g) = ov;
        }
    }
}

DEVI void dil_item(const Params& p, char* smem, int blk) {
    const u16* P = (const u16*)(p.ws + OFF_P); u16* O = (u16*)(p.ws + OFF_O);
    const int tid = tid_opaque(), lane = tid & 63, w = tid >> 6, g = lane >> 4, c = lane & 15;
    char* sK = smem + w * (ATT_SK + ATT_SV); char* sV = sK + ATT_SK;
    const int wt = blk * 4 + w, hg = wt & 1, t0r = (wt >> 1) & 15, span = (wt >> 5) & 15, b = wt >> 9;
    const int pbase = 512 * span + t0r;
    float m[2], l[2]; f32x4 o[2][4]; attn_init<2>(m, l, o);
#pragma unroll
    for (int gi = 0; gi < 3; ++gi) {
        const int dl = gi == 0 ? 1 : (gi == 1 ? 4 : 16), sh = gi == 0 ? 0 : (gi == 1 ? 2 : 4);
        const int head = 2 * gi + hg, rr = t0r & (dl - 1);
        s16x8 qf[2][2]; int uq[2];
#pragma unroll
        for (int qt = 0; qt < 2; ++qt) {
            const int pos = pbase + 16 * (16 * qt + c);
            const size_t tok = (size_t)b * SEQ + pos;
            qf[qt][0] = *(const s16x8*)(P + tok * PW + C_DQ + head * 64 + 8 * g);
            qf[qt][1] = *(const s16x8*)(P + tok * PW + C_DQ + head * 64 + 32 + 8 * g);
            uq[qt] = (pos - rr) >> sh;
        }
        int ulo = ((512 * span) >> sh) - 128; if (ulo < 0) ulo = 0;
        const int uhi = (512 * span + 15 + 496) >> sh;
        const int nt = (uhi - ulo) / 64 + 1;
        for (int kt = 0; kt < nt; ++kt) {
            __syncthreads();
#pragma unroll
            for (int i = 0; i < 8; ++i) {
                const int id = lane + 64 * i, key = id >> 3, cc = id & 7;
                int pos = rr + ((ulo + kt * 64 + key) << sh); if (pos > SEQ - 1) pos = SEQ - 1;
                const size_t tok = (size_t)b * SEQ + pos;
                const u32x4 kv = *(const u32x4*)(P + tok * PW + C_DK + head * 64 + cc * 8);
                const u32x4 vv = *(const u32x4*)(P + tok * PW + C_DV + head * 64 + cc * 8);
                *(u32x4*)(sK + key * 128 + ((cc ^ (key & 7)) << 4)) = kv;
                *(u32x4*)(sV + key * 144 + cc * 16) = vv;
            }
            __syncthreads();
            attn_tile64<2>(sK, sV, qf, m, l, o, lane, [&](int qt, int T, f32x4& s) {
                const int u0 = ulo + kt * 64 + 16 * T + 4 * g;
#pragma unroll
                for (int r = 0; r < 4; ++r) { const int u = u0 + r; s[r] = (u <= uq[qt] && u >= uq[qt] - 128) ? s[r] * 0.125f : -INFINITY; }
            });
        }
    }
#pragma unroll
    for (int qt = 0; qt < 2; ++qt) {
        const float inv = 1.f / attn_ltot(l[qt]);
        const size_t tok = (size_t)b * SEQ + pbase + 16 * (16 * qt + c);
#pragma unroll
        for (int dt = 0; dt < 4; ++dt) {
            u32x2 ov = {pk2(o[qt][dt][0] * inv, o[qt][dt][1] * inv), pk2(o[qt][dt][2] * inv, o[qt][dt][3] * inv)};
            *(u32x2*)(O + tok * OW + O_DIL + hg * 64 + 16 * dt + 4 * g) = ov;
        }
    }
}

DEVI void nsa_item(const Params& p, char* smem, int blk) {
    char* sK = smem; char* sV = smem + ATT_SK; float* sImp = (float*)(smem + ATT_SK + ATT_SV);
    const u16* P = (const u16*)(p.ws + OFF_P); const u16* NQR = (const u16*)(p.ws + OFF_NQR);
    const u16* KC = (const u16*)(p.ws + OFF_KVC); const u16* VC = KC + (size_t)NB * 512 * 64;
    u16* OC = (u16*)(p.ws + OFF_OC); unsigned* SEL = (unsigned*)(p.ws + OFF_SEL);
    const float* FS = (const float*)(p.ws + OFF_FS); u16* O = (u16*)(p.ws + OFF_O);
    const int tid = tid_opaque(), lane = tid & 63, w = tid >> 6, g = lane >> 4, c = lane & 15;
    const int b = blk >> 7, s0 = (blk & 127) * 64;
    {
        const int sq = s0 + 16 * w + c;
        const size_t tok = (size_t)b * SEQ + sq;
        __syncthreads();
        for (int i = tid; i < 64 * 128; i += 256) sImp[i] = 0.f;
        const int ntile = ((s0 + 32) / 16) / 64 + 1;
        const int cmax = (sq - 31) >> 4;
#pragma unroll 1
        for (int h = 0; h < 4; ++h) {
            s16x8 qf[1][2];
            qf[0][0] = *(const s16x8*)(P + tok * PW + C_NQ + h * 64 + 8 * g); qf[0][1] = *(const s16x8*)(P + tok * PW + C_NQ + h * 64 + 32 + 8 * g);
            float m[1], l[1]; f32x4 o[1][4];
            attn_init<1>(m, l, o);
            for (int kt = 0; kt < ntile; ++kt) {
                __syncthreads();
                stage_kv_block(sK, sV, KC + ((size_t)b * 512 + kt * 64) * 64, VC + ((size_t)b * 512 + kt * 64) * 64, 64);
                __syncthreads();
                attn_tile64<1>(sK, sV, qf, m, l, o, lane, [&](int, int T, f32x4& s) {
                    const int c0 = kt * 64 + 16 * T + 4 * g;
#pragma unroll
                    for (int r = 0; r < 4; ++r) s[r] = (c0 + r <= cmax) ? s[r] * 0.125f : -INFINITY;
                });
            }
            const float lt = attn_ltot(l[0]);
            const float linv = lt > 0.f ? 1.f / lt : 0.f;
#pragma unroll
            for (int dt = 0; dt < 4; ++dt) {
                u32x2 ov = {pk2(o[0][dt][0] * linv, o[0][dt][1] * linv), pk2(o[0][dt][2] * linv, o[0][dt][3] * linv)};
                *(u32x2*)(OC + tok * 256 + h * 64 + 16 * dt + 4 * g) = ov;
            }
            float acur = 0.f;
            for (int kt = 0; kt < ntile; ++kt) {
                __syncthreads();
                stage_kv_block(sK, sV, KC + ((size_t)b * 512 + kt * 64) * 64, VC + ((size_t)b * 512 + kt * 64) * 64, 64);
                __syncthreads();
#pragma unroll
                for (int T = 0; T < 4; ++T) {
                    const int row = 16 * T + c;
                    const s16x8 k0 = *(const s16x8*)(sK + row * 128 + ((g ^ (row & 7)) << 4));
                    const s16x8 k1 = *(const s16x8*)(sK + row * 128 + (((4 + g) ^ (row & 7)) << 4));
                    f32x4 z = {0.f, 0.f, 0.f, 0.f}; z = mfma16(k0, qf[0][0], z); z = mfma16(k1, qf[0][1], z);
                    const int c0 = kt * 64 + 16 * T + 4 * g;
                    float pr[4];
#pragma unroll
                    for (int r = 0; r < 4; ++r) pr[r] = (c0 + r <= cmax) ? __expf(z[r] * 0.125f - m[0]) * linv : 0.f;
                    const float a = __shfl(pr[3], (lane + 48) & 63);
                    const float prev = g > 0 ? a : acur;
                    acur = a;
                    sImp[(16 * w + c) * 128 + 16 * kt + 4 * T + g] += pr[0] + pr[1] + pr[2] + pr[3] + prev;
                }
            }
        }
        __syncthreads();
        for (int tl = 0; tl < 16; ++tl) {
            const int sp = s0 + 16 * w + tl, cur = sp >> 6;
            unsigned k0, k1; bool sel0 = false, sel1 = false;
            {
                const int n0 = lane, n1 = lane + 64;
                float v0 = sImp[(16 * w + tl) * 128 + n0], v1 = sImp[(16 * w + tl) * 128 + n1];
                if (n0 == 0 || n0 == cur || n0 == cur - 1) v0 = 1e6f;
                if (n1 == cur || n1 == cur - 1) v1 = 1e6f;
                k0 = n0 <= cur ? (((__float_as_uint(v0) | 0x80000000u) & ~127u) | (unsigned)(127 - n0)) : 0u;
                k1 = n1 <= cur ? (((__float_as_uint(v1) | 0x80000000u) & ~127u) | (unsigned)(127 - n1)) : 0u;
            }
            if (cur < 16) { sel0 = k0 != 0u; sel1 = k1 != 0u; }
            else {
                for (int it = 0; it < 16; ++it) {
                    const unsigned km = wave_max_u32(k0 > k1 ? k0 : k1);
                    if (k0 == km) { sel0 = true; k0 = 0u; } else if (k1 == km) { sel1 = true; k1 = 0u; }
                }
            }
            const unsigned long long b0 = __ballot(sel0), b1 = __ballot(sel1);
            if (lane == 0) { u32x4 mk = {(unsigned)b0, (unsigned)(b0 >> 32), (unsigned)b1, (unsigned)(b1 >> 32)}; *(u32x4*)(SEL + ((size_t)b * SEQ + sp) * 4) = mk; }
        }
    }
    __syncthreads();
    const int h = w;
    for (int sub = 0; sub < 2; ++sub) {
        const int t0 = s0 + 32 * sub;
        s16x8 qf[2][2]; u32x4 msk[2];
#pragma unroll
        for (int qt = 0; qt < 2; ++qt) {
            const size_t tok = (size_t)b * SEQ + t0 + 16 * qt + c;
            qf[qt][0] = *(const s16x8*)(NQR + tok * 256 + h * 64 + 8 * g);
            qf[qt][1] = *(const s16x8*)(NQR + tok * 256 + h * 64 + 32 + 8 * g);
            msk[qt] = *(const u32x4*)(SEL + tok * 4);
        }
        float m[2], l[2]; f32x4 o[2][4]; attn_init<2>(m, l, o);
        int klo = t0 - 511; if (klo < 0) klo = 0; klo >>= 6;
        const int khi = (t0 + 31) >> 6;
        for (int kt = klo; kt <= khi; ++kt) {
            __syncthreads();
            const size_t kt0 = (size_t)b * SEQ + kt * 64;
            stage_kv_block(sK, sV, P + kt0 * PW + C_NKW, P + kt0 * PW + C_NVW, PW);
            __syncthreads();
            attn_tile64<2>(sK, sV, qf, m, l, o, lane, [&](int qt, int T, f32x4& s) {
                const int qpos = t0 + 16 * qt + c, k0 = kt * 64 + 16 * T + 4 * g;
#pragma unroll
                for (int r = 0; r < 4; ++r) s[r] = (k0 + r <= qpos && k0 + r > qpos - 512) ? s[r] * 0.125f : -INFINITY;
            });
        }
        f32x4 ow[2][4];
#pragma unroll
        for (int qt = 0; qt < 2; ++qt) {
            const float inv = 1.f / attn_ltot(l[qt]);
#pragma unroll
            for (int dt = 0; dt < 4; ++dt) ow[qt][dt] = o[qt][dt] * inv;
        }
        attn_init<2>(m, l, o);
        for (int n = 0; n <= khi; ++n) {
            const unsigned w0 = n < 32 ? msk[0][0] : (n < 64 ? msk[0][1] : (n < 96 ? msk[0][2] : msk[0][3]));
            const unsigned w1 = n < 32 ? msk[1][0] : (n < 64 ? msk[1][1] : (n < 96 ? msk[1][2] : msk[1][3]));
            const bool bit0 = (w0 >> (n & 31)) & 1u, bit1 = (w1 >> (n & 31)) & 1u;
            if (__ballot(bit0 || bit1) == 0ull) continue;
            __syncthreads();
            const size_t kt0 = (size_t)b * SEQ + n * 64;
            stage_kv_block(sK, sV, P + kt0 * PW + C_NKS, P + kt0 * PW + C_NVS, PW);
            __syncthreads();
            attn_tile64<2>(sK, sV, qf, m, l, o, lane, [&](int qt, int T, f32x4& s) {
                const int qpos = t0 + 16 * qt + c, k0 = n * 64 + 16 * T + 4 * g;
                const bool bit = qt == 0 ? bit0 : bit1;
#pragma unroll
                for (int r = 0; r < 4; ++r) s[r] = (bit && k0 + r <= qpos) ? s[r] * 0.125f : -INFINITY;
            });
        }
#pragma unroll
        for (int qt = 0; qt < 2; ++qt) {
            const float lt = attn_ltot(l[qt]); const float inv = lt > 0.f ? 1.f / lt : 0.f;
            const size_t tok = (size_t)b * SEQ + t0 + 16 * qt + c;
            const float g0 = sigmoidf_(FS[tok * 16 + 4 + h * 3 + 0]), g1 = sigmoidf_(FS[tok * 16 + 4 + h * 3 + 1]), g2 = sigmoidf_(FS[tok * 16 + 4 + h * 3 + 2]);
#pragma unroll
            for (int dt = 0; dt < 4; ++dt) {
                const u32x2 oc = *(const u32x2*)(OC + tok * 256 + h * 64 + 16 * dt + 4 * g);
                const float r0 = g0 * bflo(oc[0]) + g1 * o[qt][dt][0] * inv + g2 * ow[qt][dt][0];
                const float r1 = g0 * bfhi(oc[0]) + g1 * o[qt][dt][1] * inv + g2 * ow[qt][dt][1];
                const float r2 = g0 * bflo(oc[1]) + g1 * o[qt][dt][2] * inv + g2 * ow[qt][dt][2];
                const float r3 = g0 * bfhi(oc[1]) + g1 * o[qt][dt][3] * inv + g2 * ow[qt][dt][3];
                u32x2 ov = {pk2(r0, r1), pk2(r2, r3)};
                *(u32x2*)(O + tok * OW + O_NSA + h * 64 + 16 * dt + 4 * g) = ov;
            }
        }
    }
}

DEVI void ph_branches(const Params& p, int layer, char* smem, int bid, int nblk, unsigned* qctr) {
    int* sItem = (int*)(smem + 65536);
    for (;;) {
        __syncthreads();
        if (threadIdx.x == 0) *sItem = (int)__hip_atomic_fetch_add(qctr, 1u, __ATOMIC_RELAXED, __HIP_MEMORY_SCOPE_AGENT);
        __syncthreads();
        const int it = *sItem;
        if (it >= 64 * 24) break;
        const int lvl = it / 24, j = it % 24, qb = 63 - lvl;
        if (j < 16) fox_item(p, smem, qb, j);
        else { const int jj = j - 16, b = jj >> 1; nsa_item(p, smem, b * 128 + qb * 2 + (jj & 1)); }
    }
    for (int it = bid; it < 512; it += nblk) dil_item(p, smem, it);
    ph_lru<1>(p, layer, smem, bid, nblk);
}

DEVI void ph_merge(const Params& p, int layer, char* smem, int bid, int nblk) {
    const u16* H = (const u16*)(p.ws + OFF_H); const u16* O = (const u16*)(p.ws + OFF_O);
    const u16* Wg = (const u16*)(p.ws + OFF_WIN) + ((size_t)layer * WIN_ROWS + WIN_GATE0) * 1024;
    const u16* Wbr = (const u16*)(p.ws + OFF_WBR) + (size_t)layer * 1024 * OW;
    u16* MG = (u16*)(p.ws + OFF_MERGED);
    const int tid_ = tid_opaque(), lane = tid_ & 63, w = tid_ >> 6, wm = w >> 1, wn = w & 1, g = lane >> 4, c = lane & 15;
    for (int t = bid; t < (NTOK / 128) * 16; t += nblk) {
        const int tm = t >> 4, tn = t & 15, m0 = tm * 128, n0 = tn * 64;
        f32x4 mg[4][2]; acc_zero(mg);
        f32x4 sg[4][2]; acc_zero(sg);
#pragma unroll 1
        for (int job = 0; job < 8; ++job) {
            const int br = job >> 1; const bool isy = job & 1;
            const int kb = br == 2 ? 128 : 256, oc = br == 0 ? O_FOX : (br == 1 ? O_LRU : (br == 2 ? O_DIL : O_NSA));
            const u16* Aj = isy ? O + oc : H; const size_t ldaj = isy ? (size_t)OW : (size_t)1024;
            const u16* Bj = isy ? Wbr + oc : Wg + (size_t)br * 1024 * 1024; const size_t ldbj = isy ? (size_t)OW : (size_t)1024;
            const int Kj = isy ? kb : 1024;
            f32x4 acc[4][2]; acc_zero(acc);
            gemm_mainloop<128, 64>(Aj, ldaj, 64, Bj, ldbj, Kj, m0, n0, smem, acc);
#pragma unroll
            for (int mt = 0; mt < 4; ++mt)
#pragma unroll
                for (int nt = 0; nt < 2; ++nt)
#pragma unroll
                    for (int r = 0; r < 4; ++r) {
                        if (isy) mg[mt][nt][r] += sg[mt][nt][r] * acc[mt][nt][r];
                        else sg[mt][nt][r] = sigmoidf_(acc[mt][nt][r]);
                    }
        }
#pragma unroll
        for (int mt = 0; mt < 4; ++mt)
#pragma unroll
            for (int nt = 0; nt < 2; ++nt) {
                const int m = m0 + wm * 64 + 16 * mt + c, n = n0 + wn * 32 + 16 * nt + 4 * g;
                u32x2 ov = {pk2(mg[mt][nt][0], mg[mt][nt][1]), pk2(mg[mt][nt][2], mg[mt][nt][3])};
                *(u32x2*)(MG + (size_t)m * 1024 + n) = ov;
            }
    }
}
DEVI void ph_wout(const Params& p, int layer, char* smem, int bid, int nblk) {
    const u16* MG = (const u16*)(p.ws + OFF_MERGED);
    const u16* Wt = (const u16*)(p.ws + OFF_WOUT) + (size_t)layer * 1024 * 1024;
    const float* xin = layer == 0 ? p.x : p.out;
    const int tid_ = tid_opaque(), lane = tid_ & 63, w = tid_ >> 6, wm = w >> 1, wn = w & 1, g = lane >> 4, c = lane & 15;
    for (int t = bid; t < (NTOK / 128) * 8; t += nblk) {
        const int tm = t >> 3, tn = t & 7, m0 = tm * 128, n0 = tn * 128;
        f32x4 acc[4][4]; acc_zero(acc);
        gemm_mainloop<128, 128>(MG, 1024, 64, Wt, 1024, 1024, m0, n0, smem, acc);
#pragma unroll
        for (int mt = 0; mt < 4; ++mt)
#pragma unroll
            for (int nt = 0; nt < 4; ++nt) {
                const int m = m0 + wm * 64 + 16 * mt + c, n = n0 + wn * 64 + 16 * nt + 4 * g;
                const f32x4 xv = *(const f32x4*)(xin + (size_t)m * DM + n);
                *(f32x4*)(p.out + (size_t)m * DM + n) = xv + acc[mt][nt];
            }
    }
}
DEVI void ph_peerq(const Params& p, int layer, char* smem, int bid, int nblk) {
    const u16* H = (const u16*)(p.ws + OFF_H);
    const u16* Wt = (const u16*)(p.ws + OFF_WQ) + (size_t)layer * 2048 * 1024;
    u16* QP = (u16*)(p.ws + OFF_QP);
    const int tid_ = tid_opaque(), lane = tid_ & 63, w = tid_ >> 6, wm = w >> 1, wn = w & 1, g = lane >> 4, c = lane & 15;
    for (int t = bid; t < (NTOK / 128) * 16; t += nblk) {
        const int tm = t >> 4, tn = t & 15, m0 = tm * 128, n0 = tn * 128;
        f32x4 acc[4][4]; acc_zero(acc);
        gemm_mainloop<128, 128>(H, 1024, 64, Wt, 1024, 1024, m0, n0, smem, acc);
#pragma unroll
        for (int mt = 0; mt < 4; ++mt)
#pragma unroll
            for (int nt = 0; nt < 4; ++nt) {
                const int m = m0 + wm * 64 + 16 * mt + c, n = n0 + wn * 64 + 16 * nt + 4 * g;
                u32x2 ov = {pk2(acc[mt][nt][0], acc[mt][nt][1]), pk2(acc[mt][nt][2], acc[mt][nt][3])};
                *(u32x2*)(QP + (size_t)m * 2048 + n) = ov;
            }
    }
}
template <int N> DEVI void bitonic_sort_desc(unsigned (&k)[N]) {
#pragma unroll
    for (int sz = 2; sz <= N; sz <<= 1)
#pragma unroll
        for (int st = sz >> 1; st > 0; st >>= 1)
#pragma unroll
            for (int i = 0; i < N; ++i) {
                const int j = i ^ st;
                if (j > i) {
                    const bool desc = (i & sz) == 0;
                    const unsigned a = k[i], b = k[j], hi = a > b ? a : b, lo = a > b ? b : a;
                    k[i] = desc ? hi : lo; k[j] = desc ? lo : hi;
                }
            }
}
template <int N> DEVI void bitonic_merge_desc(unsigned (&k)[N]) {
#pragma unroll
    for (int st = N >> 1; st > 0; st >>= 1)
#pragma unroll
        for (int i = 0; i < N; ++i) {
            const int j = i ^ st;
            if (j > i) { const unsigned a = k[i], b = k[j]; k[i] = a > b ? a : b; k[j] = a > b ? b : a; }
        }
}
DEVI void merge_top16_xor(unsigned (&k)[16], int x) {
    unsigned t[16];
#pragma unroll
    for (int i = 0; i < 16; ++i) { const unsigned o = (unsigned)__shfl_xor((int)k[15 - i], x); t[i] = k[i] > o ? k[i] : o; }
    bitonic_merge_desc<16>(t);
#pragma unroll
    for (int i = 0; i < 16; ++i) k[i] = t[i];
}
DEVI unsigned f2ord(float f) { unsigned u = __float_as_uint(f); return u ^ ((u >> 31) ? 0xffffffffu : 0x80000000u); }
DEVI float ord2f(unsigned u) { return __uint_as_float(u ^ ((u >> 31) ? 0x80000000u : 0xffffffffu)); }

struct PairTab { unsigned char i[64], j[64]; };
__host__ __device__ constexpr PairTab make_pairs() {
    PairTab t{};
    int n = 0;
    for (int i = 0; i < 16; ++i) for (int j = 0; j < 16; ++j) if ((i + 1) * (j + 1) <= 16) { t.i[n] = (unsigned char)i; t.j[n] = (unsigned char)j; ++n; }
    for (; n < 64; ++n) { t.i[n] = 255; t.j[n] = 255; }
    return t;
}
constexpr PairTab kPairs = make_pairs();

DEVI void ph_peertop(const Params& p, int layer, char* smem, int bid, int nblk) {
    unsigned char (*sIdx)[16][2][16] = (unsigned char (*)[16][2][16])smem;
    const u16* QP = (const u16*)(p.ws + OFF_QP);
    const u16* SK = (const u16*)(p.ws + OFF_SUBK) + (size_t)layer * 2 * 128 * 128;
    int* PIDX = (int*)(p.ws + OFF_PIDX); float* PGW = (float*)(p.ws + OFF_PGW);
    const int tid = tid_opaque(), lane = tid & 63, w = tid >> 6, g = lane >> 4, c = lane & 15;
    for (int item = bid * 4 + w; item < (NTOK / 16) * 8; item += nblk * 4) {
        const int hd = item & 7, t0 = (item >> 3) * 16;
        const size_t tok = (size_t)t0 + c;
        unsigned top[2][16];
#pragma unroll
        for (int pp = 0; pp < 2; ++pp) {
            s16x8 qf[4];
#pragma unroll
            for (int ks = 0; ks < 4; ++ks) qf[ks] = *(const s16x8*)(QP + tok * 2048 + hd * 256 + pp * 128 + 32 * ks + 8 * g);
            unsigned key[32];
#pragma unroll
            for (int T = 0; T < 8; ++T) {
                f32x4 z = {0.f, 0.f, 0.f, 0.f};
#pragma unroll
                for (int ks = 0; ks < 4; ++ks) {
                    const s16x8 kf = *(const s16x8*)(SK + ((size_t)pp * 128 + 16 * T + c) * 128 + 32 * ks + 8 * g);
                    z = mfma16(kf, qf[ks], z);
                }
#pragma unroll
                for (int r = 0; r < 4; ++r) { const int n = 16 * T + 4 * g + r; key[4 * T + r] = (f2ord(z[r]) & ~127u) | (unsigned)(127 - n); }
            }
            bitonic_sort_desc<32>(key);
#pragma unroll
            for (int i = 0; i < 16; ++i) top[pp][i] = key[i];
            merge_top16_xor(top[pp], 16);
            merge_top16_xor(top[pp], 32);
#pragma unroll
            for (int i = 0; i < 16; ++i) if ((i >> 2) == g) sIdx[w][c][pp][i] = (unsigned char)(127 - (top[pp][i] & 127u));
        }
        float v0[16], v1[16];
#pragma unroll
        for (int i = 0; i < 16; ++i) { v0[i] = ord2f(top[0][i] & ~127u); v1[i] = ord2f(top[1][i] & ~127u); }
        unsigned ck[16];
#pragma unroll
        for (int e = 0; e < 16; ++e) {
            unsigned kk[4];
#pragma unroll
            for (int gg = 0; gg < 4; ++gg) {
                const int pi = kPairs.i[gg * 16 + e], pj = kPairs.j[gg * 16 + e];
                kk[gg] = pi < 16 ? ((f2ord(v0[pi < 16 ? pi : 0] + v1[pj < 16 ? pj : 0]) & ~255u) | (unsigned)(255 - (pi * 16 + pj))) : 0u;
            }
            ck[e] = g == 0 ? kk[0] : (g == 1 ? kk[1] : (g == 2 ? kk[2] : kk[3]));
        }
        bitonic_sort_desc<16>(ck);
        merge_top16_xor(ck, 16);
        merge_top16_xor(ck, 32);
        const float smax = ord2f(ck[0] & ~255u);
        float ex[16], den = 0.f;
#pragma unroll
        for (int i = 0; i < 16; ++i) { ex[i] = __expf(ord2f(ck[i] & ~255u) - smax); den += ex[i]; }
        const float rden = 1.f / den;
        int eidx[4]; float egw[4];
#pragma unroll
        for (int r = 0; r < 4; ++r) {
            const unsigned kq = g == 0 ? ck[r] : (g == 1 ? ck[4 + r] : (g == 2 ? ck[8 + r] : ck[12 + r]));
            const float eq = g == 0 ? ex[r] : (g == 1 ? ex[4 + r] : (g == 2 ? ex[8 + r] : ex[12 + r]));
            const int flat = 255 - (int)(kq & 255u), pi = flat >> 4, pj = flat & 15;
            eidx[r] = (int)sIdx[w][c][0][pi] * 128 + (int)sIdx[w][c][1][pj];
            egw[r] = eq * rden;
        }
        *(int4*)(PIDX + tok * 128 + hd * 16 + 4 * g) = make_int4(eidx[0], eidx[1], eidx[2], eidx[3]);
        *(f32x4*)(PGW + tok * 128 + hd * 16 + 4 * g) = (f32x4){egw[0], egw[1], egw[2], egw[3]};
    }
}

DEVI void ph_peergather(const Params& p, const float* __restrict__ g2, char* smem, int bid, int nblk) {
    u16 (*sh2)[1024] = (u16 (*)[1024])smem;
    const u16* PU = (const u16*)(p.ws + OFF_PUV); const u16* PV = PU + (size_t)NEXP * 1024;
    const int* PIDX = (const int*)(p.ws + OFF_PIDX); const float* PGW = (const float*)(p.ws + OFF_PGW);
    const int tid = tid_opaque(), lane = tid & 63, w = tid >> 6, g = lane >> 4, c = lane & 15;
    for (int tok = bid * 4 + w; tok < NTOK; tok += nblk * 4) {
        float* xr = p.out + (size_t)tok * DM;
        f32x4 xv[4]; float ss = 0.f;
#pragma unroll
        for (int i = 0; i < 4; ++i) { xv[i] = *(const f32x4*)(xr + i * 256 + lane * 4); ss += xv[i][0] * xv[i][0] + xv[i][1] * xv[i][1] + xv[i][2] * xv[i][2] + xv[i][3] * xv[i][3]; }
        ss = wave_sum(ss);
        const float rs = rsqrtf(ss * (1.0f / DM) + 1e-6f);
#pragma unroll
        for (int i = 0; i < 4; ++i) {
            const f32x4 gg = *(const f32x4*)(g2 + i * 256 + lane * 4);
            u32x2 hv = {pk2(xv[i][0] * rs * gg[0], xv[i][1] * rs * gg[1]), pk2(xv[i][2] * rs * gg[2], xv[i][3] * rs * gg[3])};
            *(u32x2*)(&sh2[w][i * 256 + lane * 4]) = hv;
        }
        float acc[16];
#pragma unroll
        for (int i = 0; i < 16; ++i) acc[i] = 0.f;
        for (int hd = 0; hd < 8; ++hd) {
            const int myidx = PIDX[(size_t)tok * 128 + hd * 16 + c];
            const float mygw = PGW[(size_t)tok * 128 + hd * 16 + c];
            const u16* urow = PU + (size_t)myidx * 1024 + 256 * g;
            f32x4 z = {0.f, 0.f, 0.f, 0.f};
#pragma unroll 4
            for (int s = 0; s < 32; ++s) {
                const s16x8 a = *(const s16x8*)(urow + 8 * s);
                const s16x8 bq = *(const s16x8*)(&sh2[w][256 * g + 8 * s]);
                z = mfma16(a, bq, z);
            }
#pragma unroll
            for (int e = 0; e < 16; ++e) {
                const float ze = __shfl(z[e & 3], 16 * (e >> 2));
                const float wgt = __shfl(mygw, e) * gelu_tanh(ze);
                const int ei = __shfl(myidx, e);
                const u16* vrow = PV + (size_t)ei * 1024;
                const u32x4 va = *(const u32x4*)(vrow + lane * 8);
                const u32x4 vb = *(const u32x4*)(vrow + 512 + lane * 8);
#pragma unroll
                for (int q = 0; q < 4; ++q) { acc[2 * q] += wgt * bflo(va[q]); acc[2 * q + 1] += wgt * bfhi(va[q]); acc[8 + 2 * q] += wgt * bflo(vb[q]); acc[8 + 2 * q + 1] += wgt * bfhi(vb[q]); }
            }
        }
#pragma unroll
        for (int hlf = 0; hlf < 2; ++hlf)
#pragma unroll
            for (int q = 0; q < 2; ++q) {
                float* d = xr + hlf * 512 + lane * 8 + q * 4;
                f32x4 v = *(const f32x4*)d;
                v[0] += acc[hlf * 8 + q * 4 + 0]; v[1] += acc[hlf * 8 + q * 4 + 1]; v[2] += acc[hlf * 8 + q * 4 + 2]; v[3] += acc[hlf * 8 + q * 4 + 3];
                *(f32x4*)d = v;
            }
    }
}


template <int l>
DEVI void layer_body(char* smem, int bid, int nblk, unsigned& epoch) {
        { const Params p = kp_load(kp_get()); char* ws = p.ws; (void)ws; unsigned* ctrl = (unsigned*)(p.ws + OFF_CTRL); (void)ctrl; ph_proj(p, l, smem, bid, nblk); }
        { const Params p = kp_load(kp_get()); grid_bar((unsigned*)(p.ws + OFF_CTRL), nblk, epoch); }
        { const Params p = kp_load(kp_get()); char* ws = p.ws; (void)ws; unsigned* ctrl = (unsigned*)(p.ws + OFF_CTRL); (void)ctrl; ph_rope(p, bid, nblk); }
        { const Params p = kp_load(kp_get()); char* ws = p.ws; (void)ws; unsigned* ctrl = (unsigned*)(p.ws + OFF_CTRL); (void)ctrl; ph_foxcum(p, l, smem, (bid + nblk - 64) % nblk, nblk); }
        { const Params p = kp_load(kp_get()); char* ws = p.ws; (void)ws; unsigned* ctrl = (unsigned*)(p.ws + OFF_CTRL); (void)ctrl; ph_cmp(p, l, smem, (bid + nblk - 128) % nblk, nblk); }
        { const Params p = kp_load(kp_get()); char* ws = p.ws; (void)ws; unsigned* ctrl = (unsigned*)(p.ws + OFF_CTRL); (void)ctrl; ph_lru<0>(p, l, smem, bid, nblk); }
        { const Params p = kp_load(kp_get()); grid_bar((unsigned*)(p.ws + OFF_CTRL), nblk, epoch); }
        { const Params p = kp_load(kp_get()); char* ws = p.ws; (void)ws; unsigned* ctrl = (unsigned*)(p.ws + OFF_CTRL); (void)ctrl; ph_branches(p, l, smem, bid, nblk, ctrl + 8 + l); }
        { const Params p = kp_load(kp_get()); grid_bar((unsigned*)(p.ws + OFF_CTRL), nblk, epoch); }
        { const Params p = kp_load(kp_get()); char* ws = p.ws; (void)ws; unsigned* ctrl = (unsigned*)(p.ws + OFF_CTRL); (void)ctrl; ph_merge(p, l, smem, bid, nblk); }
        { const Params p = kp_load(kp_get()); grid_bar((unsigned*)(p.ws + OFF_CTRL), nblk, epoch); }
        { const Params p = kp_load(kp_get()); char* ws = p.ws; (void)ws; unsigned* ctrl = (unsigned*)(p.ws + OFF_CTRL); (void)ctrl; ph_wout(p, l, smem, bid, nblk); }
        { const Params p = kp_load(kp_get()); grid_bar((unsigned*)(p.ws + OFF_CTRL), nblk, epoch); }
        { const Params p = kp_load(kp_get()); char* ws = p.ws; (void)ws; unsigned* ctrl = (unsigned*)(p.ws + OFF_CTRL); (void)ctrl; ph_rmsnorm<false>(p.out, p.norm2_g + l * 1024, (u16*)(ws + OFF_H), nullptr, bid, nblk); }
        { const Params p = kp_load(kp_get()); grid_bar((unsigned*)(p.ws + OFF_CTRL), nblk, epoch); }
        { const Params p = kp_load(kp_get()); char* ws = p.ws; (void)ws; unsigned* ctrl = (unsigned*)(p.ws + OFF_CTRL); (void)ctrl; ph_peerq(p, l, smem, bid, nblk); }
        { const Params p = kp_load(kp_get()); grid_bar((unsigned*)(p.ws + OFF_CTRL), nblk, epoch); }
        { const Params p = kp_load(kp_get()); char* ws = p.ws; (void)ws; unsigned* ctrl = (unsigned*)(p.ws + OFF_CTRL); (void)ctrl; ph_peertop(p, l, smem, bid, nblk); }
        { const Params p = kp_load(kp_get()); grid_bar((unsigned*)(p.ws + OFF_CTRL), nblk, epoch); }
        { const Params p = kp_load(kp_get()); char* ws = p.ws; (void)ws; unsigned* ctrl = (unsigned*)(p.ws + OFF_CTRL); (void)ctrl; ph_peergather(p, p.norm2_g + l * 1024, smem, bid, nblk); }
        { const Params p = kp_load(kp_get()); grid_bar((unsigned*)(p.ws + OFF_CTRL), nblk, epoch); }
        if (l + 1 < NLAYER) {
            { const Params p = kp_load(kp_get()); char* ws = p.ws; (void)ws; unsigned* ctrl = (unsigned*)(p.ws + OFF_CTRL); (void)ctrl; ph_cvt(p.peer_u + (size_t)(l + 1) * NEXP * 1024, (u16*)(ws + OFF_PUV), (size_t)NEXP * 1024 / 4, bid, nblk); }
            { const Params p = kp_load(kp_get()); char* ws = p.ws; (void)ws; unsigned* ctrl = (unsigned*)(p.ws + OFF_CTRL); (void)ctrl; ph_cvt(p.peer_v + (size_t)(l + 1) * NEXP * 1024, (u16*)(ws + OFF_PUV) + (size_t)NEXP * 1024, (size_t)NEXP * 1024 / 4, bid, nblk); }
            { const Params p = kp_load(kp_get()); char* ws = p.ws; (void)ws; unsigned* ctrl = (unsigned*)(p.ws + OFF_CTRL); (void)ctrl; ph_rmsnorm<false>(p.out, p.norm1_g + (l + 1) * 1024, (u16*)(ws + OFF_H), nullptr, bid, nblk); }
            { const Params p = kp_load(kp_get()); grid_bar((unsigned*)(p.ws + OFF_CTRL), nblk, epoch); }
        }
    }

__global__ void __launch_bounds__(256, 2) mega(Params p) {
    extern __shared__ __attribute__((aligned(16))) char smem[];
    cg::grid_group grid = cg::this_grid();
    const int bid = blockIdx.x, nblk = gridDim.x;
    unsigned epoch = 0;
    { const Params p = kp_load(kp_get()); char* ws = p.ws; (void)ws; unsigned* ctrl = (unsigned*)(p.ws + OFF_CTRL); (void)ctrl; ph_tconv(p, smem, bid, nblk); }
    { const Params p = kp_load(kp_get()); char* ws = p.ws; (void)ws; unsigned* ctrl = (unsigned*)(p.ws + OFF_CTRL); (void)ctrl; ph_cvt(p.peer_sub_keys, (u16*)(ws + OFF_SUBK), (size_t)NLAYER * 2 * 128 * 128 / 4, bid, nblk); }
    { const Params p = kp_load(kp_get()); char* ws = p.ws; (void)ws; unsigned* ctrl = (unsigned*)(p.ws + OFF_CTRL); (void)ctrl; ph_misc(p, bid, nblk); }
    { const Params p = kp_load(kp_get()); char* ws = p.ws; (void)ws; unsigned* ctrl = (unsigned*)(p.ws + OFF_CTRL); (void)ctrl; ph_cvt(p.peer_u, (u16*)(ws + OFF_PUV), (size_t)NEXP * 1024 / 4, bid, nblk); }
    { const Params p = kp_load(kp_get()); char* ws = p.ws; (void)ws; unsigned* ctrl = (unsigned*)(p.ws + OFF_CTRL); (void)ctrl; ph_cvt(p.peer_v, (u16*)(ws + OFF_PUV) + (size_t)NEXP * 1024, (size_t)NEXP * 1024 / 4, bid, nblk); }
    { const Params p = kp_load(kp_get()); char* ws = p.ws; (void)ws; unsigned* ctrl = (unsigned*)(p.ws + OFF_CTRL); (void)ctrl; ph_rmsnorm<false>(p.x, p.norm1_g, (u16*)(ws + OFF_H), nullptr, bid, nblk); }
    grid.sync();
    layer_body<0>(smem, bid, nblk, epoch);
    layer_body<1>(smem, bid, nblk, epoch);
    { const Params p = kp_load(kp_get()); char* ws = p.ws; (void)ws; unsigned* ctrl = (unsigned*)(p.ws + OFF_CTRL); (void)ctrl; ph_rmsnorm<true>(p.out, p.final_g, nullptr, p.out, bid, nblk); }
}

extern "C" void kernel_launch(void* const* d_in, const int* in_sizes, int n_in, void* d_out, int out_size, void* d_ws, size_t ws_size, hipStream_t stream) {
    (void)in_sizes; (void)n_in; (void)out_size;
    if (ws_size < WS_NEED) { fprintf(stderr, "workspace too small: %zu < %zu\n", ws_size, (size_t)WS_NEED); return; }
    Params p{};
    p.x = (const float*)d_in[0]; p.norm1_g = (const float*)d_in[1]; p.w_in = (const float*)d_in[2]; p.fox_b_f = (const float*)d_in[3];
    p.lru_conv_w = (const float*)d_in[4]; p.lru_conv_b = (const float*)d_in[5]; p.lru_w_a = (const float*)d_in[6]; p.lru_b_a = (const float*)d_in[7];
    p.lru_w_x = (const float*)d_in[8]; p.lru_b_x = (const float*)d_in[9]; p.lru_lambda = (const float*)d_in[10];
    p.nsa_pe_k = (const float*)d_in[11]; p.nsa_pe_v = (const float*)d_in[12]; p.nsa_w1_k = (const float*)d_in[13]; p.nsa_w2_k = (const float*)d_in[14];
    p.nsa_w1_v = (const float*)d_in[15]; p.nsa_w2_v = (const float*)d_in[16];
    p.w_br_fox = (const float*)d_in[17]; p.w_br_lru = (const float*)d_in[18]; p.w_br_dil = (const float*)d_in[19]; p.w_br_nsa = (const float*)d_in[20];
    p.w_out = (const float*)d_in[21]; p.norm2_g = (const float*)d_in[22]; p.peer_w_q = (const float*)d_in[23]; p.peer_sub_keys = (const float*)d_in[24];
    p.peer_u = (const float*)d_in[25]; p.peer_v = (const float*)d_in[26]; p.final_g = (const float*)d_in[27];
    p.out = (float*)d_out; p.ws = (char*)d_ws;
    static int grid_blocks = 0;
    if (!grid_blocks) {
        int dev = 0, cus = 0, per_cu = 0;
        hipGetDevice(&dev);
        hipDeviceGetAttribute(&cus, hipDeviceAttributeMultiprocessorCount, dev);
        hipFuncSetAttribute((const void*)mega, hipFuncAttributeMaxDynamicSharedMemorySize, SMEM_BYTES);
        hipOccupancyMaxActiveBlocksPerMultiprocessor(&per_cu, mega, 256, SMEM_BYTES);
        if (per_cu > 2) per_cu = 2;
        if (per_cu < 1) per_cu = 1;
        grid_blocks = cus * per_cu;
    }
    hipMemsetAsync((char*)d_ws + OFF_CTRL, 0, 256, stream);
    void* args[] = {&p};
    hipError_t e = hipLaunchCooperativeKernel((void*)mega, dim3(grid_blocks), dim3(256), args, SMEM_BYTES, stream);
    if (e != hipSuccess) fprintf(stderr, "cooperative launch failed: %s (grid %d)\n", hipGetErrorString(e), grid_blocks);
}
```

```cpp
#include <hip/hip_runtime.h>
#include <cstdio>
#include <cstdint>
#define PROBE 0
#define PROBE_A 2
#define PROBE_A0 1
#define PROBE_DIV 1.f
#define STAMP(p_, k_) do { if (blockIdx.x == 0 && threadIdx.x == 0) ((unsigned long long*)((p_).ws + OFF_CTRL + 64))[k_] = wall_clock64(); } while (0)
#include <hip/hip_cooperative_groups.h>
namespace cg = cooperative_groups;

typedef unsigned short u16;
typedef short s16x8 __attribute__((ext_vector_type(8)));
typedef short s16x4 __attribute__((ext_vector_type(4)));
typedef float f32x4 __attribute__((ext_vector_type(4)));
typedef float f32x2 __attribute__((ext_vector_type(2)));
typedef unsigned u32x4 __attribute__((ext_vector_type(4)));
typedef unsigned u32x2 __attribute__((ext_vector_type(2)));
typedef int i32x4 __attribute__((ext_vector_type(4)));
typedef __bf16 bf16x2_t __attribute__((ext_vector_type(2)));
#define LAS __attribute__((address_space(3)))
#define DEVI __device__ __forceinline__

constexpr int NB = 4, SEQ = 8192, DM = 1024, NTOK = NB * SEQ, NLAYER = 2;
constexpr int PW = 3072;
constexpr int C_FQ = 0, C_FK = 256, C_FV = 512, C_LX = 768, C_LG = 1024, C_DQ = 1280, C_DK = 1664, C_DV = 2048,
              C_NQ = 2432, C_NKC = 2688, C_NVC = 2752, C_NKS = 2816, C_NVS = 2880, C_NKW = 2944, C_NVW = 3008;
constexpr int WIN_ROWS = 7296;
constexpr int WIN_GATE0 = 3200;
constexpr int IN_WIDTH = 7184;
constexpr int OW = 896;
constexpr int O_FOX = 0, O_LRU = 256, O_DIL = 512, O_NSA = 640;
constexpr int NEXP = 16384;

constexpr size_t SZ_WIN = (size_t)NLAYER * WIN_ROWS * 1024 * 2;
constexpr size_t SZ_WQ = (size_t)NLAYER * 2048 * 1024 * 2;
constexpr size_t SZ_WOUT = (size_t)NLAYER * 1024 * 1024 * 2;
constexpr size_t SZ_WBR = (size_t)NLAYER * 1024 * OW * 2;
constexpr size_t SZ_W1 = (size_t)NLAYER * 2 * 256 * 2048 * 2;
constexpr size_t SZ_W2 = (size_t)NLAYER * 2 * 64 * 256 * 2;
constexpr size_t SZ_B1 = (size_t)NLAYER * 2 * 256 * 4;
constexpr size_t SZ_SUBK = (size_t)NLAYER * 2 * 128 * 128 * 2;
constexpr size_t SZ_ROPE = (size_t)SEQ * 32 * 8;
constexpr size_t SZ_PUV = (size_t)2 * NEXP * 1024 * 2;
constexpr size_t SZ_H = (size_t)NTOK * 1024 * 2;
constexpr size_t SZ_P = (size_t)NTOK * PW * 2;
constexpr size_t SZ_FS = (size_t)NTOK * 16 * 4;
constexpr size_t SZ_NQR = (size_t)NTOK * 256 * 2;
constexpr size_t SZ_CUM = (size_t)NTOK * 4 * 4;
constexpr size_t SZ_LSUM = (size_t)2 * 512 * 256 * 4;
constexpr size_t SZ_HID = (size_t)2 * 2048 * 256 * 2;
constexpr size_t SZ_KVC = (size_t)2 * NB * 512 * 64 * 2;
constexpr size_t SZ_O = (size_t)NTOK * OW * 2;
constexpr size_t SZ_OC = (size_t)NTOK * 256 * 2;
constexpr size_t SZ_SEL = (size_t)NTOK * 4 * 4;

constexpr size_t OFF_WIN = 0;
constexpr size_t OFF_WQ = OFF_WIN + SZ_WIN;
constexpr size_t OFF_WOUT = OFF_WQ + SZ_WQ;
constexpr size_t OFF_WBR = OFF_WOUT + SZ_WOUT;
constexpr size_t OFF_W1 = OFF_WBR + SZ_WBR;
constexpr size_t OFF_W2 = OFF_W1 + SZ_W1;
constexpr size_t OFF_B1 = OFF_W2 + SZ_W2;
constexpr size_t OFF_SUBK = OFF_B1 + SZ_B1;
constexpr size_t OFF_ROPE = OFF_SUBK + SZ_SUBK;
constexpr size_t OFF_PUV = OFF_ROPE + SZ_ROPE;
constexpr size_t OFF_H = OFF_PUV + SZ_PUV;
constexpr size_t OFF_P = OFF_H + SZ_H;
constexpr size_t OFF_FS = OFF_P + SZ_P;
constexpr size_t OFF_NQR = OFF_FS + SZ_FS;
constexpr size_t OFF_CUM = OFF_NQR + SZ_NQR;
constexpr size_t OFF_LSUM = OFF_CUM + SZ_CUM;
constexpr size_t OFF_HID = OFF_LSUM + SZ_LSUM;
constexpr size_t OFF_KVC = OFF_HID + SZ_HID;
constexpr size_t OFF_O = OFF_KVC + SZ_KVC;
constexpr size_t OFF_OC = OFF_O + SZ_O;
constexpr size_t OFF_SEL = OFF_OC + SZ_OC;
constexpr size_t OFF_CTRL = OFF_SEL + SZ_SEL;
constexpr size_t OFF_XBAR = OFF_CTRL + 1024;
constexpr size_t OFF_FLAGS = OFF_XBAR + 16384;
constexpr size_t OFF_LRUF = OFF_FLAGS + 8192;
constexpr size_t OFF_PSC = OFF_LRUF + (size_t)NLAYER * 2 * 4 * 4 * 2 * 64 * 16;
constexpr size_t OFF_WI8 = OFF_PSC + (size_t)NLAYER * 2 * NEXP * 4;
constexpr size_t OFF_SWI = OFF_WI8 + (size_t)NLAYER * WIN_ROWS * 1024;
constexpr size_t OFF_WQ8 = OFF_SWI + (size_t)NLAYER * WIN_ROWS * 4;
constexpr size_t OFF_SWQ = OFF_WQ8 + (size_t)NLAYER * 2048 * 1024;
constexpr size_t WS_NEED = OFF_SWQ + (size_t)NLAYER * 2048 * 4;
static_assert(WS_NEED <= (size_t)512 * 1024 * 1024, "workspace over 512 MiB");
constexpr size_t OFF_MERGED = OFF_P;
constexpr size_t OFF_QP = OFF_P + (size_t)NTOK * 1024 * 2;
static_assert(OFF_QP + (size_t)NTOK * 2048 * 2 <= OFF_P + SZ_P, "alias");
constexpr size_t OFF_PIDX = OFF_H;
constexpr size_t OFF_PGW = OFF_H + (size_t)NTOK * 128 * 4;
static_assert(OFF_PGW + (size_t)NTOK * 128 * 4 <= OFF_H + SZ_H, "alias");
constexpr size_t OFF_H1Q = OFF_H;
constexpr size_t OFF_H1S = OFF_H + (size_t)NTOK * 1024;
constexpr size_t OFF_PW = OFF_PGW + (size_t)NTOK * 128 * 4;
constexpr size_t OFF_PWS = OFF_PW + (size_t)NTOK * 128;
static_assert(OFF_PW + (size_t)NTOK * 128 * 4 <= OFF_H + SZ_H, "alias");
constexpr size_t OFF_PART = OFF_QP;
constexpr size_t OFF_HQ = OFF_O;
constexpr size_t OFF_HS = OFF_O + (size_t)NTOK * 1024;
static_assert(OFF_HS + (size_t)NTOK * 4 <= OFF_O + SZ_O, "alias");

struct Params {
    const float* x; const float* norm1_g; const float* w_in; const float* fox_b_f;
    const float* lru_conv_w; const float* lru_conv_b; const float* lru_w_a; const float* lru_b_a;
    const float* lru_w_x; const float* lru_b_x; const float* lru_lambda;
    const float* nsa_pe_k; const float* nsa_pe_v; const float* nsa_w1_k; const float* nsa_w2_k;
    const float* nsa_w1_v; const float* nsa_w2_v;
    const float* w_br_fox; const float* w_br_lru; const float* w_br_dil; const float* w_br_nsa;
    const float* w_out; const float* norm2_g; const float* peer_w_q; const float* peer_sub_keys;
    const float* peer_u; const float* peer_v; const float* final_g;
    float* out; char* ws;
};

typedef const __attribute__((address_space(4))) Params* KP;
DEVI KP kp_get() { unsigned long long a = (unsigned long long)__builtin_amdgcn_kernarg_segment_ptr(); asm volatile("" : "+s"(a)); return (KP)a; }
DEVI Params kp_load(KP k) { Params r;
    r.x = k->x;
    r.norm1_g = k->norm1_g;
    r.w_in = k->w_in;
    r.fox_b_f = k->fox_b_f;
    r.lru_conv_w = k->lru_conv_w;
    r.lru_conv_b = k->lru_conv_b;
    r.lru_w_a = k->lru_w_a;
    r.lru_b_a = k->lru_b_a;
    r.lru_w_x = k->lru_w_x;
    r.lru_b_x = k->lru_b_x;
    r.lru_lambda = k->lru_lambda;
    r.nsa_pe_k = k->nsa_pe_k;
    r.nsa_pe_v = k->nsa_pe_v;
    r.nsa_w1_k = k->nsa_w1_k;
    r.nsa_w2_k = k->nsa_w2_k;
    r.nsa_w1_v = k->nsa_w1_v;
    r.nsa_w2_v = k->nsa_w2_v;
    r.w_br_fox = k->w_br_fox;
    r.w_br_lru = k->w_br_lru;
    r.w_br_dil = k->w_br_dil;
    r.w_br_nsa = k->w_br_nsa;
    r.w_out = k->w_out;
    r.norm2_g = k->norm2_g;
    r.peer_w_q = k->peer_w_q;
    r.peer_sub_keys = k->peer_sub_keys;
    r.peer_u = k->peer_u;
    r.peer_v = k->peer_v;
    r.final_g = k->final_g;
    r.out = k->out;
    r.ws = k->ws;
    return r; }
#define XR_OF(p) ((u16*)((char*)(p).out + (size_t)NTOK * DM * 2))
DEVI void block_sync() { asm volatile("s_waitcnt lgkmcnt(0)" ::: "memory"); __syncthreads(); }
DEVI int tid_opaque() { int t = threadIdx.x; asm volatile("" : "+v"(t)); return t; }
DEVI unsigned pk2(float a, float b) { f32x2 v = {a, b}; bf16x2_t r = __builtin_convertvector(v, bf16x2_t); return __builtin_bit_cast(unsigned, r); }
DEVI u16 f2bf(float a) { return (u16)(pk2(a, 0.f) & 0xffffu); }
DEVI float bf2f(u16 h) { return __uint_as_float(((unsigned)h) << 16); }
DEVI float bflo(unsigned w) { return __uint_as_float(w << 16); }
DEVI float bfhi(unsigned w) { return __uint_as_float(w & 0xffff0000u); }
DEVI float sigmoidf_(float x) { return __builtin_amdgcn_rcpf(1.f + __expf(-x)); }
DEVI float gelu_tanh(float x) { float u = 0.7978845608028654f * (x + 0.044715f * x * x * x); return x * __builtin_amdgcn_rcpf(1.f + __expf(-2.f * u)); }
DEVI f32x4 mfma16(s16x8 a, s16x8 b, f32x4 c) { return __builtin_amdgcn_mfma_f32_16x16x32_bf16(a, b, c, 0, 0, 0); }
DEVI float wave_sum(float v) {
#pragma unroll
    for (int o = 32; o > 0; o >>= 1) v += __shfl_xor(v, o);
    return v;
}
DEVI unsigned wave_max_u32(unsigned v) {
#pragma unroll
    for (int o = 32; o > 0; o >>= 1) { unsigned t = (unsigned)__shfl_xor((int)v, o); v = v > t ? v : t; }
    return v;
}

DEVI void glds16(const void* src, char* lds_wave_base) {
    __builtin_amdgcn_global_load_lds((const __attribute__((address_space(1))) void*)src, (__attribute__((address_space(3))) void*)lds_wave_base, 16, 0, 0);
}
template <int BM, int BN>
DEVI void gemm_mainloop(const u16* __restrict__ A, size_t lda, size_t a_kstride, const u16* __restrict__ Bt, size_t ldb, int K,
                        int m0, int n0, char* smem, f32x4 (&acc)[BM / 32][BN / 32]) {
    constexpr int MT = BM / 32, NT = BN / 32, AG = BM / 32, BG = BN / 32;
    constexpr int A_BYTES = BM * 128, STAGE = (BM + BN) * 128;
    const int tid = tid_opaque(), lane = tid & 63, w = __builtin_amdgcn_readfirstlane(tid >> 6), wm = w >> 1, wn = w & 1, g = lane >> 4, c = lane & 15;
    const int r8 = lane >> 3, cp = lane & 7;
    const u16* asrc[AG]; const u16* bsrc[BG];
#pragma unroll
    for (int i = 0; i < AG; ++i) asrc[i] = A + (size_t)(m0 + 8 * (w * AG + i) + r8) * lda + ((cp ^ r8) * 8);
#pragma unroll
    for (int i = 0; i < BG; ++i) bsrc[i] = Bt + (size_t)(n0 + 8 * (w * BG + i) + r8) * ldb + ((cp ^ r8) * 8);
    const int nk = K / 64;
#pragma unroll
    for (int i = 0; i < AG; ++i) glds16(asrc[i], smem + (w * AG + i) * 1024);
#pragma unroll
    for (int i = 0; i < BG; ++i) glds16(bsrc[i], smem + A_BYTES + (w * BG + i) * 1024);
    for (int kt = 0; kt < nk; ++kt) {
        asm volatile("s_waitcnt vmcnt(0)" ::: "memory");
        block_sync();
        if (kt + 1 < nk) {
            char* dA = smem + ((kt + 1) & 1) * STAGE; char* dB = dA + A_BYTES;
#pragma unroll
            for (int i = 0; i < AG; ++i) glds16(asrc[i] + (size_t)(kt + 1) * a_kstride, dA + (w * AG + i) * 1024);
#pragma unroll
            for (int i = 0; i < BG; ++i) glds16(bsrc[i] + (size_t)(kt + 1) * 64, dB + (w * BG + i) * 1024);
        }
        const char* sA = smem + (kt & 1) * STAGE; const char* sB = sA + A_BYTES;
#pragma unroll
        for (int ks = 0; ks < 2; ++ks) {
            s16x8 af[MT], bfr[NT];
#pragma unroll
            for (int mt = 0; mt < MT; ++mt) { int row = wm * (BM / 2) + 16 * mt + c; af[mt] = *(const s16x8*)(sA + row * 128 + (((4 * ks + g) ^ (row & 7)) << 4)); }
#pragma unroll
            for (int nt = 0; nt < NT; ++nt) { int row = wn * (BN / 2) + 16 * nt + c; bfr[nt] = *(const s16x8*)(sB + row * 128 + (((4 * ks + g) ^ (row & 7)) << 4)); }
#pragma unroll
            for (int mt = 0; mt < MT; ++mt)
#pragma unroll
                for (int nt = 0; nt < NT; ++nt) acc[mt][nt] = mfma16(bfr[nt], af[mt], acc[mt][nt]);
        }
    }
    block_sync();
}
template <int MT, int NT> DEVI void acc_zero(f32x4 (&acc)[MT][NT]) {
#pragma unroll
    for (int i = 0; i < MT; ++i)
#pragma unroll
        for (int j = 0; j < NT; ++j) acc[i][j] = (f32x4){0.f, 0.f, 0.f, 0.f};
}
struct GJob { const char* A; size_t lda, aks; const char* Bt; size_t ldb; int nk, m0, n0; bool i8; };
template <int BM, int BN, bool FRAGALL, class JobFn, class EpiFn>
DEVI void gemm_stream(char* smem, int j0, int jstep, int jend, JobFn&& jobfn, EpiFn&& epi) {
    constexpr int MT = BM / 32, NT = BN / 32, AG = BM / 32, BG = BN / 32;
    constexpr int A_BYTES = BM * 128, STAGE = (BM + BN) * 128;
    if (j0 >= jend) return;
    const int tid = tid_opaque(), lane = tid & 63, w = __builtin_amdgcn_readfirstlane(tid >> 6), wm = w >> 1, wn = w & 1, g = lane >> 4, c = lane & 15;
    const int r8 = lane >> 3, cp = lane & 7;
    GJob cur = jobfn(j0);
    const char* a0 = cur.A + (size_t)(cur.m0 + 8 * (w * AG) + r8) * cur.lda + ((cp ^ r8) * 16);
    const char* b0 = cur.Bt + (size_t)(cur.n0 + 8 * (w * BG) + r8) * cur.ldb + ((cp ^ r8) * 16);
    block_sync();
#pragma unroll
    for (int i = 0; i < AG; ++i) glds16(a0 + (size_t)i * 8 * cur.lda, smem + (w * AG + i) * 1024);
#pragma unroll
    for (int i = 0; i < BG; ++i) glds16(b0 + (size_t)i * 8 * cur.ldb, smem + A_BYTES + (w * BG + i) * 1024);
    int st = 0;
    for (int j = j0; j < jend; j += jstep) {
        f32x4 acc[MT][NT]; acc_zero(acc);
        const int nk = cur.nk; const bool i8 = cur.i8;
        const bool hasnext = j + jstep < jend;
        for (int kt = 0; kt < nk; ++kt) {
            asm volatile("s_waitcnt vmcnt(0)" ::: "memory");
            block_sync();
            char* dA = smem + (st ^ 1) * STAGE; char* dB = dA + A_BYTES;
            if (kt + 1 < nk) {
#pragma unroll
                for (int i = 0; i < AG; ++i) glds16(a0 + (size_t)i * 8 * cur.lda + (size_t)(kt + 1) * cur.aks, dA + (w * AG + i) * 1024);
#pragma unroll
                for (int i = 0; i < BG; ++i) glds16(b0 + (size_t)i * 8 * cur.ldb + (size_t)(kt + 1) * 128, dB + (w * BG + i) * 1024);
            } else if (hasnext) {
                cur = jobfn(j + jstep);
                a0 = cur.A + (size_t)(cur.m0 + 8 * (w * AG) + r8) * cur.lda + ((cp ^ r8) * 16);
                b0 = cur.Bt + (size_t)(cur.n0 + 8 * (w * BG) + r8) * cur.ldb + ((cp ^ r8) * 16);
#pragma unroll
                for (int i = 0; i < AG; ++i) glds16(a0 + (size_t)i * 8 * cur.lda, dA + (w * AG + i) * 1024);
#pragma unroll
                for (int i = 0; i < BG; ++i) glds16(b0 + (size_t)i * 8 * cur.ldb, dB + (w * BG + i) * 1024);
            }
            const char* sA = smem + st * STAGE; const char* sB = sA + A_BYTES;
            if (FRAGALL) {
                s16x8 af[2][MT], bfr[2][NT];
#pragma unroll
                for (int ks = 0; ks < 2; ++ks) {
#pragma unroll
                    for (int mt = 0; mt < MT; ++mt) { int row = wm * (BM / 2) + 16 * mt + c; af[ks][mt] = *(const s16x8*)(sA + row * 128 + (((4 * ks + g) ^ (row & 7)) << 4)); }
#pragma unroll
                    for (int nt = 0; nt < NT; ++nt) { int row = wn * (BN / 2) + 16 * nt + c; bfr[ks][nt] = *(const s16x8*)(sB + row * 128 + (((4 * ks + g) ^ (row & 7)) << 4)); }
                }
                __builtin_amdgcn_sched_barrier(0);
                __builtin_amdgcn_s_setprio(1);
                if (i8) {
#pragma unroll
                    for (int ks = 0; ks < 2; ++ks)
#pragma unroll
                        for (int mt = 0; mt < MT; ++mt)
#pragma unroll
                            for (int nt = 0; nt < NT; ++nt)
                                acc[mt][nt] = __builtin_bit_cast(f32x4, __builtin_amdgcn_mfma_i32_16x16x64_i8(__builtin_bit_cast(i32x4, bfr[ks][nt]), __builtin_bit_cast(i32x4, af[ks][mt]), __builtin_bit_cast(i32x4, acc[mt][nt]), 0, 0, 0));
                } else {
#pragma unroll
                    for (int ks = 0; ks < 2; ++ks)
#pragma unroll
                        for (int mt = 0; mt < MT; ++mt)
#pragma unroll
                            for (int nt = 0; nt < NT; ++nt) acc[mt][nt] = mfma16(bfr[ks][nt], af[ks][mt], acc[mt][nt]);
                }
                __builtin_amdgcn_s_setprio(0);
            } else {
#pragma unroll
                for (int ks = 0; ks < 2; ++ks) {
                    s16x8 af[MT], bfr[NT];
#pragma unroll
                    for (int mt = 0; mt < MT; ++mt) { int row = wm * (BM / 2) + 16 * mt + c; af[mt] = *(const s16x8*)(sA + row * 128 + (((4 * ks + g) ^ (row & 7)) << 4)); }
#pragma unroll
                    for (int nt = 0; nt < NT; ++nt) { int row = wn * (BN / 2) + 16 * nt + c; bfr[nt] = *(const s16x8*)(sB + row * 128 + (((4 * ks + g) ^ (row & 7)) << 4)); }
                    if (i8) {
#pragma unroll
                        for (int mt = 0; mt < MT; ++mt)
#pragma unroll
                            for (int nt = 0; nt < NT; ++nt)
                                acc[mt][nt] = __builtin_bit_cast(f32x4, __builtin_amdgcn_mfma_i32_16x16x64_i8(__builtin_bit_cast(i32x4, bfr[nt]), __builtin_bit_cast(i32x4, af[mt]), __builtin_bit_cast(i32x4, acc[mt][nt]), 0, 0, 0));
                    } else {
#pragma unroll
                        for (int mt = 0; mt < MT; ++mt)
#pragma unroll
                            for (int nt = 0; nt < NT; ++nt) acc[mt][nt] = mfma16(bfr[nt], af[mt], acc[mt][nt]);
                    }
                }
            }
            st ^= 1;
        }
        epi(j, acc);
    }
    asm volatile("s_waitcnt vmcnt(0)" ::: "memory");
    block_sync();
}
constexpr int SMEM_BYTES = 69632 + 16;

#define XB_TMO      128
#define XB_XCNT(j)  (256  + 64 * (j))
#define XB_XSUB(j)  (1280 + 64 * (j))
#define XB_XGEN(j)  (2304 + 64 * (j))
#define XB_TOP      3328
#define XB_TOPGEN   3392
#define XCD_BAR_WORDS 3456
#define XB_SPIN_CAP (1u << 22)
DEVI unsigned xb_ld(unsigned* p) { return __hip_atomic_load(p, __ATOMIC_RELAXED, __HIP_MEMORY_SCOPE_AGENT); }
DEVI unsigned xb_add(unsigned* p, unsigned v) { return __hip_atomic_fetch_add(p, v, __ATOMIC_RELAXED, __HIP_MEMORY_SCOPE_AGENT); }
DEVI unsigned xb_xcc_id() { return (unsigned)__builtin_amdgcn_s_getreg((3 << 11) | 20) & 0xFu; }
#define XB_SPIN(cond, bar) do { unsigned _sp = 0; while (cond) { __builtin_amdgcn_s_sleep(1); \
    if ((++_sp & 255u) == 0u) { if (xb_ld(&(bar)[XB_TMO])) break; if (_sp > XB_SPIN_CAP) { atomicAdd(&(bar)[XB_TMO], 1u); break; } } } } while (0)
DEVI void xcd_barrier_complete(unsigned* bar, unsigned x, unsigned& nloc, unsigned& nx) {
    const unsigned G = gridDim.x;
    unsigned sum, cnt, mine, sp = 0u;
    for (;;) {
        sum = 0u; cnt = 0u; mine = 0u;
#pragma unroll
        for (unsigned j = 0; j < 16; ++j) { const unsigned c = xb_ld(&bar[XB_XCNT(j)]); sum += c; cnt += (c > 0u) ? 1u : 0u; mine = (j == x) ? c : mine; }
        if (sum == G) break;
        __builtin_amdgcn_s_sleep(1);
        if ((++sp & 255u) == 0u) { if (xb_ld(&bar[XB_TMO])) break; if (sp > XB_SPIN_CAP) { atomicAdd(&bar[XB_TMO], 1u); break; } }
    }
    nloc = mine > 0u ? mine : 1u; nx = cnt > 0u ? cnt : 1u;
    unsigned low = 0u;
#pragma unroll
    for (unsigned j = 0; j < 8; ++j) low += xb_ld(&bar[XB_XCNT(j)]);
    if (nx == 8u && low == G) nx |= 0x100u;
}
DEVI void grid_bar(char* ws, char* smem, unsigned& epoch) {
    unsigned* bar = (unsigned*)(ws + OFF_XBAR);
    volatile LAS unsigned* st = (volatile LAS unsigned*)(smem + SMEM_BYTES - 16);
    asm volatile("s_waitcnt vmcnt(0) lgkmcnt(0)" ::: "memory");
    __syncthreads();
    epoch += 1;
    if (threadIdx.x == 0) {
        const unsigned x = xb_xcc_id();
        unsigned nloc = st[0], nx = st[1];
        if (nloc == 0u) { xcd_barrier_complete(bar, x, nloc, nx); st[0] = nloc; st[1] = nx; }
        nx &= 0xffu;
        const unsigned old = xb_add(&bar[XB_XSUB(x)], 1u);
        const unsigned gen = old / nloc;
        if (old + 1u == (gen + 1u) * nloc) {
            __builtin_amdgcn_fence(__ATOMIC_RELEASE, "agent");
            asm volatile("s_waitcnt vmcnt(0)" ::: "memory");
            const unsigned og = xb_add(&bar[XB_TOP], 1u);
            const unsigned tg = og / nx;
            if (og + 1u == (tg + 1u) * nx) xb_add(&bar[XB_TOPGEN], 1u);
            else XB_SPIN(xb_ld(&bar[XB_TOPGEN]) == tg, bar);
            __builtin_amdgcn_fence(__ATOMIC_ACQUIRE, "agent");
            xb_add(&bar[XB_XGEN(x)], 1u);
            asm volatile("s_waitcnt vmcnt(0)" ::: "memory");
        } else {
            XB_SPIN(xb_ld(&bar[XB_XGEN(x)]) == gen, bar);
            __builtin_amdgcn_fence(__ATOMIC_ACQUIRE, "agent");
            asm volatile("s_waitcnt vmcnt(0)" ::: "memory");
        }
#if PROBE
        if (blockIdx.x == 0) ((unsigned long long*)(ws + OFF_CTRL + 64))[epoch] = wall_clock64();
#endif
    }
    __syncthreads();
}

struct XccInfo { int s0, sstep, t0, tstep; };
DEVI XccInfo xcc_info(char* smem, int bid, int nblk) {
    volatile LAS unsigned* st = (volatile LAS unsigned*)(smem + SMEM_BYTES - 16);
    const unsigned nloc = st[0], nxf = st[1], rank = st[2];
    XccInfo r;
    if (nxf & 0x100u) { r.s0 = (int)xb_xcc_id(); r.sstep = 8; r.t0 = (int)rank; r.tstep = (int)nloc; }
    else { r.s0 = 0; r.sstep = 1; r.t0 = bid; r.tstep = nblk; }
    return r;
}
struct TileMap { int j0, jstep, jend, ntn, x; bool loc; };
DEVI TileMap tile_map(char* smem, int bid, int nblk, int ntm, int ntn) {
    const XccInfo xi = xcc_info(smem, bid, nblk);
    TileMap t; t.ntn = ntn;
    if (xi.sstep == 8) { t.loc = true; t.x = xi.s0; t.j0 = xi.t0; t.jstep = xi.tstep; t.jend = (ntm / 8) * ntn; }
    else { t.loc = false; t.x = 0; t.j0 = bid; t.jstep = nblk; t.jend = ntm * ntn; }
    return t;
}
DEVI void tile_decode(const TileMap& t, int j, int& mt, int& nt) { const int q = j / t.ntn; nt = j - q * t.ntn; mt = t.loc ? q * 8 + t.x : q; }
DEVI int win_map(int n) {
    if (n < 768) return n;
    if (n < 3072) return n + 4;
    if (n < 3076) return 768 + (n - 3072);
    if (n < 3088) return n;
    if (n < WIN_GATE0) return -1;
    return n - (WIN_GATE0 - 3088);
}
DEVI void tconv_tile(const float* __restrict__ src, int src_ld, int K, u16* __restrict__ dst, int dst_ld, int ndst, int mode, int tidx, char* smem) {
    float (*tile)[65] = (float (*)[65])smem;
    const int tiles_n = ndst / 64;
    const int kt = tidx / tiles_n, nt = tidx % tiles_n;
    const int tx = threadIdx.x & 63, ty = threadIdx.x >> 6;
    const int n = nt * 64 + tx;
    const int sc = mode == 1 ? win_map(n) : n;
    block_sync();
#pragma unroll
    for (int i = 0; i < 16; ++i) { int k = kt * 64 + ty * 16 + i; tile[ty * 16 + i][tx] = sc >= 0 ? src[(size_t)k * src_ld + sc] : 0.f; }
    block_sync();
#pragma unroll
    for (int i = 0; i < 16; ++i) { int nn = ty * 16 + i; dst[(size_t)(nt * 64 + nn) * dst_ld + kt * 64 + tx] = f2bf(tile[tx][nn]); }
}
constexpr int TC_WIN = 16 * (WIN_ROWS / 64), TC_WQ = 16 * 32, TC_WOUT = 16 * 16, TC_BR4 = 4 * 16, TC_BR2 = 2 * 16, TC_W1 = 32 * 4, TC_W2 = 4;
constexpr int TC_LAYER = TC_WIN + TC_WQ + TC_WOUT + 3 * TC_BR4 + TC_BR2 + 2 * TC_W1 + 2 * TC_W2;
DEVI void ph_tconv(const Params& p, char* smem, int bid, int nblk) {
    char* ws = p.ws;
    for (int it = bid; it < NLAYER * TC_LAYER; it += nblk) {
        const int l = it / TC_LAYER; int r = it % TC_LAYER;
        u16* wbr = (u16*)(ws + OFF_WBR) + (size_t)l * 1024 * OW;
        if (r < TC_WIN) { tconv_tile(p.w_in + (size_t)l * 1024 * IN_WIDTH, IN_WIDTH, 1024, (u16*)(ws + OFF_WIN) + (size_t)l * WIN_ROWS * 1024, 1024, WIN_ROWS, 1, r, smem); continue; }
        r -= TC_WIN;
        if (r < TC_WQ) { tconv_tile(p.peer_w_q + (size_t)l * 1024 * 2048, 2048, 1024, (u16*)(ws + OFF_WQ) + (size_t)l * 2048 * 1024, 1024, 2048, 0, r, smem); continue; }
        r -= TC_WQ;
        if (r < TC_WOUT) { tconv_tile(p.w_out + (size_t)l * 1024 * 1024, 1024, 1024, (u16*)(ws + OFF_WOUT) + (size_t)l * 1024 * 1024, 1024, 1024, 0, r, smem); continue; }
        r -= TC_WOUT;
        if (r < TC_BR4) { tconv_tile(p.w_br_fox + (size_t)l * 256 * 1024, 1024, 256, wbr + O_FOX, OW, 1024, 0, r, smem); continue; }
        r -= TC_BR4;
        if (r < TC_BR4) { tconv_tile(p.w_br_lru + (size_t)l * 256 * 1024, 1024, 256, wbr + O_LRU, OW, 1024, 0, r, smem); continue; }
        r -= TC_BR4;
        if (r < TC_BR2) { tconv_tile(p.w_br_dil + (size_t)l * 128 * 1024, 1024, 128, wbr + O_DIL, OW, 1024, 0, r, smem); continue; }
        r -= TC_BR2;
        if (r < TC_BR4) { tconv_tile(p.w_br_nsa + (size_t)l * 256 * 1024, 1024, 256, wbr + O_NSA, OW, 1024, 0, r, smem); continue; }
        r -= TC_BR4;
        if (r < 2 * TC_W1) { const int z = r / TC_W1; const float* w1 = (z ? p.nsa_w1_v : p.nsa_w1_k) + (size_t)l * 2048 * 256;
            tconv_tile(w1, 256, 2048, (u16*)(ws + OFF_W1) + (size_t)(l * 2 + z) * 256 * 2048, 2048, 256, 0, r % TC_W1, smem); continue; }
        r -= 2 * TC_W1;
        { const int z = r / TC_W2; const float* w2 = (z ? p.nsa_w2_v : p.nsa_w2_k) + (size_t)l * 256 * 64;
            tconv_tile(w2, 64, 256, (u16*)(ws + OFF_W2) + (size_t)(l * 2 + z) * 64 * 256, 256, 64, 0, r % TC_W2, smem); }
    }
}
DEVI void ph_cvt(const float* __restrict__ src, u16* __restrict__ dst, size_t n4, int bid, int nblk) {
    for (size_t i = (size_t)bid * 256 + threadIdx.x; i < n4; i += (size_t)nblk * 256) {
        f32x4 v = *(const f32x4*)(src + i * 4);
        u32x2 o = {pk2(v[0], v[1]), pk2(v[2], v[3])};
        *(u32x2*)(dst + i * 4) = o;
    }
}
DEVI void ph_bias1(const Params& p, char* smem, int bid, int nblk) {
    float* red = (float*)smem;
    const int lane = threadIdx.x & 63, w = threadIdx.x >> 6;
    for (int it = bid; it < NLAYER * 2 * 4; it += nblk) {
        const int ng = it & 3, z = (it >> 2) & 1, l = it >> 3, n = ng * 64 + lane;
        const float* pe = (z ? p.nsa_pe_v : p.nsa_pe_k) + (size_t)l * 2048 + w * 512;
        const float* w1 = (z ? p.nsa_w1_v : p.nsa_w1_k) + (size_t)l * 2048 * 256 + (size_t)w * 512 * 256 + n;
        float a = 0.f;
        for (int k = 0; k < 512; k += 16) {
            float wv[16];
#pragma unroll
            for (int j = 0; j < 16; ++j) wv[j] = w1[(size_t)(k + j) * 256];
#pragma unroll
            for (int j = 0; j < 16; ++j) a += pe[k + j] * wv[j];
        }
        block_sync();
        red[w * 64 + lane] = a;
        block_sync();
        if (w == 0) ((float*)(p.ws + OFF_B1))[(l * 2 + z) * 256 + n] = (red[lane] + red[64 + lane]) + (red[128 + lane] + red[192 + lane]);
    }
}
DEVI void ph_lrufrag(const Params& p, int bid, int nblk) {
    for (int i = bid * 256 + threadIdx.x; i < NLAYER * 2 * 4 * 4 * 2 * 64; i += nblk * 256) {
        const int lane = i & 63, ks = (i >> 6) & 1, nt = (i >> 7) & 3, nb = (i >> 9) & 3, mat = (i >> 11) & 1, l = i >> 12;
        const int g = lane >> 4, c = lane & 15, k0 = 32 * ks + 8 * g, dd = 16 * nt + c;
        const float* W = (mat ? p.lru_w_x : p.lru_w_a) + (size_t)l * 4 * 64 * 64 + (size_t)nb * 64 * 64;
        u32x4 f = {pk2(W[(k0 + 0) * 64 + dd], W[(k0 + 1) * 64 + dd]), pk2(W[(k0 + 2) * 64 + dd], W[(k0 + 3) * 64 + dd]), pk2(W[(k0 + 4) * 64 + dd], W[(k0 + 5) * 64 + dd]), pk2(W[(k0 + 6) * 64 + dd], W[(k0 + 7) * 64 + dd])};
        *(u32x4*)(p.ws + OFF_LRUF + (size_t)i * 16) = f;
    }
}
DEVI void ph_misc(const Params& p, int bid, int nblk) {
    for (int gid = bid * 256 + threadIdx.x; gid < SEQ * 32; gid += nblk * 256) {
        const int s = gid >> 5, i = gid & 31;
        const float freq = powf(10000.0f, -(float)i / 32.0f);
        const float ang = (float)s * freq;
        const double rev = (double)ang * 0.15915494309189535;
        const float fr = (float)(rev - floor(rev));
        f32x2 cs = {__builtin_amdgcn_cosf(fr), __builtin_amdgcn_sinf(fr)};
        *(f32x2*)(p.ws + OFF_ROPE + (size_t)gid * 8) = cs;
    }
}


DEVI void ph_quant(const Params& p, int bid, int nblk) {
    const int lane = tid_opaque() & 63, w = threadIdx.x >> 6;
    unsigned char* Q = (unsigned char*)(p.ws + OFF_PUV); float* SC = (float*)(p.ws + OFF_PSC);
    for (int r = bid * 4 + w; r < NLAYER * 2 * NEXP; r += nblk * 4) {
        const int e = r & (NEXP - 1), kind = (r >> 14) & 1, l = r >> 15;
        const float* src = (kind ? p.peer_v : p.peer_u) + ((size_t)l * NEXP + e) * 1024 + 16 * lane;
        f32x4 v[4]; float am = 0.f;
#pragma unroll
        for (int i = 0; i < 4; ++i) { v[i] = *(const f32x4*)(src + 4 * i);
#pragma unroll
            for (int j = 0; j < 4; ++j) am = fmaxf(am, fabsf(v[i][j])); }
#pragma unroll
        for (int o = 32; o > 0; o >>= 1) am = fmaxf(am, __shfl_xor(am, o));
        const float inv = am > 0.f ? 127.f / am : 0.f;
        const int off = 0;
        u32x4 pk;
#pragma unroll
        for (int i = 0; i < 4; ++i) {
            unsigned wv = 0;
#pragma unroll
            for (int j = 0; j < 4; ++j) { const int q = (int)rintf(v[i][j] * inv) + off; wv |= ((unsigned)q & 0xffu) << (8 * j); }
            pk[i] = wv;
        }
        *(u32x4*)(Q + (((size_t)(l * 2 + kind) * 8 + (lane >> 3)) * NEXP + e) * 128 + 16 * (lane & 7)) = pk;
        if (lane == 0) SC[(size_t)(l * 2 + kind) * NEXP + e] = am * (1.f / 127.f);
    }
}
DEVI void ph_wquant(const Params& p, int bid, int nblk) {
    const int lane = tid_opaque() & 63, w = threadIdx.x >> 6;
    constexpr int NR = NLAYER * WIN_ROWS + NLAYER * 2048;
    for (int r = bid * 4 + w; r < NR; r += nblk * 4) {
        const u16* src; char* dst; float* sc;
        if (r < NLAYER * WIN_ROWS) { src = (const u16*)(p.ws + OFF_WIN) + (size_t)r * 1024; dst = p.ws + OFF_WI8 + (size_t)r * 1024; sc = (float*)(p.ws + OFF_SWI) + r; }
        else { const int q = r - NLAYER * WIN_ROWS; src = (const u16*)(p.ws + OFF_WQ) + (size_t)q * 1024; dst = p.ws + OFF_WQ8 + (size_t)q * 1024; sc = (float*)(p.ws + OFF_SWQ) + q; }
        const u32x4 a = *(const u32x4*)(src + 16 * lane), b2 = *(const u32x4*)(src + 16 * lane + 8);
        float v[16];
#pragma unroll
        for (int i = 0; i < 4; ++i) { v[2 * i] = bflo(a[i]); v[2 * i + 1] = bfhi(a[i]); v[8 + 2 * i] = bflo(b2[i]); v[8 + 2 * i + 1] = bfhi(b2[i]); }
        float am = 0.f;
#pragma unroll
        for (int i = 0; i < 16; ++i) am = fmaxf(am, fabsf(v[i]));
#pragma unroll
        for (int o = 32; o > 0; o >>= 1) am = fmaxf(am, __shfl_xor(am, o));
        const float inv = am > 0.f ? 127.f / am : 0.f;
        u32x4 pk;
#pragma unroll
        for (int i = 0; i < 4; ++i) {
            unsigned wv = 0;
#pragma unroll
            for (int j = 0; j < 4; ++j) { const int q = (int)rintf(v[4 * i + j] * inv); wv |= ((unsigned)q & 0xffu) << (8 * j); }
            pk[i] = wv;
        }
        *(u32x4*)(dst + 16 * lane) = pk;
        if (lane == 0) *sc = am * (1.f / 127.f);
    }
}
template <bool BF>
DEVI void ph_rmsq(const void* __restrict__ x, const float* __restrict__ gam, unsigned char* __restrict__ Q, float* __restrict__ S, int bid, int nblk) {
    const int lane = tid_opaque() & 63, stride = nblk * 4;
    f32x4 gg[4];
#pragma unroll
    for (int i = 0; i < 4; ++i) gg[i] = *(const f32x4*)(gam + i * 256 + lane * 4);
    for (int row0 = bid * 4 + (threadIdx.x >> 6); row0 < NTOK; row0 += stride * 4) {
        f32x4 v[4][4]; float ss[4], am[4];
#pragma unroll
        for (int r = 0; r < 4; ++r) {
            const int row = row0 + r * stride < NTOK ? row0 + r * stride : row0;
#pragma unroll
            for (int i = 0; i < 4; ++i) {
                if (BF) { const u32x2 xb = *(const u32x2*)((const u16*)x + (size_t)row * DM + i * 256 + lane * 4); v[r][i] = (f32x4){bflo(xb[0]), bfhi(xb[0]), bflo(xb[1]), bfhi(xb[1])}; }
                else v[r][i] = *(const f32x4*)((const float*)x + (size_t)row * DM + i * 256 + lane * 4);
            }
        }
#pragma unroll
        for (int r = 0; r < 4; ++r) {
            ss[r] = 0.f;
#pragma unroll
            for (int i = 0; i < 4; ++i) ss[r] += v[r][i][0] * v[r][i][0] + v[r][i][1] * v[r][i][1] + v[r][i][2] * v[r][i][2] + v[r][i][3] * v[r][i][3];
        }
#pragma unroll
        for (int o = 32; o > 0; o >>= 1)
#pragma unroll
            for (int r = 0; r < 4; ++r) ss[r] += __shfl_xor(ss[r], o);
#pragma unroll
        for (int r = 0; r < 4; ++r) {
            const float rs = rsqrtf(ss[r] * (1.0f / DM) + 1e-6f);
            am[r] = 0.f;
#pragma unroll
            for (int i = 0; i < 4; ++i)
#pragma unroll
                for (int j = 0; j < 4; ++j) { v[r][i][j] = v[r][i][j] * rs * gg[i][j]; am[r] = fmaxf(am[r], fabsf(v[r][i][j])); }
        }
#pragma unroll
        for (int o = 32; o > 0; o >>= 1)
#pragma unroll
            for (int r = 0; r < 4; ++r) am[r] = fmaxf(am[r], __shfl_xor(am[r], o));
#pragma unroll
        for (int r = 0; r < 4; ++r) {
            const int row = row0 + r * stride;
            if (row < NTOK) {
                const float inv = am[r] > 0.f ? 127.f / am[r] : 0.f;
#pragma unroll
                for (int i = 0; i < 4; ++i) {
                    unsigned wv = 0;
#pragma unroll
                    for (int j = 0; j < 4; ++j) { const int q = (int)rintf(v[r][i][j] * inv); wv |= ((unsigned)q & 0xffu) << (8 * j); }
                    const int sl = 2 * i + (lane >> 5);
                    *(unsigned*)(Q + ((size_t)sl * NTOK + row) * 128 + (lane & 31) * 4) = wv;
                }
                if (lane == 0) S[row] = am[r] * (1.f / 127.f);
            }
        }
    }
}
template <bool FINAL>
DEVI void ph_rmsnorm(const float* __restrict__ x, const float* __restrict__ gam, u16* __restrict__ hout, float* __restrict__ fout, int bid, int nblk) {
    const int lane = threadIdx.x & 63;
    for (int row = bid * 4 + (threadIdx.x >> 6); row < NTOK; row += nblk * 4) {
        const float* xr = x + (size_t)row * DM;
        f32x4 v[4]; float ss = 0.f;
#pragma unroll
        for (int i = 0; i < 4; ++i) { v[i] = *(const f32x4*)(xr + i * 256 + lane * 4); ss += v[i][0] * v[i][0] + v[i][1] * v[i][1] + v[i][2] * v[i][2] + v[i][3] * v[i][3]; }
        ss = wave_sum(ss);
        const float rs = rsqrtf(ss * (1.0f / DM) + 1e-6f);
#pragma unroll
        for (int i = 0; i < 4; ++i) {
            f32x4 gg = *(const f32x4*)(gam + i * 256 + lane * 4);
            f32x4 y = {v[i][0] * rs * gg[0], v[i][1] * rs * gg[1], v[i][2] * rs * gg[2], v[i][3] * rs * gg[3]};
            if (FINAL) *(f32x4*)(fout + (size_t)row * DM + i * 256 + lane * 4) = y;
            else { u32x2 o = {pk2(y[0], y[1]), pk2(y[2], y[3])}; *(u32x2*)(hout + (size_t)row * DM + i * 256 + lane * 4) = o; }
        }
    }
}

DEVI void final_row(const u32x2 (&xb)[4], const float* __restrict__ gam, float* __restrict__ orow, int lane) {
    f32x4 v[4]; float ss = 0.f;
#pragma unroll
    for (int i = 0; i < 4; ++i) { v[i] = (f32x4){bflo(xb[i][0]), bfhi(xb[i][0]), bflo(xb[i][1]), bfhi(xb[i][1])}; ss += v[i][0] * v[i][0] + v[i][1] * v[i][1] + v[i][2] * v[i][2] + v[i][3] * v[i][3]; }
    ss = wave_sum(ss);
    const float rs = rsqrtf(ss * (1.0f / DM) + 1e-6f);
#pragma unroll
    for (int i = 0; i < 4; ++i) {
        const f32x4 gg = *(const f32x4*)(gam + i * 256 + lane * 4);
        *(f32x4*)(orow + i * 256 + lane * 4) = (f32x4){v[i][0] * rs * gg[0], v[i][1] * rs * gg[1], v[i][2] * rs * gg[2], v[i][3] * rs * gg[3]};
    }
}
DEVI void ph_final(const Params& p, char* smem, int bid, int nblk, unsigned& epoch) {
    const int lane = tid_opaque() & 63, wv = bid * 4 + (threadIdx.x >> 6), nwv = nblk * 4;
    const u16* XR = XR_OF(p);
    for (int row = wv; row < NTOK / 2; row += nwv) {
        u32x2 xb[4];
#pragma unroll
        for (int i = 0; i < 4; ++i) xb[i] = *(const u32x2*)(XR + (size_t)row * DM + i * 256 + lane * 4);
        final_row(xb, p.final_g, p.out + (size_t)row * DM, lane);
    }
    for (int base = NTOK / 2; base < NTOK; base += nwv * 8) {
        u32x2 xb[8][4];
#pragma unroll
        for (int k = 0; k < 8; ++k) {
            const int row = base + k * nwv + wv;
#pragma unroll
            for (int i = 0; i < 4; ++i) xb[k][i] = row < NTOK ? *(const u32x2*)(XR + (size_t)row * DM + i * 256 + lane * 4) : (u32x2){0u, 0u};
        }
        grid_bar(p.ws, smem, epoch);
#pragma unroll
        for (int k = 0; k < 8; ++k) {
            const int row = base + k * nwv + wv;
            if (row < NTOK) final_row(xb[k], p.final_g, p.out + (size_t)row * DM, lane);
        }
    }
}

DEVI void ph_rms2(const Params& p, int layer, int bid, int nblk) {
    const int lane = tid_opaque() & 63;
    const float* gam = p.norm2_g + layer * 1024;
    u16* H = (u16*)(p.ws + OFF_H); unsigned char* HQ = (unsigned char*)(p.ws + OFF_HQ); float* HS = (float*)(p.ws + OFF_HS);
    for (int row = bid * 4 + (threadIdx.x >> 6); row < NTOK; row += nblk * 4) {
        const float* xr = p.out + (size_t)row * DM;
        f32x4 v[4]; float ss = 0.f;
#pragma unroll
        for (int i = 0; i < 4; ++i) { v[i] = *(const f32x4*)(xr + i * 256 + lane * 4); ss += v[i][0] * v[i][0] + v[i][1] * v[i][1] + v[i][2] * v[i][2] + v[i][3] * v[i][3]; }
        ss = wave_sum(ss);
        const float rs = rsqrtf(ss * (1.0f / DM) + 1e-6f);
        float am = 0.f;
#pragma unroll
        for (int i = 0; i < 4; ++i) {
            const f32x4 gg = *(const f32x4*)(gam + i * 256 + lane * 4);
#pragma unroll
            for (int j = 0; j < 4; ++j) { v[i][j] = v[i][j] * rs * gg[j]; am = fmaxf(am, fabsf(v[i][j])); }
            u32x2 o = {pk2(v[i][0], v[i][1]), pk2(v[i][2], v[i][3])};
            *(u32x2*)(H + (size_t)row * DM + i * 256 + lane * 4) = o;
        }
#pragma unroll
        for (int o = 32; o > 0; o >>= 1) am = fmaxf(am, __shfl_xor(am, o));
        const float inv = am > 0.f ? 127.f / am : 0.f;
#pragma unroll
        for (int i = 0; i < 4; ++i) {
            unsigned wv = 0;
#pragma unroll
            for (int j = 0; j < 4; ++j) { const int q = (int)rintf(v[i][j] * inv); wv |= ((unsigned)q & 0xffu) << (8 * j); }
            const int sl = 2 * i + (lane >> 5);
            *(unsigned*)(HQ + ((size_t)sl * NTOK + row) * 128 + (lane & 31) * 4) = wv;
        }
        if (lane == 0) HS[row] = am * (1.f / 127.f);
    }
}

DEVI void ph_proj(const Params& p, int layer, char* smem, int bid, int nblk) {
    const char* A8 = p.ws + OFF_H1Q; const float* AS = (const float*)(p.ws + OFF_H1S);
    const char* W8 = p.ws + OFF_WI8 + (size_t)layer * WIN_ROWS * 1024; const float* SW = (const float*)(p.ws + OFF_SWI) + (size_t)layer * WIN_ROWS;
    u16* P = (u16*)(p.ws + OFF_P); float* FS = (float*)(p.ws + OFF_FS);
    constexpr int ntn = 25;
    const int tid_ = tid_opaque(), lane = tid_ & 63, w = tid_ >> 6, wm = w >> 1, wn = w & 1, g = lane >> 4, c = lane & 15;
    const TileMap tmp = tile_map(smem, bid, nblk, NTOK / 128, ntn);
    gemm_stream<128, 128, true>(smem, tmp.j0, tmp.jstep, tmp.jend,
        [&](int t) { int tm_, tn_; tile_decode(tmp, t, tm_, tn_); GJob jb; jb.A = A8; jb.lda = 128; jb.aks = (size_t)NTOK * 128; jb.Bt = W8; jb.ldb = 1024; jb.nk = 8; jb.m0 = tm_ * 128; jb.n0 = tn_ * 128; jb.i8 = true; return jb; },
        [&](int t, f32x4 (&acc)[4][4]) {
            int tm_, tn_; tile_decode(tmp, t, tm_, tn_);
            const int m0 = tm_ * 128, n0 = tn_ * 128, nb = n0 + wn * 64;
            const int hc = (nb >= C_DQ && nb < C_DV) || (nb >= C_NKS && nb < C_NVS) || (nb >= C_NKW && nb < C_NVW) ? 1 : ((nb >= C_NQ && nb < C_NKC) ? 2 : ((nb >= C_FK && nb < C_FV) ? 3 : 0));
            const int nclass = hc == 3 ? 0 : ((nb >= C_DK && nb < C_DV) ? 1 : ((nb >= C_NKS && nb < C_NVS) ? 2 : ((nb >= C_NKW && nb < C_NVW) ? 3 : ((nb >= C_DQ && nb < C_DK) ? 5 : (hc == 2 ? 6 : -1)))));
            float kmax2 = 0.f;
            float sa4[4]; f32x4 sw4[4];
#pragma unroll
            for (int i = 0; i < 4; ++i) { sa4[i] = AS[m0 + wm * 64 + 16 * i + c]; sw4[i] = *(const f32x4*)(SW + nb + 16 * i + 4 * g); }
            const bool rot = hc == 1 || hc == 2;
            f32x4 rc[4] = {{0.f, 0.f, 0.f, 0.f}, {0.f, 0.f, 0.f, 0.f}, {0.f, 0.f, 0.f, 0.f}, {0.f, 0.f, 0.f, 0.f}};
            auto rope_load = [&](int mt, f32x4 (&r)[4]) {
                const float* tb = (const float*)(p.ws + OFF_ROPE) + ((size_t)((m0 + wm * 64 + 16 * mt + c) & (SEQ - 1)) * 32) * 2;
                r[0] = *(const f32x4*)(tb + (4 * g) * 2); r[1] = *(const f32x4*)(tb + (4 * g) * 2 + 4);
                r[2] = *(const f32x4*)(tb + (16 + 4 * g) * 2); r[3] = *(const f32x4*)(tb + (16 + 4 * g) * 2 + 4);
            };
            if (rot) rope_load(0, rc);
#pragma unroll
            for (int mt = 0; mt < 4; ++mt) {
                const int m = m0 + wm * 64 + 16 * mt + c;
                const float sa = sa4[mt];
                f32x4 rn[4] = {rc[0], rc[1], rc[2], rc[3]};
                if (rot && mt < 3) rope_load(mt + 1, rn);
                f32x4 v[4];
#pragma unroll
                for (int nt = 0; nt < 4; ++nt) {
                    const f32x4 sw = sw4[nt];
                    const i32x4 ai = __builtin_bit_cast(i32x4, acc[mt][nt]);
                    v[nt] = (f32x4){(float)ai[0] * sa * sw[0], (float)ai[1] * sa * sw[1], (float)ai[2] * sa * sw[2], (float)ai[3] * sa * sw[3]};
                }
                if (nb >= PW) {
                    if (nb == PW && g == 0) *(f32x4*)(FS + (size_t)m * 16) = v[0];
                    if (nb == PW && g == 1) *(f32x4*)(FS + (size_t)m * 16 + 4) = v[0];
                    if (nb == PW && g == 2) *(f32x4*)(FS + (size_t)m * 16 + 8) = v[0];
                    if (nb == PW && g == 3) *(f32x4*)(FS + (size_t)m * 16 + 12) = v[0];
                    continue;
                }
                if (hc == 2) {
#pragma unroll
                    for (int nt = 0; nt < 4; ++nt) { u32x2 o = {pk2(v[nt][0], v[nt][1]), pk2(v[nt][2], v[nt][3])}; *(u32x2*)(P + (size_t)m * PW + nb + 16 * nt + 4 * g) = o; }
                }
                if (rot) {
#pragma unroll
                    for (int nt = 0; nt < 2; ++nt) {
                        const f32x4 cs0 = rc[2 * nt], cs1 = rc[2 * nt + 1];
                        const f32x4 x1 = v[nt], x2 = v[nt + 2];
                        v[nt]     = (f32x4){x1[0] * cs0[0] - x2[0] * cs0[1], x1[1] * cs0[2] - x2[1] * cs0[3], x1[2] * cs1[0] - x2[2] * cs1[1], x1[3] * cs1[2] - x2[3] * cs1[3]};
                        v[nt + 2] = (f32x4){x2[0] * cs0[0] + x1[0] * cs0[1], x2[1] * cs0[2] + x1[1] * cs0[3], x2[2] * cs1[0] + x1[2] * cs1[1], x2[3] * cs1[2] + x1[3] * cs1[3]};
                    }
                }
                if (nclass >= 0) {
                    float ss = 0.f;
#pragma unroll
                    for (int nt = 0; nt < 4; ++nt) {
                        const unsigned w0 = pk2(v[nt][0], v[nt][1]), w1 = pk2(v[nt][2], v[nt][3]);
                        ss += bflo(w0) * bflo(w0) + bfhi(w0) * bfhi(w0) + bflo(w1) * bflo(w1) + bfhi(w1) * bfhi(w1);
                    }
                    ss += __shfl_xor(ss, 16); ss += __shfl_xor(ss, 32);
                    kmax2 = fmaxf(kmax2, ss);
                }
                u16* dst = hc == 2 ? (u16*)(p.ws + OFF_NQR) + (size_t)m * 256 + (nb - C_NQ) : P + (size_t)m * PW + nb;
#pragma unroll
                for (int nt = 0; nt < 4; ++nt) { u32x2 o = {pk2(v[nt][0], v[nt][1]), pk2(v[nt][2], v[nt][3])}; *(u32x2*)(dst + 16 * nt + 4 * g) = o; }
#pragma unroll
                for (int i = 0; i < 4; ++i) rc[i] = rn[i];
            }
            if (nclass >= 0) {
#pragma unroll
                for (int o2 = 1; o2 < 16; o2 <<= 1) kmax2 = fmaxf(kmax2, __shfl_xor(kmax2, o2));
                if (lane == 0) atomicMax(nclass == 0 ? (unsigned*)(p.ws + OFF_CTRL) + 12 + layer : (unsigned*)(p.ws + OFF_FLAGS) + layer * 1024 + 720 + nclass, __float_as_uint(kmax2));
            }
        });
}

DEVI void ph_rope(const Params& p, int layer, int bid, int nblk) {
    u16* P = (u16*)(p.ws + OFF_P); u16* NQR = (u16*)(p.ws + OFF_NQR);
    float kmax2 = 0.f;
    const f32x2* tab = (const f32x2*)(p.ws + OFF_ROPE);
    const int lane = threadIdx.x & 63, i = lane & 31, half = lane >> 5;
    for (int tok = bid * 4 + (threadIdx.x >> 6); tok < NTOK; tok += nblk * 4) {
        const int s = tok & (SEQ - 1);
        const f32x2 cs = tab[s * 32 + i];
        u16* row = P + (size_t)tok * PW;
#pragma unroll
        for (int j = 0; j < 9; ++j) {
            const int hd = 2 * j + half;
            int col;
            if (hd < 6) col = C_DQ + hd * 64; else if (hd < 12) col = C_DK + (hd - 6) * 64; else if (hd < 16) col = C_NQ + (hd - 12) * 64; else if (hd == 16) col = C_NKS; else col = C_NKW;
            const float x1 = bf2f(row[col + i]), x2 = bf2f(row[col + 32 + i]);
            const float y1 = x1 * cs[0] - x2 * cs[1], y2 = x2 * cs[0] + x1 * cs[1];
            if (hd >= 12 && hd < 16) { u16* d = NQR + (size_t)tok * 256 + (hd - 12) * 64; d[i] = f2bf(y1); d[32 + i] = f2bf(y2); }
            else { row[col + i] = f2bf(y1); row[col + 32 + i] = f2bf(y2); }
        }
#pragma unroll
        for (int hh = 0; hh < 4; ++hh) { const float kv = bf2f(row[C_FK + hh * 64 + lane]); kmax2 = fmaxf(kmax2, wave_sum(kv * kv)); }
    }
    if (lane == 0) atomicMax((unsigned*)(p.ws + OFF_CTRL) + 12 + layer, __float_as_uint(kmax2));
}

DEVI void ph_foxcum(const Params& p, int layer, char* smem, int bid, int nblk) {
    float* part = (float*)smem;
    const int tid = threadIdx.x;
    const float* FS = (const float*)(p.ws + OFF_FS); float* CUM = (float*)(p.ws + OFF_CUM);
    for (int it = bid; it < 16; it += nblk) {
        const int b = it >> 2, h = it & 3;
        const float bf = p.fox_b_f[layer * 4 + h];
        float v[32]; float run = 0.f;
#pragma unroll
        for (int i = 0; i < 32; ++i) {
            const float z = FS[(size_t)(b * SEQ + tid * 32 + i) * 16 + h] + bf;
            const float ls = fminf(z, 0.f) - log1pf(__expf(-fabsf(z)));
            run += ls; v[i] = run;
        }
        block_sync();
        part[tid] = run; block_sync();
        if (tid == 0) { float a = 0.f; for (int i = 0; i < 256; ++i) { float t = part[i]; part[i] = a; a += t; } }
        block_sync();
        const float base = part[tid];
#pragma unroll
        for (int i = 0; i < 32; ++i) CUM[(size_t)(b * SEQ + tid * 32 + i) * 4 + h] = base + v[i];
    }
}

template <int MODE>
DEVI void ph_lru(const Params& p, int layer, char* smem, int bid, int nblk) {
    char* sXC = smem;
    float* sA = (float*)(smem + 16 * 528);
    float* sG = sA + 16 * 256;
    const int tid = tid_opaque(), ch = tid, lane = tid & 63, nb = tid >> 6, g = lane >> 4, c = lane & 15;
    const u16* P = (const u16*)(p.ws + OFF_P);
    float* SA = (float*)(p.ws + OFF_LSUM); float* SH = SA + 512 * 256;
    u16* O = (u16*)(p.ws + OFF_O);
    if (bid >= 512) return;
    s16x8 wfa[4][2], wfx[4][2];
    {
        const s16x8* F = (const s16x8*)(p.ws + OFF_LRUF);
#pragma unroll
        for (int nt = 0; nt < 4; ++nt)
#pragma unroll
            for (int ks = 0; ks < 2; ++ks) {
                wfa[nt][ks] = F[(((((layer * 2 + 0) * 4 + nb) * 4 + nt) * 2 + ks) << 6) + lane];
                wfx[nt][ks] = F[(((((layer * 2 + 1) * 4 + nb) * 4 + nt) * 2 + ks) << 6) + lane];
            }
    }
    float gba[4], gbx[4], gsp[4];
#pragma unroll
    for (int nt = 0; nt < 4; ++nt) {
        const int cc = layer * 256 + nb * 64 + 16 * nt + c;
        gba[nt] = p.lru_b_a[cc]; gbx[nt] = p.lru_b_x[cc];
        const float lam = p.lru_lambda[cc];
        gsp[nt] = (lam > 0.f ? 0.f : -lam) + log1pf(__expf(-fabsf(lam)));
    }
    const float cw0 = p.lru_conv_w[(layer * 4 + 0) * 256 + ch], cw1 = p.lru_conv_w[(layer * 4 + 1) * 256 + ch],
                cw2 = p.lru_conv_w[(layer * 4 + 2) * 256 + ch], cw3 = p.lru_conv_w[(layer * 4 + 3) * 256 + ch];
    const float cb = p.lru_conv_b[layer * 256 + ch];
    for (int tile = bid; tile < 512; tile += nblk) {
        const int b = tile >> 7, k = tile & 127, t0 = b * SEQ + k * 64;
        float hst = 0.f, aprod = 1.f;
        if (MODE == 1) {
            int j = 0;
            for (; j + 8 <= k; j += 8) {
                float ca[8], chh[8];
#pragma unroll
                for (int q = 0; q < 8; ++q) { const int tj = (b << 7) + j + q; ca[q] = SA[tj * 256 + ch]; chh[q] = SH[tj * 256 + ch]; }
#pragma unroll
                for (int q = 0; q < 8; ++q) hst = ca[q] * hst + chh[q];
            }
            for (; j < k; ++j) { const int tj = (b << 7) + j; hst = SA[tj * 256 + ch] * hst + SH[tj * 256 + ch]; }
        }
        float x0 = 0.f, x1 = 0.f, x2 = 0.f;
        if (k > 0) { x0 = bf2f(P[(size_t)(t0 - 3) * PW + C_LX + ch]); x1 = bf2f(P[(size_t)(t0 - 2) * PW + C_LX + ch]); x2 = bf2f(P[(size_t)(t0 - 1) * PW + C_LX + ch]); }
        u16 xin[16], gin[16];
#pragma unroll
        for (int i = 0; i < 16; ++i) { xin[i] = P[(size_t)(t0 + i) * PW + C_LX + ch]; if (MODE == 1) gin[i] = P[(size_t)(t0 + i) * PW + C_LG + ch]; }
        for (int sub = 0; sub < 4; ++sub) {
            float xc[16]; u16 xcur[16], gcur[16];
#pragma unroll
            for (int i = 0; i < 16; ++i) { xcur[i] = xin[i]; if (MODE == 1) gcur[i] = gin[i]; }
            if (sub < 3) {
#pragma unroll
                for (int i = 0; i < 16; ++i) { xin[i] = P[(size_t)(t0 + (sub + 1) * 16 + i) * PW + C_LX + ch]; if (MODE == 1) gin[i] = P[(size_t)(t0 + (sub + 1) * 16 + i) * PW + C_LG + ch]; }
            }
            block_sync();
#pragma unroll
            for (int i = 0; i < 16; ++i) {
                const float x3 = bf2f(xcur[i]);
                xc[i] = cw0 * x0 + cw1 * x1 + cw2 * x2 + cw3 * x3 + cb;
                x0 = x1; x1 = x2; x2 = x3;
                *(u16*)(sXC + i * 528 + ch * 2) = f2bf(xc[i]);
            }
            block_sync();
            {
                const s16x8 a0 = *(const s16x8*)(sXC + c * 528 + (nb * 64 + 8 * g) * 2);
                const s16x8 a1 = *(const s16x8*)(sXC + c * 528 + (nb * 64 + 32 + 8 * g) * 2);
#pragma unroll
                for (int nt = 0; nt < 4; ++nt) {
                    f32x4 za = {0.f, 0.f, 0.f, 0.f}, zx = {0.f, 0.f, 0.f, 0.f};
                    za = mfma16(a0, wfa[nt][0], za); za = mfma16(a1, wfa[nt][1], za);
                    zx = mfma16(a0, wfx[nt][0], zx); zx = mfma16(a1, wfx[nt][1], zx);
#pragma unroll
                    for (int r = 0; r < 4; ++r) {
                        const float rr = sigmoidf_(za[r] + gba[nt]), ig = sigmoidf_(zx[r] + gbx[nt]);
                        const float log_a = -8.0f * rr * gsp[nt], a_ = __expf(log_a), x2 = 2.f * log_a;
                        const float em = x2 > -0.02f ? -x2 * (1.f + x2 * (0.5f + x2 * 0.16666667f)) : 1.f - a_ * a_;
                        sA[(4 * g + r) * 256 + nb * 64 + 16 * nt + c] = a_;
                        sG[(4 * g + r) * 256 + nb * 64 + 16 * nt + c] = __builtin_amdgcn_sqrtf(em) * ig;
                    }
                }
            }
            block_sync();
#pragma unroll
            for (int i = 0; i < 16; ++i) {
                const float a = sA[i * 256 + ch];
                hst = a * hst + sG[i * 256 + ch] * xc[i];
                if (MODE == 0) aprod *= a;
                else {
                    const size_t tok = (size_t)(t0 + sub * 16 + i);
                    const float gate = bf2f(gcur[i]);
                    O[tok * OW + O_LRU + ch] = f2bf(hst * gelu_tanh(gate));
                }
            }
        }
        if (MODE == 0) { SA[tile * 256 + ch] = aprod; SH[tile * 256 + ch] = hst; }
    }
}

DEVI void ph_cmp(const Params& p, int layer, char* smem, int bid, int nblk) {
    const u16* P = (const u16*)(p.ws + OFF_P);
    const int tid_ = tid_opaque(), lane = tid_ & 63, w = tid_ >> 6, wm = w >> 1, wn = w & 1, g = lane >> 4, c = lane & 15;
    for (int t = bid; t < 64; t += nblk) {
        const int z = t >> 5, tm = t & 31;
        const int b = tm >> 3, i0 = (tm & 7) * 64;
        const u16* A = P + (size_t)(b * SEQ) * PW + (z ? C_NVC : C_NKC);
        const u16* Wt = (const u16*)(p.ws + OFF_W1) + ((size_t)(layer * 2 + z) * 256) * 2048;
        const float* b1 = (const float*)(p.ws + OFF_B1) + (layer * 2 + z) * 256;
        u16* HID = (u16*)(p.ws + OFF_HID) + (size_t)z * 2048 * 256;
        for (int tn = 0; tn < 2; ++tn) {
            f32x4 acc[2][4]; acc_zero(acc);
            gemm_mainloop<64, 128>(A, (size_t)16 * PW, (size_t)PW, Wt, 2048, 2048, i0, tn * 128, smem, acc);
#pragma unroll
            for (int mt = 0; mt < 2; ++mt)
#pragma unroll
                for (int nt = 0; nt < 4; ++nt) {
                    const int m = b * 512 + i0 + wm * 32 + 16 * mt + c, n = tn * 128 + wn * 64 + 16 * nt + 4 * g;
                    const f32x4 bb = *(const f32x4*)(b1 + n);
                    u32x2 o = {pk2(gelu_tanh(acc[mt][nt][0] + bb[0]), gelu_tanh(acc[mt][nt][1] + bb[1])), pk2(gelu_tanh(acc[mt][nt][2] + bb[2]), gelu_tanh(acc[mt][nt][3] + bb[3]))};
                    *(u32x2*)(HID + (size_t)m * 256 + n) = o;
                }
        }
        block_sync();
        {
            const u16* W2 = (const u16*)(p.ws + OFF_W2) + ((size_t)(layer * 2 + z) * 64) * 256;
            f32x4 acc[2][2]; acc_zero(acc); float kss[2] = {0.f, 0.f};
            gemm_mainloop<64, 64>(HID, 256, 64, W2, 256, 256, b * 512 + i0, 0, smem, acc);
            u16* KVC = (u16*)(p.ws + OFF_KVC) + (size_t)z * NB * 512 * 64;
#pragma unroll
            for (int mt = 0; mt < 2; ++mt)
#pragma unroll
                for (int nt = 0; nt < 2; ++nt) {
                    const int m = b * 512 + i0 + wm * 32 + 16 * mt + c, n = wn * 32 + 16 * nt + 4 * g;
                    u32x2 o = {pk2(acc[mt][nt][0], acc[mt][nt][1]), pk2(acc[mt][nt][2], acc[mt][nt][3])};
                    if ((m & 511) == 511) o = (u32x2){0u, 0u};
                    *(u32x2*)(KVC + (size_t)m * 64 + n) = o;
                    kss[mt] += bflo(o[0]) * bflo(o[0]) + bfhi(o[0]) * bfhi(o[0]) + bflo(o[1]) * bflo(o[1]) + bfhi(o[1]) * bfhi(o[1]);
                }
            if (z == 0) {
                float k0 = kss[0]; k0 += __shfl_xor(k0, 16); k0 += __shfl_xor(k0, 32);
                float k1 = kss[1]; k1 += __shfl_xor(k1, 16); k1 += __shfl_xor(k1, 32);
                float km = fmaxf(k0, k1);
#pragma unroll
                for (int o2 = 1; o2 < 16; o2 <<= 1) km = fmaxf(km, __shfl_xor(km, o2));
                if (lane == 0) atomicMax((unsigned*)(p.ws + OFF_FLAGS) + layer * 1024 + 730 + wn, __float_as_uint(km));
            }
        }
    }
}
constexpr float LOG2E = 1.4426950408889634f, SC2 = 0.125f * LOG2E;
template <int NQT, class F>
DEVI void attn_tile64(const char* sK, const char* sV, const s16x8 (&qf)[NQT][2], float (&m)[NQT], float (&l)[NQT], f32x4 (&o)[NQT][4], int lane, F&& logit,
                      bool fast = false, float lb0 = 0.f, float lb1 = 0.f, bool fixedm = false) {
    const int g = lane >> 4, c = lane & 15;
    f32x4 s[NQT][4];
#pragma unroll
    for (int T = 0; T < 4; ++T) {
        const int row = 16 * T + c;
        const s16x8 k0 = *(const s16x8*)(sK + row * 128 + ((g ^ (row & 7)) << 4));
        const s16x8 k1 = *(const s16x8*)(sK + row * 128 + (((4 + g) ^ (row & 7)) << 4));
#pragma unroll
        for (int qt = 0; qt < NQT; ++qt) { f32x4 z = {0.f, 0.f, 0.f, 0.f}; z = mfma16(k0, qf[qt][0], z); z = mfma16(k1, qf[qt][1], z); s[qt][T] = z; }
    }
#pragma unroll
    for (int qt = 0; qt < NQT; ++qt) {
        float mx = -INFINITY;
        float off;
        float mn = m[qt];
        if (fixedm) {
            if (!fast) {
#pragma unroll
                for (int T = 0; T < 4; ++T) logit(qt, T, s[qt][T]);
            }
        } else {
            if (fast) {
#pragma unroll
                for (int T = 0; T < 4; ++T) { mx = fmaxf(fmaxf(mx, s[qt][T][0]), s[qt][T][1]); mx = fmaxf(fmaxf(mx, s[qt][T][2]), s[qt][T][3]); }
                mx = mx * SC2 + (qt == 0 ? lb0 : lb1);
            } else {
#pragma unroll
                for (int T = 0; T < 4; ++T) { logit(qt, T, s[qt][T]); mx = fmaxf(fmaxf(mx, s[qt][T][0]), s[qt][T][1]); mx = fmaxf(fmaxf(mx, s[qt][T][2]), s[qt][T][3]); }
            }
            mx = fmaxf(mx, __shfl_xor(mx, 16)); mx = fmaxf(mx, __shfl_xor(mx, 32));
            mn = fmaxf(m[qt], mx);
            if (__ballot(mn > m[qt]) != 0ull) {
                const float alpha = __builtin_amdgcn_exp2f(m[qt] - mn);
                l[qt] *= alpha;
#pragma unroll
                for (int dt = 0; dt < 4; ++dt) o[qt][dt] *= alpha;
            }
            m[qt] = mn;
        }
        if (fast) {
            off = (qt == 0 ? lb0 : lb1) - mn;
#pragma unroll
            for (int T = 0; T < 4; ++T)
#pragma unroll
                for (int r = 0; r < 4; ++r) s[qt][T][r] = __builtin_amdgcn_exp2f(s[qt][T][r] * SC2 + off);
        } else {
#pragma unroll
            for (int T = 0; T < 4; ++T)
#pragma unroll
                for (int r = 0; r < 4; ++r) s[qt][T][r] = __builtin_amdgcn_exp2f(s[qt][T][r] - mn);
        }
    }
    const short one = (lane & 15) == 0 ? (short)0x3F80 : (short)0;
    const s16x8 ones = {one, one, one, one, one, one, one, one};
#pragma unroll
    for (int u = 0; u < 2; ++u) {
        s16x8 pb[NQT];
#pragma unroll
        for (int qt = 0; qt < NQT; ++qt) {
            u32x4 pk = {pk2(s[qt][2 * u][0], s[qt][2 * u][1]), pk2(s[qt][2 * u][2], s[qt][2 * u][3]), pk2(s[qt][2 * u + 1][0], s[qt][2 * u + 1][1]), pk2(s[qt][2 * u + 1][2], s[qt][2 * u + 1][3])};
            pb[qt] = __builtin_bit_cast(s16x8, pk);
            f32x4 lc = {l[qt], 0.f, 0.f, 0.f};
            lc = mfma16(ones, pb[qt], lc);
            l[qt] = lc[0];
        }
#pragma unroll
        for (int dt = 0; dt < 4; ++dt) {
            const char* a0 = sV + (32 * u + 4 * g + (c >> 2)) * 144 + (16 * dt + 4 * (c & 3)) * 2;
            const s16x4 v0 = __builtin_amdgcn_ds_read_tr16_b64_v4i16((LAS s16x4*)(a0));
            const s16x4 v1 = __builtin_amdgcn_ds_read_tr16_b64_v4i16((LAS s16x4*)(a0 + 16 * 144));
            const s16x8 vf = {v0[0], v0[1], v0[2], v0[3], v1[0], v1[1], v1[2], v1[3]};
#pragma unroll
            for (int qt = 0; qt < NQT; ++qt) o[qt][dt] = mfma16(vf, pb[qt], o[qt][dt]);
        }
    }
}
DEVI float logit_bound(const unsigned* FLk, int qclass, int kclass0, int kclass1 = -1) {
    const float q2 = __uint_as_float(FLk[qclass]);
    float k2 = __uint_as_float(FLk[kclass0]); if (kclass1 >= 0) k2 += __uint_as_float(FLk[kclass1]);
    return sqrtf(q2 * k2) * SC2 * 1.001f + 0.01f;
}
template <int NQT> DEVI void attn_init(float (&m)[NQT], float (&l)[NQT], f32x4 (&o)[NQT][4]) {
#pragma unroll
    for (int qt = 0; qt < NQT; ++qt) { m[qt] = -1e30f; l[qt] = 0.f;
#pragma unroll
        for (int dt = 0; dt < 4; ++dt) o[qt][dt] = (f32x4){0.f, 0.f, 0.f, 0.f}; }
}
DEVI float attn_ltot(float l) { return __shfl(l, (int)(threadIdx.x & 15)); }
DEVI void stage_kv_block(char* sK, char* sV, const u16* kbase, const u16* vbase, size_t rstride) {
    const int tid = tid_opaque();
#pragma unroll
    for (int i = 0; i < 2; ++i) {
        const int id = tid + 256 * i, key = id >> 3, cc = id & 7;
        const u32x4 kv = *(const u32x4*)(kbase + (size_t)key * rstride + cc * 8);
        const u32x4 vv = *(const u32x4*)(vbase + (size_t)key * rstride + cc * 8);
        *(u32x4*)(sK + key * 128 + ((cc ^ (key & 7)) << 4)) = kv;
        *(u32x4*)(sV + key * 144 + cc * 16) = vv;
    }
}

struct KVPref { u32x4 k[2], v[2]; };
DEVI void kv_load(KVPref& r, const u16* kbase, const u16* vbase, size_t rstride, int tid) {
#pragma unroll
    for (int i = 0; i < 2; ++i) {
        const int id = tid + 256 * i, key = id >> 3, cc = id & 7;
        r.k[i] = *(const u32x4*)(kbase + (size_t)key * rstride + cc * 8);
        r.v[i] = *(const u32x4*)(vbase + (size_t)key * rstride + cc * 8);
    }
}
DEVI void kv_store(char* sK, char* sV, const KVPref& r, int tid) {
#pragma unroll
    for (int i = 0; i < 2; ++i) {
        const int id = tid + 256 * i, key = id >> 3, cc = id & 7;
        *(u32x4*)(sK + key * 128 + ((cc ^ (key & 7)) << 4)) = r.k[i];
        *(u32x4*)(sV + key * 144 + cc * 16) = r.v[i];
    }
}
constexpr int ATT_SK = 8192, ATT_SV = 64 * 144;

DEVI void fox_item(const Params& p, int layer, char* smem, int qb, int bh) {
    char* sK = smem; char* sV = smem + ATT_SK; float* sC = (float*)(smem + ATT_SK + ATT_SV); int* sF = (int*)(smem + ATT_SK + ATT_SV + 256);
    const u16* P = (const u16*)(p.ws + OFF_P); const float* CUM = (const float*)(p.ws + OFF_CUM); u16* O = (u16*)(p.ws + OFF_O);
    const int tid = tid_opaque(), lane = tid & 63, w = tid >> 6, g = lane >> 4, c = lane & 15;
    const int b = bh >> 2, h = bh & 3;
    const int q0 = qb * 128, qw = q0 + 32 * w;
    const float kmax = sqrtf(__uint_as_float(((const unsigned*)(p.ws + OFF_CTRL))[12 + layer]));
    s16x8 qf[2][2]; float cq[2], cq2[2], qb8[2];
#pragma unroll
    for (int qt = 0; qt < 2; ++qt) {
        const size_t tok = (size_t)b * SEQ + qw + 16 * qt + c;
        qf[qt][0] = *(const s16x8*)(P + tok * PW + C_FQ + h * 64 + 8 * g);
        qf[qt][1] = *(const s16x8*)(P + tok * PW + C_FQ + h * 64 + 32 + 8 * g);
        cq[qt] = CUM[tok * 4 + h];
        cq2[qt] = cq[qt] * LOG2E;
        float ss = 0.f;
#pragma unroll
        for (int j = 0; j < 8; ++j) { const float a0 = bf2f((u16)qf[qt][0][j]), a1 = bf2f((u16)qf[qt][1][j]); ss += a0 * a0 + a1 * a1; }
        ss += __shfl_xor(ss, 16); ss += __shfl_xor(ss, 32);
        qb8[qt] = sqrtf(ss) * kmax * 0.125f;
    }
    float m[2], l[2]; f32x4 o[2][4]; attn_init<2>(m, l, o);
    const int ntile = (q0 + 128) / 64;
    KVPref pf; float pfc = 0.f;
    { const size_t kt0 = (size_t)b * SEQ + (ntile - 1) * 64; kv_load(pf, P + kt0 * PW + C_FK + h * 64, P + kt0 * PW + C_FV + h * 64, PW, tid); if (tid < 64) pfc = CUM[(kt0 + tid) * 4 + h] * LOG2E; }
    if (tid < 4) sF[tid] = 0;
    for (int kt = ntile - 1; kt >= 0; --kt) {
        block_sync();
        if (sF[0] & sF[1] & sF[2] & sF[3]) break;
        kv_store(sK, sV, pf, tid);
        if (tid < 64) sC[tid] = pfc;
        block_sync();
        float cprev = 0.f;
        if (kt > 0) { const size_t kt0 = (size_t)b * SEQ + (kt - 1) * 64; kv_load(pf, P + kt0 * PW + C_FK + h * 64, P + kt0 * PW + C_FV + h * 64, PW, tid); if (tid < 64) pfc = CUM[(kt0 + tid) * 4 + h] * LOG2E;
                      cprev = CUM[((size_t)b * SEQ + kt * 64 - 1) * 4 + h]; }
        if (kt * 64 <= qw + 31) {
            attn_tile64<2>(sK, sV, qf, m, l, o, lane, [&](int qt, int T, f32x4& s) {
                const f32x4 ck = *(const f32x4*)&sC[16 * T + 4 * g];
                const int qpos = qw + 16 * qt + c, k0 = kt * 64 + 16 * T + 4 * g;
                if (kt * 64 + 63 <= qw) {
#pragma unroll
                    for (int r = 0; r < 4; ++r) s[r] = s[r] * SC2 + (cq2[qt] - ck[r]);
                } else {
#pragma unroll
                    for (int r = 0; r < 4; ++r) s[r] = (k0 + r <= qpos) ? s[r] * SC2 + (cq2[qt] - ck[r]) : -INFINITY;
                }
            });
        }
        const bool done = (m[0] > -1e29f) && (m[1] > -1e29f) && ((qb8[0] + cq[0] - cprev) * LOG2E < m[0] - 58.f) && ((qb8[1] + cq[1] - cprev) * LOG2E < m[1] - 58.f);
        const bool wdone = __ballot(done) == ~0ull;
        if (lane == 0) sF[w] = wdone ? 1 : 0;
    }
#pragma unroll
    for (int qt = 0; qt < 2; ++qt) {
        const float inv = 1.f / attn_ltot(l[qt]);
        const size_t tok = (size_t)b * SEQ + qw + 16 * qt + c;
#pragma unroll
        for (int dt = 0; dt < 4; ++dt) {
            u32x2 ov = {pk2(o[qt][dt][0] * inv, o[qt][dt][1] * inv), pk2(o[qt][dt][2] * inv, o[qt][dt][3] * inv)};
            *(u32x2*)(O + tok * OW + O_FOX + h * 64 + 16 * dt + 4 * g) = ov;
        }
    }
}

DEVI void dil_item(const Params& p, int layer, char* smem, int blk) {
    const u16* P = (const u16*)(p.ws + OFF_P); u16* O = (u16*)(p.ws + OFF_O);
    const int tid = tid_opaque(), lane = tid & 63, w = tid >> 6, g = lane >> 4, c = lane & 15;
    char* sK = smem + w * (ATT_SK + ATT_SV); char* sV = sK + ATT_SK;
    const int wt = blk * 4 + w, hg = wt & 1, t0r = (wt >> 1) & 15, span = (wt >> 5) & 15, b = wt >> 9;
    const int pbase = 512 * span + t0r;
    float m[2], l[2]; f32x4 o[2][4]; attn_init<2>(m, l, o);
    m[0] = m[1] = logit_bound((const unsigned*)(p.ws + OFF_FLAGS) + layer * 1024 + 720, 5, 1);
#pragma unroll 1
    for (int gi = 0; gi < 3; ++gi) {
        const int sh = 2 * gi, dl = 1 << sh;
        const int head = 2 * gi + hg, rr = t0r & (dl - 1);
        s16x8 qf[2][2]; int uq[2];
#pragma unroll
        for (int qt = 0; qt < 2; ++qt) {
            const int pos = pbase + 16 * (16 * qt + c);
            const size_t tok = (size_t)b * SEQ + pos;
            qf[qt][0] = *(const s16x8*)(P + tok * PW + C_DQ + head * 64 + 8 * g);
            qf[qt][1] = *(const s16x8*)(P + tok * PW + C_DQ + head * 64 + 32 + 8 * g);
            uq[qt] = (pos - rr) >> sh;
        }
        int ulo = ((512 * span) >> sh) - 128; if (ulo < 0) ulo = 0;
        const int uhi = (512 * span + 15 + 496) >> sh;
        const int nt = (uhi - ulo) / 64 + 1;
        const u16* kb = P + (size_t)b * SEQ * PW + C_DK + head * 64 + (lane & 7) * 8;
        const u16* vb = P + (size_t)b * SEQ * PW + C_DV + head * 64 + (lane & 7) * 8;
        u32x4 kr[8], vr[8];
#pragma unroll
        for (int i = 0; i < 8; ++i) {
            int pos = rr + ((ulo + (lane >> 3) + 8 * i) << sh); if (pos > SEQ - 1) pos = SEQ - 1;
            kr[i] = *(const u32x4*)(kb + (size_t)pos * PW); vr[i] = *(const u32x4*)(vb + (size_t)pos * PW);
        }
        for (int kt = 0; kt < nt; ++kt) {
#pragma unroll
            for (int i = 0; i < 8; ++i) {
                const int key = (lane >> 3) + 8 * i, cc = lane & 7;
                *(u32x4*)(sK + key * 128 + ((cc ^ (key & 7)) << 4)) = kr[i];
                *(u32x4*)(sV + key * 144 + cc * 16) = vr[i];
            }
            if (kt + 1 < nt) {
#pragma unroll
                for (int i = 0; i < 8; ++i) {
                    int pos = rr + ((ulo + (kt + 1) * 64 + (lane >> 3) + 8 * i) << sh); if (pos > SEQ - 1) pos = SEQ - 1;
                    kr[i] = *(const u32x4*)(kb + (size_t)pos * PW); vr[i] = *(const u32x4*)(vb + (size_t)pos * PW);
                }
            }
            attn_tile64<2>(sK, sV, qf, m, l, o, lane, [&](int qt, int T, f32x4& s) {
                const int u0 = ulo + kt * 64 + 16 * T + 4 * g;
#pragma unroll
                for (int r = 0; r < 4; ++r) { const int u = u0 + r; s[r] = (u <= uq[qt] && u >= uq[qt] - 128) ? s[r] * SC2 : -INFINITY; }
            }, false, 0.f, 0.f, true);
        }
    }
#pragma unroll
    for (int qt = 0; qt < 2; ++qt) {
        const float inv = 1.f / attn_ltot(l[qt]);
        const size_t tok = (size_t)b * SEQ + pbase + 16 * (16 * qt + c);
#pragma unroll
        for (int dt = 0; dt < 4; ++dt) {
            u32x2 ov = {pk2(o[qt][dt][0] * inv, o[qt][dt][1] * inv), pk2(o[qt][dt][2] * inv, o[qt][dt][3] * inv)};
            *(u32x2*)(O + tok * OW + O_DIL + hg * 64 + 16 * dt + 4 * g) = ov;
        }
    }
}

DEVI void nsa_item(const Params& p, int layer, char* smem, int blk, int part) {
    constexpr int STG = ATT_SK + ATT_SV;
    float* sImp = (float*)(smem + 2 * STG);
    const u16* P = (const u16*)(p.ws + OFF_P); const u16* NQR = (const u16*)(p.ws + OFF_NQR);
    const u16* KC = (const u16*)(p.ws + OFF_KVC); const u16* VC = KC + (size_t)NB * 512 * 64;
    u16* OC = (u16*)(p.ws + OFF_OC); unsigned* SEL = (unsigned*)(p.ws + OFF_SEL);
    const float* FS = (const float*)(p.ws + OFF_FS); u16* O = (u16*)(p.ws + OFF_O);
    const int tid = tid_opaque(), lane = tid & 63, w = tid >> 6, g = lane >> 4, c = lane & 15;
    const int b = blk >> 7, s0 = (blk & 127) * 64;
    const unsigned* FLk = (const unsigned*)(p.ws + OFF_FLAGS) + layer * 1024 + 720;
    if (part == 0) {
        const int sq = s0 + 16 * w + c;
        const size_t tok = (size_t)b * SEQ + sq;
        block_sync();
        for (int i = tid; i < 64 * 128; i += 256) sImp[i] = 0.f;
        const int ntile = ((s0 + 32) / 16) / 64 + 1;
        const int cmax = (sq - 31) >> 4, cmin = (s0 + 16 * w - 31) >> 4;
        const u16* KCb = KC + ((size_t)b * 512) * 64; const u16* VCb = VC + ((size_t)b * 512) * 64;
        const int J = 4 * ntile;
        s16x8 qf[2][2]; float m[2], l[2]; f32x4 o[2][4]; float linv[2] = {0.f, 0.f}, acur[2] = {0.f, 0.f};
        qf[0][0] = qf[0][1] = qf[1][0] = qf[1][1] = (s16x8){0, 0, 0, 0, 0, 0, 0, 0}; attn_init<2>(m, l, o);
        const float mC = logit_bound(FLk, 6, 10, 11);
        KVPref pf;
        kv_load(pf, KCb, VCb, 64, tid);
        kv_store(smem, smem + ATT_SK, pf, tid);
        { const int k1 = 1 < ntile ? 1 : 0; kv_load(pf, KCb + (size_t)k1 * 64 * 64, VCb + (size_t)k1 * 64 * 64, 64, tid); }
        int hp = 0, jj = 0, cur = 0, kt1 = 1 < ntile ? 1 : 0;
        for (int j = 0; j < J; ++j) {
            block_sync();
            if (j + 1 < J) kv_store(smem + (cur ^ 1) * STG, smem + (cur ^ 1) * STG + ATT_SK, pf, tid);
            int kt2 = kt1 + 1; if (kt2 >= ntile) kt2 = 0;
            if (j + 2 < J) kv_load(pf, KCb + (size_t)kt2 * 64 * 64, VCb + (size_t)kt2 * 64 * 64, 64, tid);
            const char* sK = smem + cur * STG; const char* sV = sK + ATT_SK;
            if (jj == 0) {
#pragma unroll
                for (int q = 0; q < 2; ++q) {
                    qf[q][0] = *(const s16x8*)(P + tok * PW + C_NQ + (2 * hp + q) * 64 + 8 * g); qf[q][1] = *(const s16x8*)(P + tok * PW + C_NQ + (2 * hp + q) * 64 + 32 + 8 * g);
                }
                attn_init<2>(m, l, o); m[0] = m[1] = mC;
            }
            if (jj < ntile) {
                const int kt = jj;
                attn_tile64<2>(sK, sV, qf, m, l, o, lane, [&](int, int T, f32x4& s) {
                    const int c0 = kt * 64 + 16 * T + 4 * g;
#pragma unroll
                    for (int r = 0; r < 4; ++r) s[r] = (c0 + r <= cmax) ? s[r] * SC2 : -INFINITY;
                }, kt * 64 + 63 <= cmin, 0.f, 0.f, true);
                if (jj == ntile - 1) {
#pragma unroll
                    for (int q = 0; q < 2; ++q) {
                        const float lt = attn_ltot(l[q]);
                        linv[q] = lt > 0.f ? 1.f / lt : 0.f;
#pragma unroll
                        for (int dt = 0; dt < 4; ++dt) {
                            u32x2 ov = {pk2(o[q][dt][0] * linv[q], o[q][dt][1] * linv[q]), pk2(o[q][dt][2] * linv[q], o[q][dt][3] * linv[q])};
                            *(u32x2*)(OC + tok * 256 + (2 * hp + q) * 64 + 16 * dt + 4 * g) = ov;
                        }
                        acur[q] = 0.f;
                    }
                }
            } else {
                const int kt = jj - ntile;
#pragma unroll
                for (int T = 0; T < 4; ++T) {
                    const int row = 16 * T + c;
                    const s16x8 k0 = *(const s16x8*)(sK + row * 128 + ((g ^ (row & 7)) << 4));
                    const s16x8 k1 = *(const s16x8*)(sK + row * 128 + (((4 + g) ^ (row & 7)) << 4));
                    const int c0 = kt * 64 + 16 * T + 4 * g;
                    float add = 0.f;
#pragma unroll
                    for (int q = 0; q < 2; ++q) {
                        f32x4 z = {0.f, 0.f, 0.f, 0.f}; z = mfma16(k0, qf[q][0], z); z = mfma16(k1, qf[q][1], z);
                        float pr[4];
#pragma unroll
                        for (int r = 0; r < 4; ++r) pr[r] = (c0 + r <= cmax) ? __builtin_amdgcn_exp2f(z[r] * SC2 - m[q]) * linv[q] : 0.f;
                        const float a = __shfl(pr[3], (lane + 48) & 63);
                        const float prev = g > 0 ? a : acur[q];
                        acur[q] = a;
                        add += pr[0] + pr[1] + pr[2] + pr[3] + prev;
                    }
                    sImp[(16 * w + c) * 128 + 16 * kt + 4 * T + g] += add;
                }
            }
            ++jj; if (jj == 2 * ntile) { jj = 0; ++hp; }
            kt1 = kt2; cur ^= 1;
        }
        block_sync();
        for (int tl = 0; tl < 16; ++tl) {
            const int sp = s0 + 16 * w + tl, curb = sp >> 6;
            unsigned k0, k1; bool sel0 = false, sel1 = false;
            {
                const int n0 = lane, n1 = lane + 64;
                float v0 = sImp[(16 * w + tl) * 128 + n0], v1 = sImp[(16 * w + tl) * 128 + n1];
                if (n0 == 0 || n0 == curb || n0 == curb - 1) v0 = 1e6f;
                if (n1 == curb || n1 == curb - 1) v1 = 1e6f;
                k0 = n0 <= curb ? (((__float_as_uint(v0) | 0x80000000u) & ~127u) | (unsigned)(127 - n0)) : 0u;
                k1 = n1 <= curb ? (((__float_as_uint(v1) | 0x80000000u) & ~127u) | (unsigned)(127 - n1)) : 0u;
            }
            if (curb < 16) { sel0 = k0 != 0u; sel1 = k1 != 0u; }
            else {
                unsigned thr = 0x80000000u;
                for (int bit = 30; bit >= 0; --bit) {
                    const unsigned t = thr | (1u << bit);
                    const int cnt = __popcll(__ballot(k0 >= t)) + __popcll(__ballot(k1 >= t));
                    if (cnt >= 16) thr = t;
                }
                sel0 = k0 >= thr; sel1 = k1 >= thr;
            }
            const unsigned long long b0 = __ballot(sel0), b1 = __ballot(sel1);
            if (lane == 0) { u32x4 mk = {(unsigned)b0, (unsigned)(b0 >> 32), (unsigned)b1, (unsigned)(b1 >> 32)}; *(u32x4*)(SEL + ((size_t)b * SEQ + sp) * 4) = mk; }
        }
    }
    const int h = w;
    if (part > 0) {
        const int sub = part - 1;
        const int t0 = s0 + 32 * sub;
        s16x8 qf[2][2]; u32x4 msk[2];
#pragma unroll
        for (int qt = 0; qt < 2; ++qt) {
            const size_t tok = (size_t)b * SEQ + t0 + 16 * qt + c;
            qf[qt][0] = *(const s16x8*)(NQR + tok * 256 + h * 64 + 8 * g);
            qf[qt][1] = *(const s16x8*)(NQR + tok * 256 + h * 64 + 32 + 8 * g);
            msk[qt] = *(const u32x4*)(SEL + tok * 4);
        }
        float m[2], l[2]; f32x4 o[2][4]; attn_init<2>(m, l, o);
        const float mW = logit_bound(FLk, 6, 3), mS = logit_bound(FLk, 6, 2);
        m[0] = m[1] = mW;
        int klo = t0 - 511; if (klo < 0) klo = 0; klo >>= 6;
        const int khi = (t0 + 31) >> 6;
        u32x4 un;
        {
            u32x4 t = {msk[0][0] | msk[1][0], msk[0][1] | msk[1][1], msk[0][2] | msk[1][2], msk[0][3] | msk[1][3]};
#pragma unroll
            for (int o2 = 1; o2 < 16; o2 <<= 1) { t[0] |= (unsigned)__shfl_xor((int)t[0], o2); t[1] |= (unsigned)__shfl_xor((int)t[1], o2); t[2] |= (unsigned)__shfl_xor((int)t[2], o2); t[3] |= (unsigned)__shfl_xor((int)t[3], o2); }
            un = t;
        }
        auto next_tag = [&](int tag) -> int {
            if (tag < 256) return tag < khi ? tag + 1 : 256;
            int q = tag - 256 + 1;
            while (q < 128) {
                const unsigned uw = (q < 32 ? un[0] : (q < 64 ? un[1] : (q < 96 ? un[2] : un[3]))) >> (q & 31);
                if (uw) return 256 + q + __builtin_ctz(uw);
                q = (q | 31) + 1;
            }
            return -1;
        };
        auto load_tag = [&](KVPref& q, int tag) {
            if (tag < 256) { const size_t kt0 = (size_t)b * SEQ + tag * 64; kv_load(q, P + kt0 * PW + C_NKW, P + kt0 * PW + C_NVW, PW, tid); }
            else { const size_t kt0 = (size_t)b * SEQ + (tag - 256) * 64; kv_load(q, P + kt0 * PW + C_NKS, P + kt0 * PW + C_NVS, PW, tid); }
        };
        f32x4 ow[2][4];
        KVPref pf;
        int tagA = klo, tagB = next_tag(klo), cur = 0;
        load_tag(pf, tagA);
        block_sync();
        kv_store(smem, smem + ATT_SK, pf, tid);
        load_tag(pf, tagB);
        for (;;) {
            block_sync();
            if (tagB >= 0) kv_store(smem + (cur ^ 1) * STG, smem + (cur ^ 1) * STG + ATT_SK, pf, tid);
            const int tagC = tagB >= 0 ? next_tag(tagB) : -1;
            if (tagC >= 0) load_tag(pf, tagC);
            const char* sK = smem + cur * STG; const char* sV = sK + ATT_SK;
            if (tagA < 256) {
                const int kt = tagA;
                attn_tile64<2>(sK, sV, qf, m, l, o, lane, [&](int qt, int T, f32x4& s) {
                    const int qpos = t0 + 16 * qt + c, k0 = kt * 64 + 16 * T + 4 * g;
#pragma unroll
                    for (int r = 0; r < 4; ++r) s[r] = (k0 + r <= qpos && k0 + r > qpos - 512) ? s[r] * SC2 : -INFINITY;
                }, kt * 64 + 63 <= t0 && kt * 64 > t0 + 31 - 512, 0.f, 0.f, true);
                if (kt == khi) {
#pragma unroll
                    for (int qt = 0; qt < 2; ++qt) {
                        const float inv = 1.f / attn_ltot(l[qt]);
#pragma unroll
                        for (int dt = 0; dt < 4; ++dt) ow[qt][dt] = o[qt][dt] * inv;
                    }
                    attn_init<2>(m, l, o); m[0] = m[1] = mS;
                }
            } else {
                const int n = tagA - 256;
                const unsigned w0 = n < 32 ? msk[0][0] : (n < 64 ? msk[0][1] : (n < 96 ? msk[0][2] : msk[0][3]));
                const unsigned w1 = n < 32 ? msk[1][0] : (n < 64 ? msk[1][1] : (n < 96 ? msk[1][2] : msk[1][3]));
                const bool bit0 = (w0 >> (n & 31)) & 1u, bit1 = (w1 >> (n & 31)) & 1u;
                attn_tile64<2>(sK, sV, qf, m, l, o, lane, [&](int qt, int T, f32x4& s) {
                    const int qpos = t0 + 16 * qt + c, k0 = n * 64 + 16 * T + 4 * g;
                    const float lb = (qt == 0 ? bit0 : bit1) ? 0.f : -INFINITY;
#pragma unroll
                    for (int r = 0; r < 4; ++r) s[r] = (k0 + r <= qpos) ? s[r] * SC2 + lb : -INFINITY;
                }, n * 64 + 63 <= t0, bit0 ? 0.f : -INFINITY, bit1 ? 0.f : -INFINITY, true);
            }
            if (tagB < 0) break;
            tagA = tagB; tagB = tagC; cur ^= 1;
        }
#pragma unroll
        for (int qt = 0; qt < 2; ++qt) {
            const float lt = attn_ltot(l[qt]); const float inv = lt > 0.f ? 1.f / lt : 0.f;
            const size_t tok = (size_t)b * SEQ + t0 + 16 * qt + c;
            const float g0 = sigmoidf_(FS[tok * 16 + 4 + h * 3 + 0]), g1 = sigmoidf_(FS[tok * 16 + 4 + h * 3 + 1]), g2 = sigmoidf_(FS[tok * 16 + 4 + h * 3 + 2]);
#pragma unroll
            for (int dt = 0; dt < 4; ++dt) {
                const u32x2 oc = *(const u32x2*)(OC + tok * 256 + h * 64 + 16 * dt + 4 * g);
                const float r0 = g0 * bflo(oc[0]) + g1 * o[qt][dt][0] * inv + g2 * ow[qt][dt][0];
                const float r1 = g0 * bfhi(oc[0]) + g1 * o[qt][dt][1] * inv + g2 * ow[qt][dt][1];
                const float r2 = g0 * bflo(oc[1]) + g1 * o[qt][dt][2] * inv + g2 * ow[qt][dt][2];
                const float r3 = g0 * bfhi(oc[1]) + g1 * o[qt][dt][3] * inv + g2 * ow[qt][dt][3];
                u32x2 ov = {pk2(r0, r1), pk2(r2, r3)};
                *(u32x2*)(O + tok * OW + O_NSA + h * 64 + 16 * dt + 4 * g) = ov;
            }
        }
    }
}

DEVI void item_signal(unsigned* flag) {
    asm volatile("s_waitcnt vmcnt(0)" ::: "memory");
    block_sync();
    if (threadIdx.x == 0) {
        __builtin_amdgcn_fence(__ATOMIC_RELEASE, "agent");
        asm volatile("s_waitcnt vmcnt(0)" ::: "memory");
        __hip_atomic_fetch_add(flag, 1u, __ATOMIC_RELAXED, __HIP_MEMORY_SCOPE_AGENT);
    }
}
DEVI void item_wait(unsigned* flag, unsigned need) {
    if (threadIdx.x == 0) {
        unsigned sp = 0;
        while (__hip_atomic_load(flag, __ATOMIC_RELAXED, __HIP_MEMORY_SCOPE_AGENT) < need && sp < (1u << 24)) { __builtin_amdgcn_s_sleep(4); ++sp; }
        __builtin_amdgcn_fence(__ATOMIC_ACQUIRE, "agent");
        asm volatile("s_waitcnt vmcnt(0)" ::: "memory");
    }
    block_sync();
}
DEVI void ph_branches(const Params& p, int layer, char* smem, int bid, int nblk, unsigned* qctr) {
    volatile LAS int* sItem = (volatile LAS int*)(smem + SMEM_BYTES - 4);
    unsigned* FL = (unsigned*)(p.ws + OFF_FLAGS) + layer * 1024;
    for (;;) {
        block_sync();
        if (threadIdx.x == 0) *sItem = (int)__hip_atomic_fetch_add(qctr, 1u, __ATOMIC_RELAXED, __HIP_MEMORY_SCOPE_AGENT);
        block_sync();
        int it = *sItem;
        if (it < 64) { ph_cmp(p, layer, smem, it, 64); item_signal(FL + ((it & 31) >> 3)); continue; }
        it -= 64;
        if (it < 16) { ph_foxcum(p, layer, smem, it, 16); item_signal(FL + 600 + it); continue; }
        it -= 16;
        if (it < 512) { ph_lru<0>(p, layer, smem, it, 512); item_signal(FL + 4 + (it >> 7)); continue; }
        it -= 512;
        if (it < 512) { dil_item(p, layer, smem, it); continue; }
        it -= 512;
        if (it < 512) { item_wait(FL + 4 + (it >> 7), 128u); ph_lru<1>(p, layer, smem, it, 512); continue; }
        it -= 512;
        if (it < 512) {
            const int lvl = it >> 3, jj = it & 7, b = jj >> 1, blk = b * 128 + (63 - lvl) * 2 + (jj & 1);
            item_wait(FL + 0, 16u); item_wait(FL + 1, 16u); item_wait(FL + 2, 16u); item_wait(FL + 3, 16u);
            nsa_item(p, layer, smem, blk, 0);
            item_signal(FL + 8 + blk);
            continue;
        }
        it -= 512;
        if (it < 1024) { item_wait(FL + 600 + (it & 15), 1u); fox_item(p, layer, smem, 63 - (it >> 4), it & 15); continue; }
        it -= 1024;
        if (it < 1024) {
            const int lvl = it >> 4, jj = it & 15, b = jj >> 2, blk = b * 128 + (63 - lvl) * 2 + ((jj >> 1) & 1);
            item_wait(FL + 8 + blk, 1u);
            nsa_item(p, layer, smem, blk, 1 + (jj & 1));
            continue;
        }
        break;
    }
}

DEVI void ph_merge(const Params& p, int layer, char* smem, int bid, int nblk) {
    const char* A8 = p.ws + OFF_H1Q; const float* AS = (const float*)(p.ws + OFF_H1S); const u16* O = (const u16*)(p.ws + OFF_O);
    const char* Wg8 = p.ws + OFF_WI8 + ((size_t)layer * WIN_ROWS + WIN_GATE0) * 1024; const float* SWg = (const float*)(p.ws + OFF_SWI) + (size_t)layer * WIN_ROWS + WIN_GATE0;
    const u16* Wbr = (const u16*)(p.ws + OFF_WBR) + (size_t)layer * 1024 * OW;
    u16* MG = (u16*)(p.ws + OFF_MERGED);
    const int tid_ = tid_opaque(), lane = tid_ & 63, w = tid_ >> 6, wm = w >> 1, wn = w & 1, g = lane >> 4, c = lane & 15;
    const TileMap tmp = tile_map(smem, bid, nblk, NTOK / 128, 8);
    const int ntl = tmp.j0 < tmp.jend ? (tmp.jend - 1 - tmp.j0) / tmp.jstep + 1 : 0;
    u32x2 mg[4][4];
    u32x2 sg[4][4];
#pragma unroll
    for (int i = 0; i < 4; ++i)
#pragma unroll
        for (int j = 0; j < 4; ++j) { sg[i][j] = (u32x2){0u, 0u}; mg[i][j] = (u32x2){0u, 0u}; }
    gemm_stream<128, 128, false>(smem, 0, 1, ntl * 8,
        [&](int j) {
            int tm_, tn_; tile_decode(tmp, tmp.j0 + (j >> 3) * tmp.jstep, tm_, tn_);
            const int job = j & 7, br = job >> 1; const bool isy = job & 1;
            const int kb = br == 2 ? 128 : 256, oc = br == 0 ? O_FOX : (br == 1 ? O_LRU : (br == 2 ? O_DIL : O_NSA));
            GJob jb;
            jb.A = isy ? (const char*)(O + oc) : A8; jb.lda = isy ? (size_t)OW * 2 : (size_t)128; jb.aks = isy ? (size_t)128 : (size_t)NTOK * 128;
            jb.Bt = isy ? (const char*)(Wbr + oc) : Wg8 + (size_t)br * 1024 * 1024; jb.ldb = isy ? (size_t)OW * 2 : (size_t)1024;
            jb.nk = isy ? kb / 64 : 8; jb.m0 = tm_ * 128; jb.n0 = tn_ * 128; jb.i8 = !isy;
            return jb;
        },
        [&](int j, f32x4 (&acc)[4][4]) {
            int tm_, tn_; tile_decode(tmp, tmp.j0 + (j >> 3) * tmp.jstep, tm_, tn_);
            const int job = j & 7; const bool isy = job & 1;
            float sa4[4];
            if (!isy) {
#pragma unroll
                for (int i = 0; i < 4; ++i) sa4[i] = AS[tm_ * 128 + wm * 64 + 16 * i + c];
            }
#pragma unroll
            for (int nt = 0; nt < 4; ++nt) {
                f32x4 sw = {0.f, 0.f, 0.f, 0.f};
                if (!isy) sw = *(const f32x4*)(SWg + (job >> 1) * 1024 + tn_ * 128 + wn * 64 + 16 * nt + 4 * g);
#pragma unroll
                for (int mt = 0; mt < 4; ++mt) {
                    if (isy) {
                        mg[mt][nt] = (u32x2){pk2(bflo(mg[mt][nt][0]) + bflo(sg[mt][nt][0]) * acc[mt][nt][0], bfhi(mg[mt][nt][0]) + bfhi(sg[mt][nt][0]) * acc[mt][nt][1]),
                                             pk2(bflo(mg[mt][nt][1]) + bflo(sg[mt][nt][1]) * acc[mt][nt][2], bfhi(mg[mt][nt][1]) + bfhi(sg[mt][nt][1]) * acc[mt][nt][3])};
                    } else {
                        const float sa = sa4[mt];
                        const i32x4 ai = __builtin_bit_cast(i32x4, acc[mt][nt]);
                        sg[mt][nt] = (u32x2){pk2(sigmoidf_((float)ai[0] * sa * sw[0]), sigmoidf_((float)ai[1] * sa * sw[1])), pk2(sigmoidf_((float)ai[2] * sa * sw[2]), sigmoidf_((float)ai[3] * sa * sw[3]))};
                    }
                }
                __builtin_amdgcn_sched_barrier(0);
            }
            if (job == 7) {
                const int m0 = tm_ * 128, n0 = tn_ * 128;
#pragma unroll
                for (int mt = 0; mt < 4; ++mt)
#pragma unroll
                    for (int nt = 0; nt < 4; ++nt) {
                        const int m = m0 + wm * 64 + 16 * mt + c, n = n0 + wn * 64 + 16 * nt + 4 * g;
                        *(u32x2*)(MG + (size_t)m * 1024 + n) = mg[mt][nt];
                        mg[mt][nt] = (u32x2){0u, 0u};
                    }
            }
        });
}
DEVI void ph_wout(const Params& p, int layer, char* smem, int bid, int nblk) {
    const u16* MG = (const u16*)(p.ws + OFF_MERGED);
    const u16* Wt = (const u16*)(p.ws + OFF_WOUT) + (size_t)layer * 1024 * 1024;
    u16* XR = XR_OF(p);
    const int tid_ = tid_opaque(), lane = tid_ & 63, w = tid_ >> 6, wm = w >> 1, wn = w & 1, g = lane >> 4, c = lane & 15;
    const TileMap tmp = tile_map(smem, bid, nblk, NTOK / 128, 8);
    gemm_stream<128, 128, true>(smem, tmp.j0, tmp.jstep, tmp.jend,
        [&](int t) { int tm_, tn_; tile_decode(tmp, t, tm_, tn_); GJob jb; jb.A = (const char*)MG; jb.lda = 2048; jb.aks = 128; jb.Bt = (const char*)Wt; jb.ldb = 2048; jb.nk = 16; jb.m0 = tm_ * 128; jb.n0 = tn_ * 128; jb.i8 = false; return jb; },
        [&](int t, f32x4 (&acc)[4][4]) {
            int tm_, tn_; tile_decode(tmp, t, tm_, tn_);
            const int m0 = tm_ * 128, n0 = tn_ * 128;
#pragma unroll
            for (int mt = 0; mt < 4; ++mt)
#pragma unroll
                for (int nt = 0; nt < 4; ++nt) {
                    const int m = m0 + wm * 64 + 16 * mt + c, n = n0 + wn * 64 + 16 * nt + 4 * g;
                    f32x4 xv;
                    if (layer == 0) xv = *(const f32x4*)(p.x + (size_t)m * DM + n);
                    else { const u32x2 xb = *(const u32x2*)(XR + (size_t)m * DM + n); xv = (f32x4){bflo(xb[0]), bfhi(xb[0]), bflo(xb[1]), bfhi(xb[1])}; }
                    xv = xv + acc[mt][nt];
                    *(u32x2*)(XR + (size_t)m * DM + n) = (u32x2){pk2(xv[0], xv[1]), pk2(xv[2], xv[3])};
                }
        });
}
DEVI void ph_peerq(const Params& p, int layer, char* smem, int bid, int nblk) {
    const char* A8 = p.ws + OFF_HQ; const float* AS = (const float*)(p.ws + OFF_HS);
    const char* W8 = p.ws + OFF_WQ8 + (size_t)layer * 2048 * 1024; const float* SW = (const float*)(p.ws + OFF_SWQ) + (size_t)layer * 2048;
    u16* QP = (u16*)(p.ws + OFF_QP);
    const int tid_ = tid_opaque(), lane = tid_ & 63, w = tid_ >> 6, wm = w >> 1, wn = w & 1, g = lane >> 4, c = lane & 15;
    const TileMap tmp = tile_map(smem, bid, nblk, NTOK / 128, 16);
    gemm_stream<128, 128, true>(smem, tmp.j0, tmp.jstep, tmp.jend,
        [&](int t) { int tm_, tn_; tile_decode(tmp, t, tm_, tn_); GJob jb; jb.A = A8; jb.lda = 128; jb.aks = (size_t)NTOK * 128; jb.Bt = W8; jb.ldb = 1024; jb.nk = 8; jb.m0 = tm_ * 128; jb.n0 = tn_ * 128; jb.i8 = true; return jb; },
        [&](int t, f32x4 (&acc)[4][4]) {
            int tm_, tn_; tile_decode(tmp, t, tm_, tn_);
            const int m0 = tm_ * 128, n0 = tn_ * 128;
            float sa4[4]; f32x4 sw4[4];
#pragma unroll
            for (int i = 0; i < 4; ++i) { sa4[i] = AS[m0 + wm * 64 + 16 * i + c]; sw4[i] = *(const f32x4*)(SW + n0 + wn * 64 + 16 * i + 4 * g); }
#pragma unroll
            for (int mt = 0; mt < 4; ++mt) {
                const int m = m0 + wm * 64 + 16 * mt + c;
                const float sa = sa4[mt];
#pragma unroll
                for (int nt = 0; nt < 4; ++nt) {
                    const int n = n0 + wn * 64 + 16 * nt + 4 * g;
                    const f32x4 sw = sw4[nt];
                    const i32x4 ai = __builtin_bit_cast(i32x4, acc[mt][nt]);
                    u32x2 ov = {pk2((float)ai[0] * sa * sw[0], (float)ai[1] * sa * sw[1]), pk2((float)ai[2] * sa * sw[2], (float)ai[3] * sa * sw[3])};
                    *(u32x2*)(QP + (size_t)m * 2048 + n) = ov;
                }
            }
        });
}
template <int N> DEVI void bitonic_sort_desc(unsigned (&k)[N]) {
#pragma unroll
    for (int sz = 2; sz <= N; sz <<= 1)
#pragma unroll
        for (int st = sz >> 1; st > 0; st >>= 1)
#pragma unroll
            for (int i = 0; i < N; ++i) {
                const int j = i ^ st;
                if (j > i) {
                    const bool desc = (i & sz) == 0;
                    const unsigned a = k[i], b = k[j], hi = a > b ? a : b, lo = a > b ? b : a;
                    k[i] = desc ? hi : lo; k[j] = desc ? lo : hi;
                }
            }
}
template <int N> DEVI void bitonic_merge_desc(unsigned (&k)[N]) {
#pragma unroll
    for (int st = N >> 1; st > 0; st >>= 1)
#pragma unroll
        for (int i = 0; i < N; ++i) {
            const int j = i ^ st;
            if (j > i) { const unsigned a = k[i], b = k[j]; k[i] = a > b ? a : b; k[j] = a > b ? b : a; }
        }
}
DEVI void merge_top16_xor(unsigned (&k)[16], int x) {
    unsigned t[16];
#pragma unroll
    for (int i = 0; i < 16; ++i) { const unsigned o = (unsigned)__shfl_xor((int)k[15 - i], x); t[i] = k[i] > o ? k[i] : o; }
    bitonic_merge_desc<16>(t);
#pragma unroll
    for (int i = 0; i < 16; ++i) k[i] = t[i];
}
DEVI unsigned f2ord(float f) { unsigned u = __float_as_uint(f); return u ^ ((u >> 31) ? 0xffffffffu : 0x80000000u); }
DEVI float ord2f(unsigned u) { return __uint_as_float(u ^ ((u >> 31) ? 0x80000000u : 0xffffffffu)); }

struct PairTab { unsigned char i[64], j[64]; };
__host__ __device__ constexpr PairTab make_pairs() {
    PairTab t{};
    int n = 0;
    for (int i = 0; i < 16; ++i) for (int j = 0; j < 16; ++j) if ((i + 1) * (j + 1) <= 16) { t.i[n] = (unsigned char)i; t.j[n] = (unsigned char)j; ++n; }
    for (; n < 64; ++n) { t.i[n] = 255; t.j[n] = 255; }
    return t;
}
constexpr PairTab kPairs = make_pairs();

DEVI void ph_peertop(const Params& p, int layer, char* smem, int bid, int nblk) {
    char* sSK = smem;
    unsigned char (*sIdx)[16][2][16] = (unsigned char (*)[16][2][16])(smem + 65536);
    const u16* QP = (const u16*)(p.ws + OFF_QP);
    const u16* SK = (const u16*)(p.ws + OFF_SUBK) + (size_t)layer * 2 * 128 * 128;
    u16* PIDX = (u16*)(p.ws + OFF_PIDX); float* PGW = (float*)(p.ws + OFF_PGW);
    const int tid = tid_opaque(), lane = tid & 63, w = tid >> 6, g = lane >> 4, c = lane & 15;
    block_sync();
    for (int i = tid; i < 4096; i += 256) { const int r = i >> 4, ch = i & 15; *(u32x4*)(sSK + r * 256 + ((ch ^ (r & 15)) << 4)) = *(const u32x4*)(SK + (size_t)r * 128 + ch * 8); }
    block_sync();
    s16x8 qnext[2][4];
    auto q_load = [&](int item, s16x8 (&q)[2][4]) {
        const int hd = item & 7; const size_t tok = (size_t)((item >> 3) * 16 + c);
#pragma unroll
        for (int pp = 0; pp < 2; ++pp)
#pragma unroll
            for (int ks = 0; ks < 4; ++ks) q[pp][ks] = *(const s16x8*)(QP + tok * 2048 + hd * 256 + pp * 128 + 32 * ks + 8 * g);
    };
    if (bid * 4 + w < (NTOK / 16) * 8) q_load(bid * 4 + w, qnext);
    for (int item = bid * 4 + w; item < (NTOK / 16) * 8; item += nblk * 4) {
        const int hd = item & 7, t0 = (item >> 3) * 16;
        const size_t tok = (size_t)t0 + c;
        unsigned top[2][16];
        s16x8 qcur[2][4];
#pragma unroll
        for (int pp = 0; pp < 2; ++pp)
#pragma unroll
            for (int ks = 0; ks < 4; ++ks) qcur[pp][ks] = qnext[pp][ks];
        if (item + nblk * 4 < (NTOK / 16) * 8) q_load(item + nblk * 4, qnext);
#pragma unroll
        for (int pp = 0; pp < 2; ++pp) {
            s16x8 qf[4];
#pragma unroll
            for (int ks = 0; ks < 4; ++ks) qf[ks] = qcur[pp][ks];
            unsigned key[32];
#pragma unroll
            for (int T = 0; T < 8; ++T) {
                f32x4 z = {0.f, 0.f, 0.f, 0.f};
#pragma unroll
                for (int ks = 0; ks < 4; ++ks) {
                    const int rw = pp * 128 + 16 * T + c; const s16x8 kf = *(const s16x8*)(sSK + rw * 256 + (((4 * ks + g) ^ (rw & 15)) << 4));
                    z = mfma16(kf, qf[ks], z);
                }
#pragma unroll
                for (int r = 0; r < 4; ++r) { const int n = 16 * T + 4 * g + r; key[4 * T + r] = (f2ord(z[r]) & ~127u) | (unsigned)(127 - n); }
            }
            bitonic_sort_desc<32>(key);
#pragma unroll
            for (int i = 0; i < 16; ++i) top[pp][i] = key[i];
            merge_top16_xor(top[pp], 16);
            merge_top16_xor(top[pp], 32);
#pragma unroll
            for (int i = 0; i < 16; ++i) if ((i >> 2) == g) sIdx[w][c][pp][i] = (unsigned char)(127 - (top[pp][i] & 127u));
        }
        float v0[16], v1[16];
#pragma unroll
        for (int i = 0; i < 16; ++i) { v0[i] = ord2f(top[0][i] & ~127u); v1[i] = ord2f(top[1][i] & ~127u); }
        unsigned ck[16];
#pragma unroll
        for (int e = 0; e < 16; ++e) {
            unsigned kk[4];
#pragma unroll
            for (int gg = 0; gg < 4; ++gg) {
                const int pi = kPairs.i[gg * 16 + e], pj = kPairs.j[gg * 16 + e];
                kk[gg] = pi < 16 ? ((f2ord(v0[pi < 16 ? pi : 0] + v1[pj < 16 ? pj : 0]) & ~255u) | (unsigned)(255 - (pi * 16 + pj))) : 0u;
            }
            ck[e] = g == 0 ? kk[0] : (g == 1 ? kk[1] : (g == 2 ? kk[2] : kk[3]));
        }
        bitonic_sort_desc<16>(ck);
        merge_top16_xor(ck, 16);
        merge_top16_xor(ck, 32);
        const float smax = ord2f(ck[0] & ~255u);
        float ex[16], den = 0.f;
#pragma unroll
        for (int i = 0; i < 16; ++i) { ex[i] = __expf(ord2f(ck[i] & ~255u) - smax); den += ex[i]; }
        const float rden = 1.f / den;
        int eidx[4]; float egw[4];
#pragma unroll
        for (int r = 0; r < 4; ++r) {
            const unsigned kq = g == 0 ? ck[r] : (g == 1 ? ck[4 + r] : (g == 2 ? ck[8 + r] : ck[12 + r]));
            const float eq = g == 0 ? ex[r] : (g == 1 ? ex[4 + r] : (g == 2 ? ex[8 + r] : ex[12 + r]));
            const int flat = 255 - (int)(kq & 255u), pi = flat >> 4, pj = flat & 15;
            eidx[r] = (int)sIdx[w][c][0][pi] * 128 + (int)sIdx[w][c][1][pj];
            egw[r] = eq * rden;
        }
        *(u32x2*)(PIDX + tok * 128 + hd * 16 + 4 * g) = (u32x2){(unsigned)eidx[0] | ((unsigned)eidx[1] << 16), (unsigned)eidx[2] | ((unsigned)eidx[3] << 16)};
        *(f32x4*)(PGW + tok * 128 + hd * 16 + 4 * g) = (f32x4){egw[0], egw[1], egw[2], egw[3]};
    }
}

struct G1Buf { u32x4 ra[8], rb[8]; i32x4 b0, b1; };
DEVI void g1_load(G1Buf& q, const unsigned char* UQ, const unsigned char* HQs, const u16* PIDX, int tok, int lane) {
    const int rr = lane >> 3, pc = lane & 7, g = lane >> 4;
#pragma unroll
    for (int hd = 0; hd < 8; ++hd) {
        const unsigned ew = *(const unsigned*)(PIDX + (size_t)tok * 128 + hd * 16 + 2 * rr);
        const int ea = (int)(ew & 0xffffu), eb = (int)(ew >> 16);
        q.ra[hd] = *(const u32x4*)(UQ + (size_t)ea * 128 + 16 * pc);
        q.rb[hd] = *(const u32x4*)(UQ + (size_t)eb * 128 + 16 * pc);
    }
    const unsigned char* hq = HQs + (size_t)tok * 128 + 32 * g;
    q.b0 = *(const i32x4*)(hq); q.b1 = *(const i32x4*)(hq + 16);
}
DEVI void g1_math(const G1Buf& q, char* sT, u16* part, int lane) {
    const int rr = lane >> 3, pc = lane & 7, g = lane >> 4, c = lane & 15;
#pragma unroll
    for (int hd = 0; hd < 8; ++hd) {
        *(u32x4*)(sT + (2 * rr) * 144 + pc * 16) = q.ra[hd];
        *(u32x4*)(sT + (2 * rr + 1) * 144 + pc * 16) = q.rb[hd];
        const i32x4 a0 = *(const i32x4*)(sT + c * 144 + 32 * g), a1 = *(const i32x4*)(sT + c * 144 + 32 * g + 16);
        i32x4 z = {0, 0, 0, 0};
        z = __builtin_amdgcn_mfma_i32_16x16x64_i8(a0, q.b0, z, 0, 0, 0);
        z = __builtin_amdgcn_mfma_i32_16x16x64_i8(a1, q.b1, z, 0, 0, 0);
        if (c == 0) *(u32x2*)(part + hd * 16 + 4 * g) = (u32x2){pk2((float)z[0], (float)z[1]), pk2((float)z[2], (float)z[3])};
    }
}
DEVI void ph_pg1(const Params& p, int layer, char* smem, int bid, int nblk) {
    const int tid = tid_opaque(), lane = tid & 63, w = tid >> 6;
    const XccInfo xi = xcc_info(smem, bid, nblk);
    char* sT = smem + w * 2304;
    const u16* PIDX = (const u16*)(p.ws + OFF_PIDX); u16* PART = (u16*)(p.ws + OFF_PART);
    const int step = xi.tstep * 4;
    for (int sl = xi.s0; sl < 8; sl += xi.sstep) {
        const unsigned char* UQ = (const unsigned char*)(p.ws + OFF_PUV) + ((size_t)(layer * 2) * 8 + sl) * NEXP * 128;
        const unsigned char* HQs = (const unsigned char*)(p.ws + OFF_HQ) + (size_t)sl * NTOK * 128;
        u16* parts = PART + (size_t)sl * NTOK * 128;
        int tok = xi.t0 * 4 + w;
        if (tok >= NTOK) continue;
        G1Buf qa, qb;
        g1_load(qa, UQ, HQs, PIDX, tok, lane);
        for (;;) {
            const bool v1 = tok + step < NTOK;
            if (v1) g1_load(qb, UQ, HQs, PIDX, tok + step, lane);
            g1_math(qa, sT, parts + (size_t)tok * 128, lane);
            if (!v1) break;
            const bool v2 = tok + 2 * step < NTOK;
            if (v2) g1_load(qa, UQ, HQs, PIDX, tok + 2 * step, lane);
            g1_math(qb, sT, parts + (size_t)(tok + step) * 128, lane);
            if (!v2) break;
            tok += 2 * step;
        }
    }
}
DEVI void ph_pg2(const Params& p, int layer, int bid, int nblk) {
    const u16* PIDX = (const u16*)(p.ws + OFF_PIDX); const float* PGW = (const float*)(p.ws + OFF_PGW); const u16* PART = (const u16*)(p.ws + OFF_PART);
    const float* SU = (const float*)(p.ws + OFF_PSC) + (size_t)(layer * 2) * NEXP; const float* SV = SU + NEXP;
    const float* HS = (const float*)(p.ws + OFF_HS); signed char* PWQ = (signed char*)(p.ws + OFF_PW); float* PWS = (float*)(p.ws + OFF_PWS);
    const int lane = tid_opaque() & 63;
    const int stride = nblk * 4;
    for (int tok0 = bid * 4 + (threadIdx.x >> 6); tok0 < NTOK; tok0 += stride * 4) {
        float wv[4][2], am[4];
        unsigned pw[4][8]; int e0[4], e1[4]; float g0[4], g1[4], hs[4];
#pragma unroll
        for (int r = 0; r < 4; ++r) {
            const int tok = tok0 + r * stride < NTOK ? tok0 + r * stride : tok0;
            const size_t i = (size_t)tok * 128 + 2 * lane;
#pragma unroll
            for (int sl = 0; sl < 8; ++sl) pw[r][sl] = *(const unsigned*)(PART + (size_t)sl * NTOK * 128 + i);
            { const unsigned ew = *(const unsigned*)(PIDX + i); e0[r] = (int)(ew & 0xffffu); e1[r] = (int)(ew >> 16); }
            g0[r] = PGW[i]; g1[r] = PGW[i + 1]; hs[r] = HS[tok];
        }
#pragma unroll
        for (int r = 0; r < 4; ++r) {
            float z0 = 0.f, z1 = 0.f;
#pragma unroll
            for (int sl = 0; sl < 8; ++sl) { z0 += bflo(pw[r][sl]); z1 += bfhi(pw[r][sl]); }
            wv[r][0] = g0[r] * gelu_tanh(z0 * SU[e0[r]] * hs[r]) * SV[e0[r]];
            wv[r][1] = g1[r] * gelu_tanh(z1 * SU[e1[r]] * hs[r]) * SV[e1[r]];
            am[r] = fmaxf(fabsf(wv[r][0]), fabsf(wv[r][1]));
        }
#pragma unroll
        for (int o = 32; o > 0; o >>= 1)
#pragma unroll
            for (int r = 0; r < 4; ++r) am[r] = fmaxf(am[r], __shfl_xor(am[r], o));
#pragma unroll
        for (int r = 0; r < 4; ++r) {
            const int tok = tok0 + r * stride;
            if (tok < NTOK) {
                const float inv = am[r] > 0.f ? 127.f / am[r] : 0.f;
                *(u16*)(PWQ + (size_t)tok * 128 + 2 * lane) = (u16)(((unsigned)(int)rintf(wv[r][0] * inv) & 0xffu) | (((unsigned)(int)rintf(wv[r][1] * inv) & 0xffu) << 8));
                if (lane == 0) PWS[tok] = am[r] * (1.f / 127.f);
            }
        }
    }
}
struct G3Buf { u32x4 vb[16]; i32x4 bop; };
DEVI void g3_load(G3Buf& q, const unsigned char* VQ, const u16* PIDX, const signed char* PWQ, int tok, int lane) {
    const int r = lane >> 3, i8 = lane & 7;
    u32x4 ei[2];
#pragma unroll
    for (int k = 0; k < 2; ++k) ei[k] = *(const u32x4*)(PIDX + (size_t)tok * 128 + 16 * r + 8 * k);
#pragma unroll
    for (int k = 0; k < 16; ++k) { const unsigned e = (ei[k >> 3][(k >> 1) & 3] >> (16 * (k & 1))) & 0xffffu; q.vb[k] = *(const u32x4*)(VQ + (size_t)e * 128 + 16 * i8); }
    const int cB = lane & 15, gB = lane >> 4;
    q.bop = (i32x4){0, 0, 0, 0};
    if (cB < 2) q.bop = *(const i32x4*)(PWQ + (size_t)tok * 128 + 32 * gB + 16 * cB);
}
DEVI void g3_math(const G3Buf& q, u16* xrow, float wscale, char* sOut, int lane) {
    int* so = (int*)sOut;
    const int gD = lane >> 4, cD = lane & 15;
    const bool wr = (cD == 0 && gD < 2) || (cD == 1 && gD >= 2);
    const int par = cD, i80 = 4 * (gD & 1);
#pragma unroll
    for (int qq = 0; qq < 4; ++qq) {
        i32x4 T[4];
#pragma unroll
        for (int kb = 0; kb < 4; ++kb) {
            const unsigned in0 = q.vb[4 * kb + 0][qq], in1 = q.vb[4 * kb + 1][qq], in2 = q.vb[4 * kb + 2][qq], in3 = q.vb[4 * kb + 3][qq];
            const unsigned t0 = __builtin_amdgcn_perm(in1, in0, 0x05010400u), t1 = __builtin_amdgcn_perm(in1, in0, 0x07030602u);
            const unsigned t2 = __builtin_amdgcn_perm(in3, in2, 0x05010400u), t3 = __builtin_amdgcn_perm(in3, in2, 0x07030602u);
            T[0][kb] = (int)__builtin_amdgcn_perm(t2, t0, 0x05040100u); T[1][kb] = (int)__builtin_amdgcn_perm(t2, t0, 0x07060302u);
            T[2][kb] = (int)__builtin_amdgcn_perm(t3, t1, 0x05040100u); T[3][kb] = (int)__builtin_amdgcn_perm(t3, t1, 0x07060302u);
        }
#pragma unroll
        for (int j = 0; j < 4; ++j) {
            i32x4 d = {0, 0, 0, 0};
            d = __builtin_amdgcn_mfma_i32_16x16x64_i8(T[j], q.bop, d, 0, 0, 0);
            if (wr) *(i32x4*)(so + par * 128 + (4 * qq + j) * 8 + i80) = d;
        }
    }
    if (lane < 32) {
        i32x4 a, b2;
#pragma unroll
        for (int e = 0; e < 4; ++e) { a[e] = so[(4 * (lane & 3) + e) * 8 + (lane >> 2)]; b2[e] = so[128 + (4 * (lane & 3) + e) * 8 + (lane >> 2)]; }
        const u32x2 xb = *(const u32x2*)(xrow + 4 * lane);
        const float v0 = bflo(xb[0]) + (float)(a[0] + b2[0]) * wscale, v1 = bfhi(xb[0]) + (float)(a[1] + b2[1]) * wscale;
        const float v2 = bflo(xb[1]) + (float)(a[2] + b2[2]) * wscale, v3 = bfhi(xb[1]) + (float)(a[3] + b2[3]) * wscale;
        *(u32x2*)(xrow + 4 * lane) = (u32x2){pk2(v0, v1), pk2(v2, v3)};
    }
}
DEVI void ph_pg3(const Params& p, int layer, char* smem, int bid, int nblk) {
    const int tid = tid_opaque(), lane = tid & 63, w = tid >> 6;
    const XccInfo xi = xcc_info(smem, bid, nblk);
    const u16* PIDX = (const u16*)(p.ws + OFF_PIDX); const signed char* PWQ = (const signed char*)(p.ws + OFF_PW); const float* PWS = (const float*)(p.ws + OFF_PWS);
    char* sOut = smem + w * 1024;
    const int step = xi.tstep * 4;
    for (int sl = xi.s0; sl < 8; sl += xi.sstep) {
        const unsigned char* VQ = (const unsigned char*)(p.ws + OFF_PUV) + ((size_t)(layer * 2 + 1) * 8 + sl) * NEXP * 128;
        u16* xs = XR_OF(p) + sl * 128;
        int tok = xi.t0 * 4 + w;
        if (tok >= NTOK) continue;
        G3Buf qa, qb;
        g3_load(qa, VQ, PIDX, PWQ, tok, lane);
        for (;;) {
            const bool v1 = tok + step < NTOK;
            if (v1) g3_load(qb, VQ, PIDX, PWQ, tok + step, lane);
            g3_math(qa, xs + (size_t)tok * DM, PWS[tok], sOut, lane);
            if (!v1) break;
            const bool v2 = tok + 2 * step < NTOK;
            if (v2) g3_load(qa, VQ, PIDX, PWQ, tok + 2 * step, lane);
            g3_math(qb, xs + (size_t)(tok + step) * DM, PWS[tok + step], sOut, lane);
            if (!v2) break;
            tok += 2 * step;
        }
    }
}

template <int l>
DEVI void layer_body(char* smem, int bid, int nblk, unsigned& epoch) {
        { const Params p = kp_load(kp_get()); char* ws = p.ws; (void)ws; unsigned* ctrl = (unsigned*)(p.ws + OFF_CTRL); (void)ctrl; ph_proj(p, l, smem, bid, nblk); }
        { const Params p = kp_load(kp_get()); grid_bar(p.ws, smem, epoch); }
        { const Params p = kp_load(kp_get()); char* ws = p.ws; (void)ws; unsigned* ctrl = (unsigned*)(p.ws + OFF_CTRL); (void)ctrl; ph_branches(p, l, smem, bid, nblk, ctrl + 8 + l); }
        { const Params p = kp_load(kp_get()); grid_bar(p.ws, smem, epoch); }
        { const Params p = kp_load(kp_get()); char* ws = p.ws; (void)ws; unsigned* ctrl = (unsigned*)(p.ws + OFF_CTRL); (void)ctrl; ph_merge(p, l, smem, bid, nblk); }
        { const Params p = kp_load(kp_get()); grid_bar(p.ws, smem, epoch); }
        { const Params p = kp_load(kp_get()); char* ws = p.ws; (void)ws; unsigned* ctrl = (unsigned*)(p.ws + OFF_CTRL); (void)ctrl; ph_wout(p, l, smem, bid, nblk); }
        { const Params p = kp_load(kp_get()); grid_bar(p.ws, smem, epoch); }
        { const Params p = kp_load(kp_get()); char* ws = p.ws; (void)ws; unsigned* ctrl = (unsigned*)(p.ws + OFF_CTRL); (void)ctrl; ph_rmsq<true>(XR_OF(p), p.norm2_g + l * 1024, (unsigned char*)(ws + OFF_HQ), (float*)(ws + OFF_HS), bid, nblk); }
        { const Params p = kp_load(kp_get()); grid_bar(p.ws, smem, epoch); }
        { const Params p = kp_load(kp_get()); char* ws = p.ws; (void)ws; unsigned* ctrl = (unsigned*)(p.ws + OFF_CTRL); (void)ctrl; ph_peerq(p, l, smem, bid, nblk); }
        { const Params p = kp_load(kp_get()); grid_bar(p.ws, smem, epoch); }
        { const Params p = kp_load(kp_get()); char* ws = p.ws; (void)ws; unsigned* ctrl = (unsigned*)(p.ws + OFF_CTRL); (void)ctrl; ph_peertop(p, l, smem, bid, nblk); }
        { const Params p = kp_load(kp_get()); grid_bar(p.ws, smem, epoch); }
        { const Params p = kp_load(kp_get()); char* ws = p.ws; (void)ws; unsigned* ctrl = (unsigned*)(p.ws + OFF_CTRL); (void)ctrl; ph_pg1(p, l, smem, bid, nblk); }
        { const Params p = kp_load(kp_get()); grid_bar(p.ws, smem, epoch); }
        { const Params p = kp_load(kp_get()); char* ws = p.ws; (void)ws; unsigned* ctrl = (unsigned*)(p.ws + OFF_CTRL); (void)ctrl; ph_pg2(p, l, bid, nblk); }
        { const Params p = kp_load(kp_get()); grid_bar(p.ws, smem, epoch); }
        { const Params p = kp_load(kp_get()); char* ws = p.ws; (void)ws; unsigned* ctrl = (unsigned*)(p.ws + OFF_CTRL); (void)ctrl; ph_pg3(p, l, smem, bid, nblk); }
        { const Params p = kp_load(kp_get()); grid_bar(p.ws, smem, epoch); }
        if (l + 1 < NLAYER) {
            { const Params p = kp_load(kp_get()); char* ws = p.ws; (void)ws; unsigned* ctrl = (unsigned*)(p.ws + OFF_CTRL); (void)ctrl; ph_rmsq<true>(XR_OF(p), p.norm1_g + (l + 1) * 1024, (unsigned char*)(ws + OFF_H1Q), (float*)(ws + OFF_H1S), bid, nblk); }
            { const Params p = kp_load(kp_get()); grid_bar(p.ws, smem, epoch); }
        }
    }

__global__ void __launch_bounds__(256, 2) mega(Params p) {
    extern __shared__ __attribute__((aligned(16))) char smem[];
    cg::grid_group grid = cg::this_grid();
    const int bid = blockIdx.x, nblk = gridDim.x;
    unsigned epoch = 0;
#if PROBE
    { const Params p = kp_load(kp_get()); if (blockIdx.x == 0 && threadIdx.x == 0) ((unsigned long long*)(p.ws + OFF_CTRL + 64))[62] = wall_clock64(); }
#endif
    { const Params p = kp_load(kp_get());
      if (threadIdx.x == 0) { volatile LAS unsigned* st = (volatile LAS unsigned*)(smem + SMEM_BYTES - 16); st[0] = 0u; st[1] = 0u;
        st[2] = xb_add(&((unsigned*)(p.ws + OFF_XBAR))[XB_XCNT(xb_xcc_id())], 1u); } }
    __syncthreads();
    { const Params p = kp_load(kp_get()); char* ws = p.ws; (void)ws; unsigned* ctrl = (unsigned*)(p.ws + OFF_CTRL); (void)ctrl; ph_tconv(p, smem, bid, nblk); }
    { const Params p = kp_load(kp_get()); char* ws = p.ws; (void)ws; unsigned* ctrl = (unsigned*)(p.ws + OFF_CTRL); (void)ctrl; ph_cvt(p.peer_sub_keys, (u16*)(ws + OFF_SUBK), (size_t)NLAYER * 2 * 128 * 128 / 4, bid, nblk); }
    { const Params p = kp_load(kp_get()); char* ws = p.ws; (void)ws; unsigned* ctrl = (unsigned*)(p.ws + OFF_CTRL); (void)ctrl; ph_misc(p, bid, nblk); }
    { const Params p = kp_load(kp_get()); ph_lrufrag(p, (bid + nblk - 64) % nblk, nblk); }
    { const Params p = kp_load(kp_get()); ph_bias1(p, smem, (bid + nblk - 32) % nblk, nblk); }
    { const Params p = kp_load(kp_get()); ph_quant(p, bid, nblk); }
    { const Params p = kp_load(kp_get()); char* ws = p.ws; (void)ws; unsigned* ctrl = (unsigned*)(p.ws + OFF_CTRL); (void)ctrl; ph_rmsq<false>(p.x, p.norm1_g, (unsigned char*)(ws + OFF_H1Q), (float*)(ws + OFF_H1S), bid, nblk); }
    { const Params p = kp_load(kp_get()); unsigned e1 = 101u; grid_bar(p.ws, smem, e1); }
    { const Params p = kp_load(kp_get()); ph_wquant(p, bid, nblk); }
    if (nblk == 0x7fffffff) grid.sync();
    { const Params p = kp_load(kp_get()); unsigned e0 = 100u; grid_bar(p.ws, smem, e0); }
#if PROBE
    { const Params p = kp_load(kp_get()); if (blockIdx.x == 0 && threadIdx.x == 0) ((unsigned long long*)(p.ws + OFF_CTRL + 64))[0] = wall_clock64(); }
#endif
    layer_body<0>(smem, bid, nblk, epoch);
    layer_body<1>(smem, bid, nblk, epoch);
    { const Params p = kp_load(kp_get()); char* ws = p.ws; (void)ws; unsigned* ctrl = (unsigned*)(p.ws + OFF_CTRL); (void)ctrl; ph_final(p, smem, bid, nblk, epoch);
#if PROBE
      { block_sync();
        const unsigned long long* T = (const unsigned long long*)(p.ws + OFF_CTRL + 64);
        if (bid == 0 && threadIdx.x == 0) { const float us = (float)(T[PROBE_A] - T[PROBE_A0]) * 0.01f / PROBE_DIV; p.out[0] += us * (1.f / 50.f); } }
#endif
    }
}

extern "C" void kernel_launch(void* const* d_in, const int* in_sizes, int n_in, void* d_out, int out_size, void* d_ws, size_t ws_size, hipStream_t stream) {
    (void)in_sizes; (void)n_in; (void)out_size;
    if (ws_size < WS_NEED) { fprintf(stderr, "workspace too small: %zu < %zu\n", ws_size, (size_t)WS_NEED); return; }
    Params p{};
    p.x = (const float*)d_in[0]; p.norm1_g = (const float*)d_in[1]; p.w_in = (const float*)d_in[2]; p.fox_b_f = (const float*)d_in[3];
    p.lru_conv_w = (const float*)d_in[4]; p.lru_conv_b = (const float*)d_in[5]; p.lru_w_a = (const float*)d_in[6]; p.lru_b_a = (const float*)d_in[7];
    p.lru_w_x = (const float*)d_in[8]; p.lru_b_x = (const float*)d_in[9]; p.lru_lambda = (const float*)d_in[10];
    p.nsa_pe_k = (const float*)d_in[11]; p.nsa_pe_v = (const float*)d_in[12]; p.nsa_w1_k = (const float*)d_in[13]; p.nsa_w2_k = (const float*)d_in[14];
    p.nsa_w1_v = (const float*)d_in[15]; p.nsa_w2_v = (const float*)d_in[16];
    p.w_br_fox = (const float*)d_in[17]; p.w_br_lru = (const float*)d_in[18]; p.w_br_dil = (const float*)d_in[19]; p.w_br_nsa = (const float*)d_in[20];
    p.w_out = (const float*)d_in[21]; p.norm2_g = (const float*)d_in[22]; p.peer_w_q = (const float*)d_in[23]; p.peer_sub_keys = (const float*)d_in[24];
    p.peer_u = (const float*)d_in[25]; p.peer_v = (const float*)d_in[26]; p.final_g = (const float*)d_in[27];
    p.out = (float*)d_out; p.ws = (char*)d_ws;
    static int grid_blocks = 0;
    if (!grid_blocks) {
        int dev = 0, cus = 0, per_cu = 0;
        hipGetDevice(&dev);
        hipDeviceGetAttribute(&cus, hipDeviceAttributeMultiprocessorCount, dev);
        hipFuncSetAttribute((const void*)mega, hipFuncAttributeMaxDynamicSharedMemorySize, SMEM_BYTES);
        hipOccupancyMaxActiveBlocksPerMultiprocessor(&per_cu, mega, 256, SMEM_BYTES);
        if (per_cu > 2) per_cu = 2;
        if (per_cu < 1) per_cu = 1;
        grid_blocks = cus * per_cu;
    }
    hipMemsetAsync((char*)d_ws + OFF_CTRL, 0, 1024 + 16384 + 8192, stream);
    void* args[] = {&p};
    hipError_t e = hipLaunchCooperativeKernel((void*)mega, dim3(grid_blocks), dim3(256), args, SMEM_BYTES, stream);
    if (e != hipSuccess) fprintf(stderr, "cooperative launch failed: %s (grid %d)\n", hipGetErrorString(e), grid_blocks);
}
```

```cpp
#include <hip/hip_runtime.h>
#include <cstdio>
#include <cstdint>
#define PROBE 0
#define PROBE_A 2
#define PROBE_A0 1
#define PROBE_DIV 1.f
#define STAMP(p_, k_) do { if (blockIdx.x == 0 && threadIdx.x == 0) ((unsigned long long*)((p_).ws + OFF_CTRL + 64))[k_] = wall_clock64(); } while (0)
#include <hip/hip_cooperative_groups.h>
namespace cg = cooperative_groups;

typedef unsigned short u16;
typedef short s16x8 __attribute__((ext_vector_type(8)));
typedef short s16x4 __attribute__((ext_vector_type(4)));
typedef float f32x4 __attribute__((ext_vector_type(4)));
typedef float f32x2 __attribute__((ext_vector_type(2)));
typedef unsigned u32x4 __attribute__((ext_vector_type(4)));
typedef unsigned u32x2 __attribute__((ext_vector_type(2)));
typedef int i32x4 __attribute__((ext_vector_type(4)));
typedef __bf16 bf16x2_t __attribute__((ext_vector_type(2)));
#define LAS __attribute__((address_space(3)))
#define DEVI __device__ __forceinline__

constexpr int NB = 4, SEQ = 8192, DM = 1024, NTOK = NB * SEQ, NLAYER = 2;
constexpr int PW = 3072;
constexpr int C_FQ = 0, C_FK = 256, C_FV = 512, C_LX = 768, C_LG = 1024, C_DQ = 1280, C_DK = 1664, C_DV = 2048,
              C_NQ = 2432, C_NKC = 2688, C_NVC = 2752, C_NKS = 2816, C_NVS = 2880, C_NKW = 2944, C_NVW = 3008;
constexpr int WIN_ROWS = 7296;
constexpr int WIN_GATE0 = 3200;
constexpr int IN_WIDTH = 7184;
constexpr int OW = 896;
constexpr int O_FOX = 0, O_LRU = 256, O_DIL = 512, O_NSA = 640;
constexpr int NEXP = 16384;

constexpr size_t SZ_WIN = (size_t)NLAYER * WIN_ROWS * 1024 * 2;
constexpr size_t SZ_WQ = (size_t)NLAYER * 2048 * 1024 * 2;
constexpr size_t SZ_WOUT = (size_t)NLAYER * 1024 * 1024 * 2;
constexpr size_t SZ_WBR = (size_t)NLAYER * 1024 * OW * 2;
constexpr size_t SZ_W1 = (size_t)NLAYER * 2 * 256 * 2048 * 2;
constexpr size_t SZ_W2 = (size_t)NLAYER * 2 * 64 * 256 * 2;
constexpr size_t SZ_B1 = (size_t)NLAYER * 2 * 256 * 4;
constexpr size_t SZ_SUBK = (size_t)NLAYER * 2 * 128 * 128 * 2;
constexpr size_t SZ_ROPE = (size_t)SEQ * 32 * 8;
constexpr size_t SZ_PUV = (size_t)2 * NEXP * 1024 * 2;
constexpr size_t SZ_H = (size_t)NTOK * 1024 * 2;
constexpr size_t SZ_P = (size_t)NTOK * PW * 2;
constexpr size_t SZ_FS = (size_t)NTOK * 16 * 4;
constexpr size_t SZ_NQR = (size_t)NTOK * 256 * 2;
constexpr size_t SZ_CUM = (size_t)NTOK * 4 * 4;
constexpr size_t SZ_LSUM = (size_t)2 * 512 * 256 * 4;
constexpr size_t SZ_HID = (size_t)2 * 2048 * 256 * 2;
constexpr size_t SZ_KVC = (size_t)2 * NB * 512 * 64 * 2;
constexpr size_t SZ_O = (size_t)NTOK * OW * 2;
constexpr size_t SZ_OC = (size_t)NTOK * 256 * 2;
constexpr size_t SZ_SEL = (size_t)NTOK * 4 * 4;

constexpr size_t OFF_WIN = 0;
constexpr size_t OFF_WQ = OFF_WIN + SZ_WIN;
constexpr size_t OFF_WOUT = OFF_WQ + SZ_WQ;
constexpr size_t OFF_WBR = OFF_WOUT + SZ_WOUT;
constexpr size_t OFF_W1 = OFF_WBR + SZ_WBR;
constexpr size_t OFF_W2 = OFF_W1 + SZ_W1;
constexpr size_t OFF_B1 = OFF_W2 + SZ_W2;
constexpr size_t OFF_SUBK = OFF_B1 + SZ_B1;
constexpr size_t OFF_ROPE = OFF_SUBK + SZ_SUBK;
constexpr size_t OFF_PUV = OFF_ROPE + SZ_ROPE;
constexpr size_t OFF_H = OFF_PUV + SZ_PUV;
constexpr size_t OFF_P = OFF_H + SZ_H;
constexpr size_t OFF_FS = OFF_P + SZ_P;
constexpr size_t OFF_NQR = OFF_FS + SZ_FS;
constexpr size_t OFF_CUM = OFF_NQR + SZ_NQR;
constexpr size_t OFF_LSUM = OFF_CUM + SZ_CUM;
constexpr size_t OFF_HID = OFF_LSUM + SZ_LSUM;
constexpr size_t OFF_KVC = OFF_HID + SZ_HID;
constexpr size_t OFF_O = OFF_KVC + SZ_KVC;
constexpr size_t OFF_OC = OFF_O + SZ_O;
constexpr size_t OFF_SEL = OFF_OC + SZ_OC;
constexpr size_t OFF_CTRL = OFF_SEL + SZ_SEL;
constexpr size_t OFF_XBAR = OFF_CTRL + 1024;
constexpr size_t OFF_FLAGS = OFF_XBAR + 16384;
constexpr size_t OFF_LRUF = OFF_FLAGS + 8192;
constexpr size_t OFF_PSC = OFF_LRUF + (size_t)NLAYER * 2 * 4 * 4 * 2 * 64 * 16;
constexpr size_t OFF_WI8 = OFF_PSC + (size_t)NLAYER * 2 * NEXP * 4;
constexpr size_t OFF_SWI = OFF_WI8 + (size_t)NLAYER * WIN_ROWS * 1024;
constexpr size_t OFF_WQ8 = OFF_SWI + (size_t)NLAYER * WIN_ROWS * 4;
constexpr size_t OFF_SWQ = OFF_WQ8 + (size_t)NLAYER * 2048 * 1024;
constexpr size_t WS_NEED = OFF_SWQ + (size_t)NLAYER * 2048 * 4;
static_assert(WS_NEED <= (size_t)512 * 1024 * 1024, "workspace over 512 MiB");
constexpr size_t OFF_MERGED = OFF_P;
constexpr size_t OFF_QP = OFF_P + (size_t)NTOK * 1024 * 2;
static_assert(OFF_QP + (size_t)NTOK * 2048 * 2 <= OFF_P + SZ_P, "alias");
constexpr size_t OFF_PIDX = OFF_H;
constexpr size_t OFF_PGW = OFF_H + (size_t)NTOK * 128 * 4;
static_assert(OFF_PGW + (size_t)NTOK * 128 * 4 <= OFF_H + SZ_H, "alias");
constexpr size_t OFF_H1Q = OFF_H;
constexpr size_t OFF_H1S = OFF_H + (size_t)NTOK * 1024;
constexpr size_t OFF_PW = OFF_PGW + (size_t)NTOK * 128 * 4;
constexpr size_t OFF_PWS = OFF_PW + (size_t)NTOK * 128;
static_assert(OFF_PW + (size_t)NTOK * 128 * 4 <= OFF_H + SZ_H, "alias");
constexpr size_t OFF_PART = OFF_QP;
constexpr size_t OFF_HQ = OFF_O;
constexpr size_t OFF_HS = OFF_O + (size_t)NTOK * 1024;
static_assert(OFF_HS + (size_t)NTOK * 4 <= OFF_O + SZ_O, "alias");

struct Params {
    const float* x; const float* norm1_g; const float* w_in; const float* fox_b_f;
    const float* lru_conv_w; const float* lru_conv_b; const float* lru_w_a; const float* lru_b_a;
    const float* lru_w_x; const float* lru_b_x; const float* lru_lambda;
    const float* nsa_pe_k; const float* nsa_pe_v; const float* nsa_w1_k; const float* nsa_w2_k;
    const float* nsa_w1_v; const float* nsa_w2_v;
    const float* w_br_fox; const float* w_br_lru; const float* w_br_dil; const float* w_br_nsa;
    const float* w_out; const float* norm2_g; const float* peer_w_q; const float* peer_sub_keys;
    const float* peer_u; const float* peer_v; const float* final_g;
    float* out; char* ws;
};

typedef const __attribute__((address_space(4))) Params* KP;
DEVI KP kp_get() { unsigned long long a = (unsigned long long)__builtin_amdgcn_kernarg_segment_ptr(); asm volatile("" : "+s"(a)); return (KP)a; }
DEVI Params kp_load(KP k) { Params r;
    r.x = k->x;
    r.norm1_g = k->norm1_g;
    r.w_in = k->w_in;
    r.fox_b_f = k->fox_b_f;
    r.lru_conv_w = k->lru_conv_w;
    r.lru_conv_b = k->lru_conv_b;
    r.lru_w_a = k->lru_w_a;
    r.lru_b_a = k->lru_b_a;
    r.lru_w_x = k->lru_w_x;
    r.lru_b_x = k->lru_b_x;
    r.lru_lambda = k->lru_lambda;
    r.nsa_pe_k = k->nsa_pe_k;
    r.nsa_pe_v = k->nsa_pe_v;
    r.nsa_w1_k = k->nsa_w1_k;
    r.nsa_w2_k = k->nsa_w2_k;
    r.nsa_w1_v = k->nsa_w1_v;
    r.nsa_w2_v = k->nsa_w2_v;
    r.w_br_fox = k->w_br_fox;
    r.w_br_lru = k->w_br_lru;
    r.w_br_dil = k->w_br_dil;
    r.w_br_nsa = k->w_br_nsa;
    r.w_out = k->w_out;
    r.norm2_g = k->norm2_g;
    r.peer_w_q = k->peer_w_q;
    r.peer_sub_keys = k->peer_sub_keys;
    r.peer_u = k->peer_u;
    r.peer_v = k->peer_v;
    r.final_g = k->final_g;
    r.out = k->out;
    r.ws = k->ws;
    return r; }
#define XR_OF(p) ((u16*)((char*)(p).out + (size_t)NTOK * DM * 2))
DEVI void block_sync() { asm volatile("s_waitcnt lgkmcnt(0)" ::: "memory"); __syncthreads(); }
DEVI int tid_opaque() { int t = threadIdx.x; asm volatile("" : "+v"(t)); return t; }
DEVI unsigned pk2(float a, float b) { f32x2 v = {a, b}; bf16x2_t r = __builtin_convertvector(v, bf16x2_t); return __builtin_bit_cast(unsigned, r); }
DEVI u16 f2bf(float a) { return (u16)(pk2(a, 0.f) & 0xffffu); }
DEVI float bf2f(u16 h) { return __uint_as_float(((unsigned)h) << 16); }
DEVI float bflo(unsigned w) { return __uint_as_float(w << 16); }
DEVI float bfhi(unsigned w) { return __uint_as_float(w & 0xffff0000u); }
DEVI void store_row4(u16* p64, const u32x2 (&v)[4], int g) {
#pragma unroll
    for (int k = 0; k < 4; k += 2) {
        const auto r0 = __builtin_amdgcn_permlane16_swap(v[k][0], v[k + 1][0], false, false);
        const auto r1 = __builtin_amdgcn_permlane16_swap(v[k][1], v[k + 1][1], false, false);
        const int col = (g & 1) ? 16 * (k + 1) + 4 * (g - 1) : 16 * k + 4 * g;
        *(u32x4*)(p64 + col) = (u32x4){r0[0], r1[0], r0[1], r1[1]};
    }
}
DEVI float sigmoidf_(float x) { return __builtin_amdgcn_rcpf(1.f + __expf(-x)); }
DEVI float gelu_tanh(float x) { float u = 0.7978845608028654f * (x + 0.044715f * x * x * x); return x * __builtin_amdgcn_rcpf(1.f + __expf(-2.f * u)); }
DEVI f32x4 mfma16(s16x8 a, s16x8 b, f32x4 c) { return __builtin_amdgcn_mfma_f32_16x16x32_bf16(a, b, c, 0, 0, 0); }
DEVI float wave_sum(float v) {
#pragma unroll
    for (int o = 32; o > 0; o >>= 1) v += __shfl_xor(v, o);
    return v;
}
DEVI unsigned wave_max_u32(unsigned v) {
#pragma unroll
    for (int o = 32; o > 0; o >>= 1) { unsigned t = (unsigned)__shfl_xor((int)v, o); v = v > t ? v : t; }
    return v;
}

DEVI void glds16(const void* src, char* lds_wave_base) {
    __builtin_amdgcn_global_load_lds((const __attribute__((address_space(1))) void*)src, (__attribute__((address_space(3))) void*)lds_wave_base, 16, 0, 0);
}
template <int BM, int BN>
DEVI void gemm_mainloop(const u16* __restrict__ A, size_t lda, size_t a_kstride, const u16* __restrict__ Bt, size_t ldb, int K,
                        int m0, int n0, char* smem, f32x4 (&acc)[BM / 32][BN / 32]) {
    constexpr int MT = BM / 32, NT = BN / 32, AG = BM / 32, BG = BN / 32;
    constexpr int A_BYTES = BM * 128, STAGE = (BM + BN) * 128;
    const int tid = tid_opaque(), lane = tid & 63, w = __builtin_amdgcn_readfirstlane(tid >> 6), wm = w >> 1, wn = w & 1, g = lane >> 4, c = lane & 15;
    const int r8 = lane >> 3, cp = lane & 7;
    const u16* asrc[AG]; const u16* bsrc[BG];
#pragma unroll
    for (int i = 0; i < AG; ++i) asrc[i] = A + (size_t)(m0 + 8 * (w * AG + i) + r8) * lda + ((cp ^ r8) * 8);
#pragma unroll
    for (int i = 0; i < BG; ++i) bsrc[i] = Bt + (size_t)(n0 + 8 * (w * BG + i) + r8) * ldb + ((cp ^ r8) * 8);
    const int nk = K / 64;
#pragma unroll
    for (int i = 0; i < AG; ++i) glds16(asrc[i], smem + (w * AG + i) * 1024);
#pragma unroll
    for (int i = 0; i < BG; ++i) glds16(bsrc[i], smem + A_BYTES + (w * BG + i) * 1024);
    for (int kt = 0; kt < nk; ++kt) {
        asm volatile("s_waitcnt vmcnt(0)" ::: "memory");
        block_sync();
        if (kt + 1 < nk) {
            char* dA = smem + ((kt + 1) & 1) * STAGE; char* dB = dA + A_BYTES;
#pragma unroll
            for (int i = 0; i < AG; ++i) glds16(asrc[i] + (size_t)(kt + 1) * a_kstride, dA + (w * AG + i) * 1024);
#pragma unroll
            for (int i = 0; i < BG; ++i) glds16(bsrc[i] + (size_t)(kt + 1) * 64, dB + (w * BG + i) * 1024);
        }
        const char* sA = smem + (kt & 1) * STAGE; const char* sB = sA + A_BYTES;
#pragma unroll
        for (int ks = 0; ks < 2; ++ks) {
            s16x8 af[MT], bfr[NT];
#pragma unroll
            for (int mt = 0; mt < MT; ++mt) { int row = wm * (BM / 2) + 16 * mt + c; af[mt] = *(const s16x8*)(sA + row * 128 + (((4 * ks + g) ^ (row & 7)) << 4)); }
#pragma unroll
            for (int nt = 0; nt < NT; ++nt) { int row = wn * (BN / 2) + 16 * nt + c; bfr[nt] = *(const s16x8*)(sB + row * 128 + (((4 * ks + g) ^ (row & 7)) << 4)); }
#pragma unroll
            for (int mt = 0; mt < MT; ++mt)
#pragma unroll
                for (int nt = 0; nt < NT; ++nt) acc[mt][nt] = mfma16(bfr[nt], af[mt], acc[mt][nt]);
        }
    }
    block_sync();
}
template <int MT, int NT> DEVI void acc_zero(f32x4 (&acc)[MT][NT]) {
#pragma unroll
    for (int i = 0; i < MT; ++i)
#pragma unroll
        for (int j = 0; j < NT; ++j) acc[i][j] = (f32x4){0.f, 0.f, 0.f, 0.f};
}
struct GJob { const char* A; size_t lda, aks; const char* Bt; size_t ldb; int nk, m0, n0; bool i8; };
template <int BM, int BN, bool FRAGALL, class JobFn, class EpiFn>
DEVI void gemm_stream(char* smem, int j0, int jstep, int jend, JobFn&& jobfn, EpiFn&& epi) {
    constexpr int MT = BM / 32, NT = BN / 32, AG = BM / 32, BG = BN / 32;
    constexpr int A_BYTES = BM * 128, STAGE = (BM + BN) * 128;
    if (j0 >= jend) return;
    const int tid = tid_opaque(), lane = tid & 63, w = __builtin_amdgcn_readfirstlane(tid >> 6), wm = w >> 1, wn = w & 1, g = lane >> 4, c = lane & 15;
    const int r8 = lane >> 3, cp = lane & 7;
    GJob cur = jobfn(j0);
    const char* a0 = cur.A + (size_t)(cur.m0 + 8 * (w * AG) + r8) * cur.lda + ((cp ^ r8) * 16);
    const char* b0 = cur.Bt + (size_t)(cur.n0 + 8 * (w * BG) + r8) * cur.ldb + ((cp ^ r8) * 16);
    block_sync();
#pragma unroll
    for (int i = 0; i < AG; ++i) glds16(a0 + (size_t)i * 8 * cur.lda, smem + (w * AG + i) * 1024);
#pragma unroll
    for (int i = 0; i < BG; ++i) glds16(b0 + (size_t)i * 8 * cur.ldb, smem + A_BYTES + (w * BG + i) * 1024);
    int st = 0;
    for (int j = j0; j < jend; j += jstep) {
        f32x4 acc[MT][NT]; acc_zero(acc);
        const int nk = cur.nk; const bool i8 = cur.i8;
        const bool hasnext = j + jstep < jend;
        for (int kt = 0; kt < nk; ++kt) {
            asm volatile("s_waitcnt vmcnt(0)" ::: "memory");
            block_sync();
            char* dA = smem + (st ^ 1) * STAGE; char* dB = dA + A_BYTES;
            if (kt + 1 < nk) {
#pragma unroll
                for (int i = 0; i < AG; ++i) glds16(a0 + (size_t)i * 8 * cur.lda + (size_t)(kt + 1) * cur.aks, dA + (w * AG + i) * 1024);
#pragma unroll
                for (int i = 0; i < BG; ++i) glds16(b0 + (size_t)i * 8 * cur.ldb + (size_t)(kt + 1) * 128, dB + (w * BG + i) * 1024);
            } else if (hasnext) {
                cur = jobfn(j + jstep);
                a0 = cur.A + (size_t)(cur.m0 + 8 * (w * AG) + r8) * cur.lda + ((cp ^ r8) * 16);
                b0 = cur.Bt + (size_t)(cur.n0 + 8 * (w * BG) + r8) * cur.ldb + ((cp ^ r8) * 16);
#pragma unroll
                for (int i = 0; i < AG; ++i) glds16(a0 + (size_t)i * 8 * cur.lda, dA + (w * AG + i) * 1024);
#pragma unroll
                for (int i = 0; i < BG; ++i) glds16(b0 + (size_t)i * 8 * cur.ldb, dB + (w * BG + i) * 1024);
            }
            const char* sA = smem + st * STAGE; const char* sB = sA + A_BYTES;
            if (FRAGALL) {
                s16x8 af[2][MT], bfr[2][NT];
#pragma unroll
                for (int ks = 0; ks < 2; ++ks) {
#pragma unroll
                    for (int mt = 0; mt < MT; ++mt) { int row = wm * (BM / 2) + 16 * mt + c; af[ks][mt] = *(const s16x8*)(sA + row * 128 + (((4 * ks + g) ^ (row & 7)) << 4)); }
#pragma unroll
                    for (int nt = 0; nt < NT; ++nt) { int row = wn * (BN / 2) + 16 * nt + c; bfr[ks][nt] = *(const s16x8*)(sB + row * 128 + (((4 * ks + g) ^ (row & 7)) << 4)); }
                }
                __builtin_amdgcn_sched_barrier(0);
                __builtin_amdgcn_s_setprio(1);
                if (i8) {
#pragma unroll
                    for (int ks = 0; ks < 2; ++ks)
#pragma unroll
                        for (int mt = 0; mt < MT; ++mt)
#pragma unroll
                            for (int nt = 0; nt < NT; ++nt)
                                acc[mt][nt] = __builtin_bit_cast(f32x4, __builtin_amdgcn_mfma_i32_16x16x64_i8(__builtin_bit_cast(i32x4, bfr[ks][nt]), __builtin_bit_cast(i32x4, af[ks][mt]), __builtin_bit_cast(i32x4, acc[mt][nt]), 0, 0, 0));
                } else {
#pragma unroll
                    for (int ks = 0; ks < 2; ++ks)
#pragma unroll
                        for (int mt = 0; mt < MT; ++mt)
#pragma unroll
                            for (int nt = 0; nt < NT; ++nt) acc[mt][nt] = mfma16(bfr[ks][nt], af[ks][mt], acc[mt][nt]);
                }
                __builtin_amdgcn_s_setprio(0);
            } else {
#pragma unroll
                for (int ks = 0; ks < 2; ++ks) {
                    s16x8 af[MT], bfr[NT];
#pragma unroll
                    for (int mt = 0; mt < MT; ++mt) { int row = wm * (BM / 2) + 16 * mt + c; af[mt] = *(const s16x8*)(sA + row * 128 + (((4 * ks + g) ^ (row & 7)) << 4)); }
#pragma unroll
                    for (int nt = 0; nt < NT; ++nt) { int row = wn * (BN / 2) + 16 * nt + c; bfr[nt] = *(const s16x8*)(sB + row * 128 + (((4 * ks + g) ^ (row & 7)) << 4)); }
                    if (i8) {
#pragma unroll
                        for (int mt = 0; mt < MT; ++mt)
#pragma unroll
                            for (int nt = 0; nt < NT; ++nt)
                                acc[mt][nt] = __builtin_bit_cast(f32x4, __builtin_amdgcn_mfma_i32_16x16x64_i8(__builtin_bit_cast(i32x4, bfr[nt]), __builtin_bit_cast(i32x4, af[mt]), __builtin_bit_cast(i32x4, acc[mt][nt]), 0, 0, 0));
                    } else {
#pragma unroll
                        for (int mt = 0; mt < MT; ++mt)
#pragma unroll
                            for (int nt = 0; nt < NT; ++nt) acc[mt][nt] = mfma16(bfr[nt], af[mt], acc[mt][nt]);
                    }
                }
            }
            st ^= 1;
        }
        epi(j, acc);
    }
    asm volatile("s_waitcnt vmcnt(0)" ::: "memory");
    block_sync();
}
constexpr int SMEM_BYTES = 69632 + 16;

#define XB_TMO      128
#define XB_XCNT(j)  (256  + 64 * (j))
#define XB_XSUB(j)  (1280 + 64 * (j))
#define XB_XGEN(j)  (2304 + 64 * (j))
#define XB_TOP      3328
#define XB_TOPGEN   3392
#define XCD_BAR_WORDS 3456
#define XB_SPIN_CAP (1u << 22)
DEVI unsigned xb_ld(unsigned* p) { return __hip_atomic_load(p, __ATOMIC_RELAXED, __HIP_MEMORY_SCOPE_AGENT); }
DEVI unsigned xb_add(unsigned* p, unsigned v) { return __hip_atomic_fetch_add(p, v, __ATOMIC_RELAXED, __HIP_MEMORY_SCOPE_AGENT); }
DEVI unsigned xb_xcc_id() { return (unsigned)__builtin_amdgcn_s_getreg((3 << 11) | 20) & 0xFu; }
#define XB_SPIN(cond, bar) do { unsigned _sp = 0; while (cond) { __builtin_amdgcn_s_sleep(1); \
    if ((++_sp & 255u) == 0u) { if (xb_ld(&(bar)[XB_TMO])) break; if (_sp > XB_SPIN_CAP) { atomicAdd(&(bar)[XB_TMO], 1u); break; } } } } while (0)
DEVI void xcd_barrier_complete(unsigned* bar, unsigned x, unsigned& nloc, unsigned& nx) {
    const unsigned G = gridDim.x;
    unsigned sum, cnt, mine, sp = 0u;
    for (;;) {
        sum = 0u; cnt = 0u; mine = 0u;
#pragma unroll
        for (unsigned j = 0; j < 16; ++j) { const unsigned c = xb_ld(&bar[XB_XCNT(j)]); sum += c; cnt += (c > 0u) ? 1u : 0u; mine = (j == x) ? c : mine; }
        if (sum == G) break;
        __builtin_amdgcn_s_sleep(1);
        if ((++sp & 255u) == 0u) { if (xb_ld(&bar[XB_TMO])) break; if (sp > XB_SPIN_CAP) { atomicAdd(&bar[XB_TMO], 1u); break; } }
    }
    nloc = mine > 0u ? mine : 1u; nx = cnt > 0u ? cnt : 1u;
    unsigned low = 0u;
#pragma unroll
    for (unsigned j = 0; j < 8; ++j) low += xb_ld(&bar[XB_XCNT(j)]);
    if (nx == 8u && low == G) nx |= 0x100u;
}
DEVI void grid_bar(char* ws, char* smem, unsigned& epoch) {
    unsigned* bar = (unsigned*)(ws + OFF_XBAR);
    volatile LAS unsigned* st = (volatile LAS unsigned*)(smem + SMEM_BYTES - 16);
    asm volatile("s_waitcnt vmcnt(0) lgkmcnt(0)" ::: "memory");
    __syncthreads();
    epoch += 1;
    if (threadIdx.x == 0) {
        const unsigned x = xb_xcc_id();
        unsigned nloc = st[0], nx = st[1];
        if (nloc == 0u) { xcd_barrier_complete(bar, x, nloc, nx); st[0] = nloc; st[1] = nx; }
        nx &= 0xffu;
        const unsigned old = xb_add(&bar[XB_XSUB(x)], 1u);
        const unsigned gen = old / nloc;
        if (old + 1u == (gen + 1u) * nloc) {
            __builtin_amdgcn_fence(__ATOMIC_RELEASE, "agent");
            asm volatile("s_waitcnt vmcnt(0)" ::: "memory");
            const unsigned og = xb_add(&bar[XB_TOP], 1u);
            const unsigned tg = og / nx;
            if (og + 1u == (tg + 1u) * nx) xb_add(&bar[XB_TOPGEN], 1u);
            else XB_SPIN(xb_ld(&bar[XB_TOPGEN]) == tg, bar);
            __builtin_amdgcn_fence(__ATOMIC_ACQUIRE, "agent");
            xb_add(&bar[XB_XGEN(x)], 1u);
            asm volatile("s_waitcnt vmcnt(0)" ::: "memory");
        } else {
            XB_SPIN(xb_ld(&bar[XB_XGEN(x)]) == gen, bar);
            __builtin_amdgcn_fence(__ATOMIC_ACQUIRE, "agent");
            asm volatile("s_waitcnt vmcnt(0)" ::: "memory");
        }
#if PROBE
        if (blockIdx.x == 0) ((unsigned long long*)(ws + OFF_CTRL + 64))[epoch] = wall_clock64();
#endif
    }
    __syncthreads();
}

struct XccInfo { int s0, sstep, t0, tstep; };
DEVI XccInfo xcc_info(char* smem, int bid, int nblk) {
    volatile LAS unsigned* st = (volatile LAS unsigned*)(smem + SMEM_BYTES - 16);
    const unsigned nloc = st[0], nxf = st[1], rank = st[2];
    XccInfo r;
    if (nxf & 0x100u) { r.s0 = (int)xb_xcc_id(); r.sstep = 8; r.t0 = (int)rank; r.tstep = (int)nloc; }
    else { r.s0 = 0; r.sstep = 1; r.t0 = bid; r.tstep = nblk; }
    return r;
}
struct TileMap { int j0, jstep, jend, ntn, x; bool loc; };
DEVI TileMap tile_map(char* smem, int bid, int nblk, int ntm, int ntn) {
    const XccInfo xi = xcc_info(smem, bid, nblk);
    TileMap t; t.ntn = ntn;
    if (xi.sstep == 8) { t.loc = true; t.x = xi.s0; t.j0 = xi.t0; t.jstep = xi.tstep; t.jend = (ntm / 8) * ntn; }
    else { t.loc = false; t.x = 0; t.j0 = bid; t.jstep = nblk; t.jend = ntm * ntn; }
    return t;
}
DEVI void tile_decode(const TileMap& t, int j, int& mt, int& nt) { const int q = j / t.ntn; nt = j - q * t.ntn; mt = t.loc ? q * 8 + t.x : q; }
DEVI int win_map(int n) {
    if (n < 768) return n;
    if (n < 3072) return n + 4;
    if (n < 3076) return 768 + (n - 3072);
    if (n < 3088) return n;
    if (n < WIN_GATE0) return -1;
    return n - (WIN_GATE0 - 3088);
}
DEVI void tconv_tile(const float* __restrict__ src, int src_ld, int K, u16* __restrict__ dst, int dst_ld, int ndst, int mode, int tidx, char* smem) {
    float (*tile)[65] = (float (*)[65])smem;
    const int tiles_n = ndst / 64;
    const int kt = tidx / tiles_n, nt = tidx % tiles_n;
    const int tx = threadIdx.x & 63, ty = threadIdx.x >> 6;
    const int n = nt * 64 + tx;
    const int sc = mode == 1 ? win_map(n) : n;
    block_sync();
#pragma unroll
    for (int i = 0; i < 16; ++i) { int k = kt * 64 + ty * 16 + i; tile[ty * 16 + i][tx] = sc >= 0 ? src[(size_t)k * src_ld + sc] : 0.f; }
    block_sync();
#pragma unroll
    for (int i = 0; i < 16; ++i) { int nn = ty * 16 + i; dst[(size_t)(nt * 64 + nn) * dst_ld + kt * 64 + tx] = f2bf(tile[tx][nn]); }
}
constexpr int TC_WIN = 16 * (WIN_ROWS / 64), TC_WQ = 16 * 32, TC_WOUT = 16 * 16, TC_BR4 = 4 * 16, TC_BR2 = 2 * 16, TC_W1 = 32 * 4, TC_W2 = 4;
constexpr int TC_LAYER = TC_WIN + TC_WQ + TC_WOUT + 3 * TC_BR4 + TC_BR2 + 2 * TC_W1 + 2 * TC_W2;
DEVI void ph_tconv(const Params& p, char* smem, int bid, int nblk) {
    char* ws = p.ws;
    for (int it = bid; it < NLAYER * TC_LAYER; it += nblk) {
        const int l = it / TC_LAYER; int r = it % TC_LAYER;
        u16* wbr = (u16*)(ws + OFF_WBR) + (size_t)l * 1024 * OW;
        if (r < TC_WIN) { tconv_tile(p.w_in + (size_t)l * 1024 * IN_WIDTH, IN_WIDTH, 1024, (u16*)(ws + OFF_WIN) + (size_t)l * WIN_ROWS * 1024, 1024, WIN_ROWS, 1, r, smem); continue; }
        r -= TC_WIN;
        if (r < TC_WQ) { tconv_tile(p.peer_w_q + (size_t)l * 1024 * 2048, 2048, 1024, (u16*)(ws + OFF_WQ) + (size_t)l * 2048 * 1024, 1024, 2048, 0, r, smem); continue; }
        r -= TC_WQ;
        if (r < TC_WOUT) { tconv_tile(p.w_out + (size_t)l * 1024 * 1024, 1024, 1024, (u16*)(ws + OFF_WOUT) + (size_t)l * 1024 * 1024, 1024, 1024, 0, r, smem); continue; }
        r -= TC_WOUT;
        if (r < TC_BR4) { tconv_tile(p.w_br_fox + (size_t)l * 256 * 1024, 1024, 256, wbr + O_FOX, OW, 1024, 0, r, smem); continue; }
        r -= TC_BR4;
        if (r < TC_BR4) { tconv_tile(p.w_br_lru + (size_t)l * 256 * 1024, 1024, 256, wbr + O_LRU, OW, 1024, 0, r, smem); continue; }
        r -= TC_BR4;
        if (r < TC_BR2) { tconv_tile(p.w_br_dil + (size_t)l * 128 * 1024, 1024, 128, wbr + O_DIL, OW, 1024, 0, r, smem); continue; }
        r -= TC_BR2;
        if (r < TC_BR4) { tconv_tile(p.w_br_nsa + (size_t)l * 256 * 1024, 1024, 256, wbr + O_NSA, OW, 1024, 0, r, smem); continue; }
        r -= TC_BR4;
        if (r < 2 * TC_W1) { const int z = r / TC_W1; const float* w1 = (z ? p.nsa_w1_v : p.nsa_w1_k) + (size_t)l * 2048 * 256;
            tconv_tile(w1, 256, 2048, (u16*)(ws + OFF_W1) + (size_t)(l * 2 + z) * 256 * 2048, 2048, 256, 0, r % TC_W1, smem); continue; }
        r -= 2 * TC_W1;
        { const int z = r / TC_W2; const float* w2 = (z ? p.nsa_w2_v : p.nsa_w2_k) + (size_t)l * 256 * 64;
            tconv_tile(w2, 64, 256, (u16*)(ws + OFF_W2) + (size_t)(l * 2 + z) * 64 * 256, 256, 64, 0, r % TC_W2, smem); }
    }
}
DEVI void ph_cvt(const float* __restrict__ src, u16* __restrict__ dst, size_t n4, int bid, int nblk) {
    for (size_t i = (size_t)bid * 256 + threadIdx.x; i < n4; i += (size_t)nblk * 256) {
        f32x4 v = *(const f32x4*)(src + i * 4);
        u32x2 o = {pk2(v[0], v[1]), pk2(v[2], v[3])};
        *(u32x2*)(dst + i * 4) = o;
    }
}
DEVI void ph_bias1(const Params& p, char* smem, int bid, int nblk) {
    float* red = (float*)smem;
    const int lane = threadIdx.x & 63, w = threadIdx.x >> 6;
    for (int it = bid; it < NLAYER * 2 * 4; it += nblk) {
        const int ng = it & 3, z = (it >> 2) & 1, l = it >> 3, n = ng * 64 + lane;
        const float* pe = (z ? p.nsa_pe_v : p.nsa_pe_k) + (size_t)l * 2048 + w * 512;
        const float* w1 = (z ? p.nsa_w1_v : p.nsa_w1_k) + (size_t)l * 2048 * 256 + (size_t)w * 512 * 256 + n;
        float a = 0.f;
        for (int k = 0; k < 512; k += 16) {
            float wv[16];
#pragma unroll
            for (int j = 0; j < 16; ++j) wv[j] = w1[(size_t)(k + j) * 256];
#pragma unroll
            for (int j = 0; j < 16; ++j) a += pe[k + j] * wv[j];
        }
        block_sync();
        red[w * 64 + lane] = a;
        block_sync();
        if (w == 0) ((float*)(p.ws + OFF_B1))[(l * 2 + z) * 256 + n] = (red[lane] + red[64 + lane]) + (red[128 + lane] + red[192 + lane]);
    }
}
DEVI void ph_lrufrag(const Params& p, int bid, int nblk) {
    for (int i = bid * 256 + threadIdx.x; i < NLAYER * 2 * 4 * 4 * 2 * 64; i += nblk * 256) {
        const int lane = i & 63, ks = (i >> 6) & 1, nt = (i >> 7) & 3, nb = (i >> 9) & 3, mat = (i >> 11) & 1, l = i >> 12;
        const int g = lane >> 4, c = lane & 15, k0 = 32 * ks + 8 * g, dd = 16 * nt + c;
        const float* W = (mat ? p.lru_w_x : p.lru_w_a) + (size_t)l * 4 * 64 * 64 + (size_t)nb * 64 * 64;
        u32x4 f = {pk2(W[(k0 + 0) * 64 + dd], W[(k0 + 1) * 64 + dd]), pk2(W[(k0 + 2) * 64 + dd], W[(k0 + 3) * 64 + dd]), pk2(W[(k0 + 4) * 64 + dd], W[(k0 + 5) * 64 + dd]), pk2(W[(k0 + 6) * 64 + dd], W[(k0 + 7) * 64 + dd])};
        *(u32x4*)(p.ws + OFF_LRUF + (size_t)i * 16) = f;
    }
}
DEVI void ph_misc(const Params& p, int bid, int nblk) {
    for (int gid = bid * 256 + threadIdx.x; gid < SEQ * 32; gid += nblk * 256) {
        const int s = gid >> 5, i = gid & 31;
        const float freq = powf(10000.0f, -(float)i / 32.0f);
        const float ang = (float)s * freq;
        const double rev = (double)ang * 0.15915494309189535;
        const float fr = (float)(rev - floor(rev));
        f32x2 cs = {__builtin_amdgcn_cosf(fr), __builtin_amdgcn_sinf(fr)};
        *(f32x2*)(p.ws + OFF_ROPE + (size_t)gid * 8) = cs;
    }
}


DEVI void ph_quant(const Params& p, int bid, int nblk) {
    const int tq_ = tid_opaque(), lane = tq_ & 63, w = tq_ >> 6;
    unsigned char* Q = (unsigned char*)(p.ws + OFF_PUV); float* SC = (float*)(p.ws + OFF_PSC);
    for (int r = bid * 4 + w; r < NLAYER * 2 * NEXP; r += nblk * 4) {
        const int e = r & (NEXP - 1), kind = (r >> 14) & 1, l = r >> 15;
        const float* src = (kind ? p.peer_v : p.peer_u) + ((size_t)l * NEXP + e) * 1024 + 16 * lane;
        f32x4 v[4]; float am = 0.f;
#pragma unroll
        for (int i = 0; i < 4; ++i) { v[i] = *(const f32x4*)(src + 4 * i);
#pragma unroll
            for (int j = 0; j < 4; ++j) am = fmaxf(am, fabsf(v[i][j])); }
#pragma unroll
        for (int o = 32; o > 0; o >>= 1) am = fmaxf(am, __shfl_xor(am, o));
        const float inv = am > 0.f ? 127.f / am : 0.f;
        const int off = 0;
        u32x4 pk;
#pragma unroll
        for (int i = 0; i < 4; ++i) {
            unsigned wv = 0;
#pragma unroll
            for (int j = 0; j < 4; ++j) { const int q = (int)rintf(v[i][j] * inv) + off; wv |= ((unsigned)q & 0xffu) << (8 * j); }
            pk[i] = wv;
        }
        *(u32x4*)(Q + (((size_t)(l * 2 + kind) * 8 + (lane >> 3)) * NEXP + e) * 128 + 16 * (lane & 7)) = pk;
        if (lane == 0) SC[(size_t)(l * 2 + kind) * NEXP + e] = am * (1.f / 127.f);
    }
}
DEVI void ph_wquant(const Params& p, int bid, int nblk) {
    const int tq_ = tid_opaque(), lane = tq_ & 63, w = tq_ >> 6;
    constexpr int NR = NLAYER * WIN_ROWS + NLAYER * 2048;
    for (int r = bid * 4 + w; r < NR; r += nblk * 4) {
        const u16* src; char* dst; float* sc;
        if (r < NLAYER * WIN_ROWS) { src = (const u16*)(p.ws + OFF_WIN) + (size_t)r * 1024; dst = p.ws + OFF_WI8 + (size_t)r * 1024; sc = (float*)(p.ws + OFF_SWI) + r; }
        else { const int q = r - NLAYER * WIN_ROWS; src = (const u16*)(p.ws + OFF_WQ) + (size_t)q * 1024; dst = p.ws + OFF_WQ8 + (size_t)q * 1024; sc = (float*)(p.ws + OFF_SWQ) + q; }
        const u32x4 a = *(const u32x4*)(src + 16 * lane), b2 = *(const u32x4*)(src + 16 * lane + 8);
        float v[16];
#pragma unroll
        for (int i = 0; i < 4; ++i) { v[2 * i] = bflo(a[i]); v[2 * i + 1] = bfhi(a[i]); v[8 + 2 * i] = bflo(b2[i]); v[8 + 2 * i + 1] = bfhi(b2[i]); }
        float am = 0.f;
#pragma unroll
        for (int i = 0; i < 16; ++i) am = fmaxf(am, fabsf(v[i]));
#pragma unroll
        for (int o = 32; o > 0; o >>= 1) am = fmaxf(am, __shfl_xor(am, o));
        const float inv = am > 0.f ? 127.f / am : 0.f;
        u32x4 pk;
#pragma unroll
        for (int i = 0; i < 4; ++i) {
            unsigned wv = 0;
#pragma unroll
            for (int j = 0; j < 4; ++j) { const int q = (int)rintf(v[4 * i + j] * inv); wv |= ((unsigned)q & 0xffu) << (8 * j); }
            pk[i] = wv;
        }
        *(u32x4*)(dst + 16 * lane) = pk;
        if (lane == 0) *sc = am * (1.f / 127.f);
    }
}
template <bool BF>
DEVI void ph_rmsq(const void* __restrict__ x, const float* __restrict__ gam, unsigned char* __restrict__ Q, float* __restrict__ S, int bid, int nblk) {
    const int lane = tid_opaque() & 63, stride = nblk * 4;
    f32x4 gg[4];
#pragma unroll
    for (int i = 0; i < 4; ++i) gg[i] = *(const f32x4*)(gam + i * 256 + lane * 4);
    for (int row0 = bid * 4 + (tid_opaque() >> 6); row0 < NTOK; row0 += stride * 4) {
        f32x4 v[4][4]; float ss[4], am[4];
#pragma unroll
        for (int r = 0; r < 4; ++r) {
            const int row = row0 + r * stride < NTOK ? row0 + r * stride : row0;
#pragma unroll
            for (int i = 0; i < 4; ++i) {
                if (BF) { const u32x2 xb = *(const u32x2*)((const u16*)x + (size_t)row * DM + i * 256 + lane * 4); v[r][i] = (f32x4){bflo(xb[0]), bfhi(xb[0]), bflo(xb[1]), bfhi(xb[1])}; }
                else v[r][i] = *(const f32x4*)((const float*)x + (size_t)row * DM + i * 256 + lane * 4);
            }
        }
#pragma unroll
        for (int r = 0; r < 4; ++r) {
            ss[r] = 0.f;
#pragma unroll
            for (int i = 0; i < 4; ++i) ss[r] += v[r][i][0] * v[r][i][0] + v[r][i][1] * v[r][i][1] + v[r][i][2] * v[r][i][2] + v[r][i][3] * v[r][i][3];
        }
#pragma unroll
        for (int o = 32; o > 0; o >>= 1)
#pragma unroll
            for (int r = 0; r < 4; ++r) ss[r] += __shfl_xor(ss[r], o);
#pragma unroll
        for (int r = 0; r < 4; ++r) {
            const float rs = rsqrtf(ss[r] * (1.0f / DM) + 1e-6f);
            am[r] = 0.f;
#pragma unroll
            for (int i = 0; i < 4; ++i)
#pragma unroll
                for (int j = 0; j < 4; ++j) { v[r][i][j] = v[r][i][j] * rs * gg[i][j]; am[r] = fmaxf(am[r], fabsf(v[r][i][j])); }
        }
#pragma unroll
        for (int o = 32; o > 0; o >>= 1)
#pragma unroll
            for (int r = 0; r < 4; ++r) am[r] = fmaxf(am[r], __shfl_xor(am[r], o));
#pragma unroll
        for (int r = 0; r < 4; ++r) {
            const int row = row0 + r * stride;
            if (row < NTOK) {
                const float inv = am[r] > 0.f ? 127.f / am[r] : 0.f;
#pragma unroll
                for (int i = 0; i < 4; ++i) {
                    unsigned wv = 0;
#pragma unroll
                    for (int j = 0; j < 4; ++j) { const int q = (int)rintf(v[r][i][j] * inv); wv |= ((unsigned)q & 0xffu) << (8 * j); }
                    const int sl = 2 * i + (lane >> 5);
                    *(unsigned*)(Q + ((size_t)sl * NTOK + row) * 128 + (lane & 31) * 4) = wv;
                }
                if (lane == 0) S[row] = am[r] * (1.f / 127.f);
            }
        }
    }
}
template <bool FINAL>
DEVI void ph_rmsnorm(const float* __restrict__ x, const float* __restrict__ gam, u16* __restrict__ hout, float* __restrict__ fout, int bid, int nblk) {
    const int lane = threadIdx.x & 63;
    for (int row = bid * 4 + (tid_opaque() >> 6); row < NTOK; row += nblk * 4) {
        const float* xr = x + (size_t)row * DM;
        f32x4 v[4]; float ss = 0.f;
#pragma unroll
        for (int i = 0; i < 4; ++i) { v[i] = *(const f32x4*)(xr + i * 256 + lane * 4); ss += v[i][0] * v[i][0] + v[i][1] * v[i][1] + v[i][2] * v[i][2] + v[i][3] * v[i][3]; }
        ss = wave_sum(ss);
        const float rs = rsqrtf(ss * (1.0f / DM) + 1e-6f);
#pragma unroll
        for (int i = 0; i < 4; ++i) {
            f32x4 gg = *(const f32x4*)(gam + i * 256 + lane * 4);
            f32x4 y = {v[i][0] * rs * gg[0], v[i][1] * rs * gg[1], v[i][2] * rs * gg[2], v[i][3] * rs * gg[3]};
            if (FINAL) *(f32x4*)(fout + (size_t)row * DM + i * 256 + lane * 4) = y;
            else { u32x2 o = {pk2(y[0], y[1]), pk2(y[2], y[3])}; *(u32x2*)(hout + (size_t)row * DM + i * 256 + lane * 4) = o; }
        }
    }
}

DEVI void final_row(const u32x2 (&xb)[4], const float* __restrict__ gam, float* __restrict__ orow, int lane) {
    f32x4 v[4]; float ss = 0.f;
#pragma unroll
    for (int i = 0; i < 4; ++i) { v[i] = (f32x4){bflo(xb[i][0]), bfhi(xb[i][0]), bflo(xb[i][1]), bfhi(xb[i][1])}; ss += v[i][0] * v[i][0] + v[i][1] * v[i][1] + v[i][2] * v[i][2] + v[i][3] * v[i][3]; }
    ss = wave_sum(ss);
    const float rs = rsqrtf(ss * (1.0f / DM) + 1e-6f);
#pragma unroll
    for (int i = 0; i < 4; ++i) {
        const f32x4 gg = *(const f32x4*)(gam + i * 256 + lane * 4);
        *(f32x4*)(orow + i * 256 + lane * 4) = (f32x4){v[i][0] * rs * gg[0], v[i][1] * rs * gg[1], v[i][2] * rs * gg[2], v[i][3] * rs * gg[3]};
    }
}
DEVI void ph_final(const Params& p, char* smem, int bid, int nblk, unsigned& epoch) {
    const int lane = tid_opaque() & 63, wv = bid * 4 + (tid_opaque() >> 6), nwv = nblk * 4;
    const u16* XR = XR_OF(p);
    for (int row = wv; row < NTOK / 2; row += nwv) {
        u32x2 xb[4];
#pragma unroll
        for (int i = 0; i < 4; ++i) xb[i] = *(const u32x2*)(XR + (size_t)row * DM + i * 256 + lane * 4);
        final_row(xb, p.final_g, p.out + (size_t)row * DM, lane);
    }
    for (int base = NTOK / 2; base < NTOK; base += nwv * 8) {
        u32x2 xb[8][4];
#pragma unroll
        for (int k = 0; k < 8; ++k) {
            const int row = base + k * nwv + wv;
#pragma unroll
            for (int i = 0; i < 4; ++i) xb[k][i] = row < NTOK ? *(const u32x2*)(XR + (size_t)row * DM + i * 256 + lane * 4) : (u32x2){0u, 0u};
        }
        grid_bar(p.ws, smem, epoch);
#pragma unroll
        for (int k = 0; k < 8; ++k) {
            const int row = base + k * nwv + wv;
            if (row < NTOK) final_row(xb[k], p.final_g, p.out + (size_t)row * DM, lane);
        }
    }
}

DEVI void ph_rms2(const Params& p, int layer, int bid, int nblk) {
    const int lane = tid_opaque() & 63;
    const float* gam = p.norm2_g + layer * 1024;
    u16* H = (u16*)(p.ws + OFF_H); unsigned char* HQ = (unsigned char*)(p.ws + OFF_HQ); float* HS = (float*)(p.ws + OFF_HS);
    for (int row = bid * 4 + (tid_opaque() >> 6); row < NTOK; row += nblk * 4) {
        const float* xr = p.out + (size_t)row * DM;
        f32x4 v[4]; float ss = 0.f;
#pragma unroll
        for (int i = 0; i < 4; ++i) { v[i] = *(const f32x4*)(xr + i * 256 + lane * 4); ss += v[i][0] * v[i][0] + v[i][1] * v[i][1] + v[i][2] * v[i][2] + v[i][3] * v[i][3]; }
        ss = wave_sum(ss);
        const float rs = rsqrtf(ss * (1.0f / DM) + 1e-6f);
        float am = 0.f;
#pragma unroll
        for (int i = 0; i < 4; ++i) {
            const f32x4 gg = *(const f32x4*)(gam + i * 256 + lane * 4);
#pragma unroll
            for (int j = 0; j < 4; ++j) { v[i][j] = v[i][j] * rs * gg[j]; am = fmaxf(am, fabsf(v[i][j])); }
            u32x2 o = {pk2(v[i][0], v[i][1]), pk2(v[i][2], v[i][3])};
            *(u32x2*)(H + (size_t)row * DM + i * 256 + lane * 4) = o;
        }
#pragma unroll
        for (int o = 32; o > 0; o >>= 1) am = fmaxf(am, __shfl_xor(am, o));
        const float inv = am > 0.f ? 127.f / am : 0.f;
#pragma unroll
        for (int i = 0; i < 4; ++i) {
            unsigned wv = 0;
#pragma unroll
            for (int j = 0; j < 4; ++j) { const int q = (int)rintf(v[i][j] * inv); wv |= ((unsigned)q & 0xffu) << (8 * j); }
            const int sl = 2 * i + (lane >> 5);
            *(unsigned*)(HQ + ((size_t)sl * NTOK + row) * 128 + (lane & 31) * 4) = wv;
        }
        if (lane == 0) HS[row] = am * (1.f / 127.f);
    }
}

DEVI void ph_proj(const Params& p, int layer, char* smem, int bid, int nblk) {
    const char* A8 = p.ws + OFF_H1Q; const float* AS = (const float*)(p.ws + OFF_H1S);
    const char* W8 = p.ws + OFF_WI8 + (size_t)layer * WIN_ROWS * 1024; const float* SW = (const float*)(p.ws + OFF_SWI) + (size_t)layer * WIN_ROWS;
    u16* P = (u16*)(p.ws + OFF_P); float* FS = (float*)(p.ws + OFF_FS);
    constexpr int ntn = 25;
    const int tid_ = tid_opaque(), lane = tid_ & 63, w = tid_ >> 6, wm = w >> 1, wn = w & 1, g = lane >> 4, c = lane & 15;
    const TileMap tmp = tile_map(smem, bid, nblk, NTOK / 128, ntn);
    if (tid_ < 8) ((LAS unsigned*)(smem + 65536))[tid_] = 0u;
    gemm_stream<128, 128, true>(smem, tmp.j0, tmp.jstep, tmp.jend,
        [&](int t) { int tm_, tn_; tile_decode(tmp, t, tm_, tn_); GJob jb; jb.A = A8; jb.lda = 128; jb.aks = (size_t)NTOK * 128; jb.Bt = W8; jb.ldb = 1024; jb.nk = 8; jb.m0 = tm_ * 128; jb.n0 = tn_ * 128; jb.i8 = true; return jb; },
        [&](int t, f32x4 (&acc)[4][4]) {
            int tm_, tn_; tile_decode(tmp, t, tm_, tn_);
            const int m0 = tm_ * 128, n0 = tn_ * 128, nb = n0 + wn * 64;
            const int hc = (nb >= C_DQ && nb < C_DV) || (nb >= C_NKS && nb < C_NVS) || (nb >= C_NKW && nb < C_NVW) ? 1 : ((nb >= C_NQ && nb < C_NKC) ? 2 : ((nb >= C_FK && nb < C_FV) ? 3 : 0));
            const int nclass = hc == 3 ? 0 : ((nb >= C_DK && nb < C_DV) ? 1 : ((nb >= C_NKS && nb < C_NVS) ? 2 : ((nb >= C_NKW && nb < C_NVW) ? 3 : ((nb >= C_DQ && nb < C_DK) ? 5 : (hc == 2 ? 6 : -1)))));
            float kmax2 = 0.f;
            float sa4[4]; f32x4 sw4[4];
#pragma unroll
            for (int i = 0; i < 4; ++i) { sa4[i] = AS[m0 + wm * 64 + 16 * i + c]; sw4[i] = *(const f32x4*)(SW + nb + 16 * i + 4 * g); }
            const bool rot = hc == 1 || hc == 2;
            f32x4 rc[4] = {{0.f, 0.f, 0.f, 0.f}, {0.f, 0.f, 0.f, 0.f}, {0.f, 0.f, 0.f, 0.f}, {0.f, 0.f, 0.f, 0.f}};
            auto rope_load = [&](int mt, f32x4 (&r)[4]) {
                const float* tb = (const float*)(p.ws + OFF_ROPE) + ((size_t)((m0 + wm * 64 + 16 * mt + c) & (SEQ - 1)) * 32) * 2;
                r[0] = *(const f32x4*)(tb + (4 * g) * 2); r[1] = *(const f32x4*)(tb + (4 * g) * 2 + 4);
                r[2] = *(const f32x4*)(tb + (16 + 4 * g) * 2); r[3] = *(const f32x4*)(tb + (16 + 4 * g) * 2 + 4);
            };
            if (rot) rope_load(0, rc);
#pragma unroll
            for (int mt = 0; mt < 4; ++mt) {
                const int m = m0 + wm * 64 + 16 * mt + c;
                const float sa = sa4[mt];
                f32x4 rn[4] = {rc[0], rc[1], rc[2], rc[3]};
                if (rot && mt < 3) rope_load(mt + 1, rn);
                f32x4 v[4];
#pragma unroll
                for (int nt = 0; nt < 4; ++nt) {
                    const f32x4 sw = sw4[nt];
                    const i32x4 ai = __builtin_bit_cast(i32x4, acc[mt][nt]);
                    v[nt] = (f32x4){(float)ai[0] * sa * sw[0], (float)ai[1] * sa * sw[1], (float)ai[2] * sa * sw[2], (float)ai[3] * sa * sw[3]};
                }
                if (nb >= PW) {
                    if (nb == PW && g == 0) *(f32x4*)(FS + (size_t)m * 16) = v[0];
                    if (nb == PW && g == 1) *(f32x4*)(FS + (size_t)m * 16 + 4) = v[0];
                    if (nb == PW && g == 2) *(f32x4*)(FS + (size_t)m * 16 + 8) = v[0];
                    if (nb == PW && g == 3) *(f32x4*)(FS + (size_t)m * 16 + 12) = v[0];
                    continue;
                }
                if (hc == 2) {
                    { u32x2 o4[4];
#pragma unroll
                      for (int nt = 0; nt < 4; ++nt) o4[nt] = (u32x2){pk2(v[nt][0], v[nt][1]), pk2(v[nt][2], v[nt][3])};
                      store_row4(P + (size_t)m * PW + nb, o4, g); }
                }
                if (rot) {
#pragma unroll
                    for (int nt = 0; nt < 2; ++nt) {
                        const f32x4 cs0 = rc[2 * nt], cs1 = rc[2 * nt + 1];
                        const f32x4 x1 = v[nt], x2 = v[nt + 2];
                        v[nt]     = (f32x4){x1[0] * cs0[0] - x2[0] * cs0[1], x1[1] * cs0[2] - x2[1] * cs0[3], x1[2] * cs1[0] - x2[2] * cs1[1], x1[3] * cs1[2] - x2[3] * cs1[3]};
                        v[nt + 2] = (f32x4){x2[0] * cs0[0] + x1[0] * cs0[1], x2[1] * cs0[2] + x1[1] * cs0[3], x2[2] * cs1[0] + x1[2] * cs1[1], x2[3] * cs1[2] + x1[3] * cs1[3]};
                    }
                }
                if (nclass >= 0) {
                    float ss = 0.f;
#pragma unroll
                    for (int nt = 0; nt < 4; ++nt) {
                        const unsigned w0 = pk2(v[nt][0], v[nt][1]), w1 = pk2(v[nt][2], v[nt][3]);
                        ss += bflo(w0) * bflo(w0) + bfhi(w0) * bfhi(w0) + bflo(w1) * bflo(w1) + bfhi(w1) * bfhi(w1);
                    }
                    ss += __shfl_xor(ss, 16); ss += __shfl_xor(ss, 32);
                    kmax2 = fmaxf(kmax2, ss);
                }
                u16* dst = hc == 2 ? (u16*)(p.ws + OFF_NQR) + (size_t)m * 256 + (nb - C_NQ) : P + (size_t)m * PW + nb;
                { u32x2 o4[4];
#pragma unroll
                  for (int nt = 0; nt < 4; ++nt) o4[nt] = (u32x2){pk2(v[nt][0], v[nt][1]), pk2(v[nt][2], v[nt][3])};
                  store_row4(dst, o4, g); }
#pragma unroll
                for (int i = 0; i < 4; ++i) rc[i] = rn[i];
            }
            if (nclass >= 0) {
#pragma unroll
                for (int o2 = 1; o2 < 16; o2 <<= 1) kmax2 = fmaxf(kmax2, __shfl_xor(kmax2, o2));
                if (lane == 0) __hip_atomic_fetch_max((LAS unsigned*)(smem + 65536) + nclass, __float_as_uint(kmax2), __ATOMIC_RELAXED, __HIP_MEMORY_SCOPE_WORKGROUP);
            }
        });
    block_sync();
    if (tid_ < 8) {
        const unsigned v = ((LAS unsigned*)(smem + 65536))[tid_];
        if (v != 0u) atomicMax(tid_ == 0 ? (unsigned*)(p.ws + OFF_CTRL) + 12 + layer : (unsigned*)(p.ws + OFF_FLAGS) + layer * 1024 + 720 + tid_, v);
    }
}

DEVI void ph_rope(const Params& p, int layer, int bid, int nblk) {
    u16* P = (u16*)(p.ws + OFF_P); u16* NQR = (u16*)(p.ws + OFF_NQR);
    float kmax2 = 0.f;
    const f32x2* tab = (const f32x2*)(p.ws + OFF_ROPE);
    const int lane = threadIdx.x & 63, i = lane & 31, half = lane >> 5;
    for (int tok = bid * 4 + (tid_opaque() >> 6); tok < NTOK; tok += nblk * 4) {
        const int s = tok & (SEQ - 1);
        const f32x2 cs = tab[s * 32 + i];
        u16* row = P + (size_t)tok * PW;
#pragma unroll
        for (int j = 0; j < 9; ++j) {
            const int hd = 2 * j + half;
            int col;
            if (hd < 6) col = C_DQ + hd * 64; else if (hd < 12) col = C_DK + (hd - 6) * 64; else if (hd < 16) col = C_NQ + (hd - 12) * 64; else if (hd == 16) col = C_NKS; else col = C_NKW;
            const float x1 = bf2f(row[col + i]), x2 = bf2f(row[col + 32 + i]);
            const float y1 = x1 * cs[0] - x2 * cs[1], y2 = x2 * cs[0] + x1 * cs[1];
            if (hd >= 12 && hd < 16) { u16* d = NQR + (size_t)tok * 256 + (hd - 12) * 64; d[i] = f2bf(y1); d[32 + i] = f2bf(y2); }
            else { row[col + i] = f2bf(y1); row[col + 32 + i] = f2bf(y2); }
        }
#pragma unroll
        for (int hh = 0; hh < 4; ++hh) { const float kv = bf2f(row[C_FK + hh * 64 + lane]); kmax2 = fmaxf(kmax2, wave_sum(kv * kv)); }
    }
    if (lane == 0) atomicMax((unsigned*)(p.ws + OFF_CTRL) + 12 + layer, __float_as_uint(kmax2));
}

DEVI void ph_foxcum(const Params& p, int layer, char* smem, int bid, int nblk) {
    float* part = (float*)smem;
    const int tid = threadIdx.x;
    const float* FS = (const float*)(p.ws + OFF_FS); float* CUM = (float*)(p.ws + OFF_CUM);
    for (int it = bid; it < 16; it += nblk) {
        const int b = it >> 2, h = it & 3;
        const float bf = p.fox_b_f[layer * 4 + h];
        float v[32]; float run = 0.f;
#pragma unroll
        for (int i = 0; i < 32; ++i) {
            const float z = FS[(size_t)(b * SEQ + tid * 32 + i) * 16 + h] + bf;
            const float ls = fminf(z, 0.f) - log1pf(__expf(-fabsf(z)));
            run += ls; v[i] = run;
        }
        block_sync();
        part[tid] = run; block_sync();
        if (tid == 0) { float a = 0.f; for (int i = 0; i < 256; ++i) { float t = part[i]; part[i] = a; a += t; } }
        block_sync();
        const float base = part[tid];
#pragma unroll
        for (int i = 0; i < 32; ++i) CUM[(size_t)(b * SEQ + tid * 32 + i) * 4 + h] = base + v[i];
    }
}

template <int MODE>
DEVI void ph_lru(const Params& p, int layer, char* smem, int bid, int nblk) {
    char* sXC = smem;
    float* sA = (float*)(smem + 16 * 528);
    float* sG = sA + 16 * 256;
    const int tid = tid_opaque(), ch = tid, lane = tid & 63, nb = tid >> 6, g = lane >> 4, c = lane & 15;
    const u16* P = (const u16*)(p.ws + OFF_P);
    float* SA = (float*)(p.ws + OFF_LSUM); float* SH = SA + 512 * 256;
    u16* O = (u16*)(p.ws + OFF_O);
    if (bid >= 512) return;
    s16x8 wfa[4][2], wfx[4][2];
    {
        const s16x8* F = (const s16x8*)(p.ws + OFF_LRUF);
#pragma unroll
        for (int nt = 0; nt < 4; ++nt)
#pragma unroll
            for (int ks = 0; ks < 2; ++ks) {
                wfa[nt][ks] = F[(((((layer * 2 + 0) * 4 + nb) * 4 + nt) * 2 + ks) << 6) + lane];
                wfx[nt][ks] = F[(((((layer * 2 + 1) * 4 + nb) * 4 + nt) * 2 + ks) << 6) + lane];
            }
    }
    float gba[4], gbx[4], gsp[4];
#pragma unroll
    for (int nt = 0; nt < 4; ++nt) {
        const int cc = layer * 256 + nb * 64 + 16 * nt + c;
        gba[nt] = p.lru_b_a[cc]; gbx[nt] = p.lru_b_x[cc];
        const float lam = p.lru_lambda[cc];
        gsp[nt] = (lam > 0.f ? 0.f : -lam) + log1pf(__expf(-fabsf(lam)));
    }
    const float cw0 = p.lru_conv_w[(layer * 4 + 0) * 256 + ch], cw1 = p.lru_conv_w[(layer * 4 + 1) * 256 + ch],
                cw2 = p.lru_conv_w[(layer * 4 + 2) * 256 + ch], cw3 = p.lru_conv_w[(layer * 4 + 3) * 256 + ch];
    const float cb = p.lru_conv_b[layer * 256 + ch];
    for (int tile = bid; tile < 512; tile += nblk) {
        const int b = tile >> 7, k = tile & 127, t0 = b * SEQ + k * 64;
        float hst = 0.f, aprod = 1.f;
        if (MODE == 1) {
            int j = 0;
            for (; j + 8 <= k; j += 8) {
                float ca[8], chh[8];
#pragma unroll
                for (int q = 0; q < 8; ++q) { const int tj = (b << 7) + j + q; ca[q] = SA[tj * 256 + ch]; chh[q] = SH[tj * 256 + ch]; }
#pragma unroll
                for (int q = 0; q < 8; ++q) hst = ca[q] * hst + chh[q];
            }
            for (; j < k; ++j) { const int tj = (b << 7) + j; hst = SA[tj * 256 + ch] * hst + SH[tj * 256 + ch]; }
        }
        float x0 = 0.f, x1 = 0.f, x2 = 0.f;
        if (k > 0) { x0 = bf2f(P[(size_t)(t0 - 3) * PW + C_LX + ch]); x1 = bf2f(P[(size_t)(t0 - 2) * PW + C_LX + ch]); x2 = bf2f(P[(size_t)(t0 - 1) * PW + C_LX + ch]); }
        u16 xin[16], gin[16];
#pragma unroll
        for (int i = 0; i < 16; ++i) { xin[i] = P[(size_t)(t0 + i) * PW + C_LX + ch]; if (MODE == 1) gin[i] = P[(size_t)(t0 + i) * PW + C_LG + ch]; }
        for (int sub = 0; sub < 4; ++sub) {
            float xc[16]; u16 xcur[16], gcur[16];
#pragma unroll
            for (int i = 0; i < 16; ++i) { xcur[i] = xin[i]; if (MODE == 1) gcur[i] = gin[i]; }
            if (sub < 3) {
#pragma unroll
                for (int i = 0; i < 16; ++i) { xin[i] = P[(size_t)(t0 + (sub + 1) * 16 + i) * PW + C_LX + ch]; if (MODE == 1) gin[i] = P[(size_t)(t0 + (sub + 1) * 16 + i) * PW + C_LG + ch]; }
            }
            block_sync();
#pragma unroll
            for (int i = 0; i < 16; ++i) {
                const float x3 = bf2f(xcur[i]);
                xc[i] = cw0 * x0 + cw1 * x1 + cw2 * x2 + cw3 * x3 + cb;
                x0 = x1; x1 = x2; x2 = x3;
                *(u16*)(sXC + i * 528 + ch * 2) = f2bf(xc[i]);
            }
            block_sync();
            {
                const s16x8 a0 = *(const s16x8*)(sXC + c * 528 + (nb * 64 + 8 * g) * 2);
                const s16x8 a1 = *(const s16x8*)(sXC + c * 528 + (nb * 64 + 32 + 8 * g) * 2);
#pragma unroll
                for (int nt = 0; nt < 4; ++nt) {
                    f32x4 za = {0.f, 0.f, 0.f, 0.f}, zx = {0.f, 0.f, 0.f, 0.f};
                    za = mfma16(a0, wfa[nt][0], za); za = mfma16(a1, wfa[nt][1], za);
                    zx = mfma16(a0, wfx[nt][0], zx); zx = mfma16(a1, wfx[nt][1], zx);
#pragma unroll
                    for (int r = 0; r < 4; ++r) {
                        const float rr = sigmoidf_(za[r] + gba[nt]), ig = sigmoidf_(zx[r] + gbx[nt]);
                        const float log_a = -8.0f * rr * gsp[nt], a_ = __expf(log_a), x2 = 2.f * log_a;
                        const float em = x2 > -0.02f ? -x2 * (1.f + x2 * (0.5f + x2 * 0.16666667f)) : 1.f - a_ * a_;
                        sA[(4 * g + r) * 256 + nb * 64 + 16 * nt + c] = a_;
                        sG[(4 * g + r) * 256 + nb * 64 + 16 * nt + c] = __builtin_amdgcn_sqrtf(em) * ig;
                    }
                }
            }
            block_sync();
#pragma unroll
            for (int i = 0; i < 16; ++i) {
                const float a = sA[i * 256 + ch];
                hst = a * hst + sG[i * 256 + ch] * xc[i];
                if (MODE == 0) aprod *= a;
                else {
                    const size_t tok = (size_t)(t0 + sub * 16 + i);
                    const float gate = bf2f(gcur[i]);
                    O[tok * OW + O_LRU + ch] = f2bf(hst * gelu_tanh(gate));
                }
            }
        }
        if (MODE == 0) { SA[tile * 256 + ch] = aprod; SH[tile * 256 + ch] = hst; }
    }
}

DEVI void ph_cmp(const Params& p, int layer, char* smem, int bid, int nblk) {
    const u16* P = (const u16*)(p.ws + OFF_P);
    const int tid_ = tid_opaque(), lane = tid_ & 63, w = tid_ >> 6, wm = w >> 1, wn = w & 1, g = lane >> 4, c = lane & 15;
    for (int t = bid; t < 64; t += nblk) {
        const int z = t >> 5, tm = t & 31;
        const int b = tm >> 3, i0 = (tm & 7) * 64;
        const u16* A = P + (size_t)(b * SEQ) * PW + (z ? C_NVC : C_NKC);
        const u16* Wt = (const u16*)(p.ws + OFF_W1) + ((size_t)(layer * 2 + z) * 256) * 2048;
        const float* b1 = (const float*)(p.ws + OFF_B1) + (layer * 2 + z) * 256;
        u16* HID = (u16*)(p.ws + OFF_HID) + (size_t)z * 2048 * 256;
        for (int tn = 0; tn < 2; ++tn) {
            f32x4 acc[2][4]; acc_zero(acc);
            gemm_mainloop<64, 128>(A, (size_t)16 * PW, (size_t)PW, Wt, 2048, 2048, i0, tn * 128, smem, acc);
#pragma unroll
            for (int mt = 0; mt < 2; ++mt)
#pragma unroll
                for (int nt = 0; nt < 4; ++nt) {
                    const int m = b * 512 + i0 + wm * 32 + 16 * mt + c, n = tn * 128 + wn * 64 + 16 * nt + 4 * g;
                    const f32x4 bb = *(const f32x4*)(b1 + n);
                    u32x2 o = {pk2(gelu_tanh(acc[mt][nt][0] + bb[0]), gelu_tanh(acc[mt][nt][1] + bb[1])), pk2(gelu_tanh(acc[mt][nt][2] + bb[2]), gelu_tanh(acc[mt][nt][3] + bb[3]))};
                    *(u32x2*)(HID + (size_t)m * 256 + n) = o;
                }
        }
        block_sync();
        {
            const u16* W2 = (const u16*)(p.ws + OFF_W2) + ((size_t)(layer * 2 + z) * 64) * 256;
            f32x4 acc[2][2]; acc_zero(acc); float kss[2] = {0.f, 0.f};
            gemm_mainloop<64, 64>(HID, 256, 64, W2, 256, 256, b * 512 + i0, 0, smem, acc);
            u16* KVC = (u16*)(p.ws + OFF_KVC) + (size_t)z * NB * 512 * 64;
#pragma unroll
            for (int mt = 0; mt < 2; ++mt)
#pragma unroll
                for (int nt = 0; nt < 2; ++nt) {
                    const int m = b * 512 + i0 + wm * 32 + 16 * mt + c, n = wn * 32 + 16 * nt + 4 * g;
                    u32x2 o = {pk2(acc[mt][nt][0], acc[mt][nt][1]), pk2(acc[mt][nt][2], acc[mt][nt][3])};
                    if ((m & 511) == 511) o = (u32x2){0u, 0u};
                    *(u32x2*)(KVC + (size_t)m * 64 + n) = o;
                    kss[mt] += bflo(o[0]) * bflo(o[0]) + bfhi(o[0]) * bfhi(o[0]) + bflo(o[1]) * bflo(o[1]) + bfhi(o[1]) * bfhi(o[1]);
                }
            if (z == 0) {
                float k0 = kss[0]; k0 += __shfl_xor(k0, 16); k0 += __shfl_xor(k0, 32);
                float k1 = kss[1]; k1 += __shfl_xor(k1, 16); k1 += __shfl_xor(k1, 32);
                float km = fmaxf(k0, k1);
#pragma unroll
                for (int o2 = 1; o2 < 16; o2 <<= 1) km = fmaxf(km, __shfl_xor(km, o2));
                if (lane == 0) atomicMax((unsigned*)(p.ws + OFF_FLAGS) + layer * 1024 + 730 + wn, __float_as_uint(km));
            }
        }
    }
}
constexpr float LOG2E = 1.4426950408889634f, SC2 = 0.125f * LOG2E;
template <int NQT, class F>
DEVI void attn_tile64(const char* sK, const char* sV, const s16x8 (&qf)[NQT][2], float (&m)[NQT], f32x4 (&l)[NQT], f32x4 (&o)[NQT][4], int lane, F&& logit,
                      bool fast = false, float lb0 = 0.f, float lb1 = 0.f, bool fixedm = false) {
    const int g = lane >> 4, c = lane & 15;
    f32x4 s[NQT][4];
#pragma unroll
    for (int T = 0; T < 4; ++T) {
        const int row = 16 * T + c;
        const s16x8 k0 = *(const s16x8*)(sK + row * 128 + ((g ^ (row & 7)) << 4));
        const s16x8 k1 = *(const s16x8*)(sK + row * 128 + (((4 + g) ^ (row & 7)) << 4));
#pragma unroll
        for (int qt = 0; qt < NQT; ++qt) { f32x4 z = {0.f, 0.f, 0.f, 0.f}; z = mfma16(k0, qf[qt][0], z); z = mfma16(k1, qf[qt][1], z); s[qt][T] = z; }
    }
#pragma unroll
    for (int qt = 0; qt < NQT; ++qt) {
        float mx = -INFINITY;
        float off;
        float mn = m[qt];
        if (fixedm) {
            if (!fast) {
#pragma unroll
                for (int T = 0; T < 4; ++T) logit(qt, T, s[qt][T]);
            }
        } else {
            if (fast) {
#pragma unroll
                for (int T = 0; T < 4; ++T) { mx = fmaxf(fmaxf(mx, s[qt][T][0]), s[qt][T][1]); mx = fmaxf(fmaxf(mx, s[qt][T][2]), s[qt][T][3]); }
                mx = mx * SC2 + (qt == 0 ? lb0 : lb1);
            } else {
#pragma unroll
                for (int T = 0; T < 4; ++T) { logit(qt, T, s[qt][T]); mx = fmaxf(fmaxf(mx, s[qt][T][0]), s[qt][T][1]); mx = fmaxf(fmaxf(mx, s[qt][T][2]), s[qt][T][3]); }
            }
            mx = fmaxf(mx, __shfl_xor(mx, 16)); mx = fmaxf(mx, __shfl_xor(mx, 32));
            mn = fmaxf(m[qt], mx);
            if (__ballot(mn > m[qt]) != 0ull) {
                const float alpha = __builtin_amdgcn_exp2f(m[qt] - mn);
                l[qt] *= alpha;
#pragma unroll
                for (int dt = 0; dt < 4; ++dt) o[qt][dt] *= alpha;
            }
            m[qt] = mn;
        }
        if (fast) {
            off = (qt == 0 ? lb0 : lb1) - mn;
#pragma unroll
            for (int T = 0; T < 4; ++T)
#pragma unroll
                for (int r = 0; r < 4; ++r) s[qt][T][r] = __builtin_amdgcn_exp2f(s[qt][T][r] * SC2 + off);
        } else {
#pragma unroll
            for (int T = 0; T < 4; ++T)
#pragma unroll
                for (int r = 0; r < 4; ++r) s[qt][T][r] = __builtin_amdgcn_exp2f(s[qt][T][r] - mn);
        }
    }
    const short one = (lane & 15) == 0 ? (short)0x3F80 : (short)0;
    const s16x8 ones = {one, one, one, one, one, one, one, one};
#pragma unroll
    for (int u = 0; u < 2; ++u) {
        s16x8 pb[NQT];
#pragma unroll
        for (int qt = 0; qt < NQT; ++qt) {
            u32x4 pk = {pk2(s[qt][2 * u][0], s[qt][2 * u][1]), pk2(s[qt][2 * u][2], s[qt][2 * u][3]), pk2(s[qt][2 * u + 1][0], s[qt][2 * u + 1][1]), pk2(s[qt][2 * u + 1][2], s[qt][2 * u + 1][3])};
            pb[qt] = __builtin_bit_cast(s16x8, pk);
            l[qt] = mfma16(ones, pb[qt], l[qt]);
        }
#pragma unroll
        for (int dt = 0; dt < 4; ++dt) {
            const char* a0 = sV + (32 * u + 4 * g + (c >> 2)) * 144 + (16 * dt + 4 * (c & 3)) * 2;
            const s16x4 v0 = __builtin_amdgcn_ds_read_tr16_b64_v4i16((LAS s16x4*)(a0));
            const s16x4 v1 = __builtin_amdgcn_ds_read_tr16_b64_v4i16((LAS s16x4*)(a0 + 16 * 144));
            const s16x8 vf = {v0[0], v0[1], v0[2], v0[3], v1[0], v1[1], v1[2], v1[3]};
#pragma unroll
            for (int qt = 0; qt < NQT; ++qt) o[qt][dt] = mfma16(vf, pb[qt], o[qt][dt]);
        }
    }
}
DEVI float logit_bound(const unsigned* FLk, int qclass, int kclass0, int kclass1 = -1) {
    const float q2 = __uint_as_float(FLk[qclass]);
    float k2 = __uint_as_float(FLk[kclass0]); if (kclass1 >= 0) k2 += __uint_as_float(FLk[kclass1]);
    return sqrtf(q2 * k2) * SC2 * 1.001f + 0.01f;
}
template <int NQT> DEVI void attn_init(float (&m)[NQT], f32x4 (&l)[NQT], f32x4 (&o)[NQT][4]) {
#pragma unroll
    for (int qt = 0; qt < NQT; ++qt) { m[qt] = -1e30f; l[qt] = (f32x4){0.f, 0.f, 0.f, 0.f};
#pragma unroll
        for (int dt = 0; dt < 4; ++dt) o[qt][dt] = (f32x4){0.f, 0.f, 0.f, 0.f}; }
}
DEVI float attn_ltot(float l) { return __shfl(l, (int)(threadIdx.x & 15)); }
DEVI void stage_kv_block(char* sK, char* sV, const u16* kbase, const u16* vbase, size_t rstride) {
    const int tid = tid_opaque();
#pragma unroll
    for (int i = 0; i < 2; ++i) {
        const int id = tid + 256 * i, key = id >> 3, cc = id & 7;
        const u32x4 kv = *(const u32x4*)(kbase + (size_t)key * rstride + cc * 8);
        const u32x4 vv = *(const u32x4*)(vbase + (size_t)key * rstride + cc * 8);
        *(u32x4*)(sK + key * 128 + ((cc ^ (key & 7)) << 4)) = kv;
        *(u32x4*)(sV + key * 144 + cc * 16) = vv;
    }
}

struct KVPref { u32x4 k[2], v[2]; };
DEVI void kv_load(KVPref& r, const u16* kbase, const u16* vbase, size_t rstride, int tid) {
#pragma unroll
    for (int i = 0; i < 2; ++i) {
        const int id = tid + 256 * i, key = id >> 3, cc = id & 7;
        r.k[i] = *(const u32x4*)(kbase + (size_t)key * rstride + cc * 8);
        r.v[i] = *(const u32x4*)(vbase + (size_t)key * rstride + cc * 8);
    }
}
DEVI void kv_store(char* sK, char* sV, const KVPref& r, int tid) {
#pragma unroll
    for (int i = 0; i < 2; ++i) {
        const int id = tid + 256 * i, key = id >> 3, cc = id & 7;
        *(u32x4*)(sK + key * 128 + ((cc ^ (key & 7)) << 4)) = r.k[i];
        *(u32x4*)(sV + key * 144 + cc * 16) = r.v[i];
    }
}
constexpr int ATT_SK = 8192, ATT_SV = 64 * 144;

DEVI void fox_item(const Params& p, int layer, char* smem, int qb, int bh) {
    char* sK = smem; char* sV = smem + ATT_SK; float* sC = (float*)(smem + ATT_SK + ATT_SV); int* sF = (int*)(smem + ATT_SK + ATT_SV + 256);
    const u16* P = (const u16*)(p.ws + OFF_P); const float* CUM = (const float*)(p.ws + OFF_CUM); u16* O = (u16*)(p.ws + OFF_O);
    const int tid = tid_opaque(), lane = tid & 63, w = tid >> 6, g = lane >> 4, c = lane & 15;
    const int b = bh >> 2, h = bh & 3;
    const int q0 = qb * 128, qw = q0 + 32 * w;
    const float kmax = sqrtf(__uint_as_float(((const unsigned*)(p.ws + OFF_CTRL))[12 + layer]));
    s16x8 qf[2][2]; float cq[2], cq2[2], qb8[2];
#pragma unroll
    for (int qt = 0; qt < 2; ++qt) {
        const size_t tok = (size_t)b * SEQ + qw + 16 * qt + c;
        qf[qt][0] = *(const s16x8*)(P + tok * PW + C_FQ + h * 64 + 8 * g);
        qf[qt][1] = *(const s16x8*)(P + tok * PW + C_FQ + h * 64 + 32 + 8 * g);
        cq[qt] = CUM[tok * 4 + h];
        cq2[qt] = cq[qt] * LOG2E;
        float ss = 0.f;
#pragma unroll
        for (int j = 0; j < 8; ++j) { const float a0 = bf2f((u16)qf[qt][0][j]), a1 = bf2f((u16)qf[qt][1][j]); ss += a0 * a0 + a1 * a1; }
        ss += __shfl_xor(ss, 16); ss += __shfl_xor(ss, 32);
        qb8[qt] = sqrtf(ss) * kmax * 0.125f;
    }
    float m[2]; f32x4 l[2]; f32x4 o[2][4]; attn_init<2>(m, l, o);
    const int ntile = (q0 + 128) / 64;
    KVPref pf; float pfc = 0.f;
    { const size_t kt0 = (size_t)b * SEQ + (ntile - 1) * 64; kv_load(pf, P + kt0 * PW + C_FK + h * 64, P + kt0 * PW + C_FV + h * 64, PW, tid); if (tid < 64) pfc = CUM[(kt0 + tid) * 4 + h] * LOG2E; }
    if (tid < 4) sF[tid] = 0;
    for (int kt = ntile - 1; kt >= 0; --kt) {
        block_sync();
        if (sF[0] & sF[1] & sF[2] & sF[3]) break;
        kv_store(sK, sV, pf, tid);
        if (tid < 64) sC[tid] = pfc;
        block_sync();
        float cprev = 0.f;
        if (kt > 0) { const size_t kt0 = (size_t)b * SEQ + (kt - 1) * 64; kv_load(pf, P + kt0 * PW + C_FK + h * 64, P + kt0 * PW + C_FV + h * 64, PW, tid); if (tid < 64) pfc = CUM[(kt0 + tid) * 4 + h] * LOG2E;
                      cprev = CUM[((size_t)b * SEQ + kt * 64 - 1) * 4 + h]; }
        if (kt * 64 <= qw + 31) {
            attn_tile64<2>(sK, sV, qf, m, l, o, lane, [&](int qt, int T, f32x4& s) {
                const f32x4 ck = *(const f32x4*)&sC[16 * T + 4 * g];
                const int qpos = qw + 16 * qt + c, k0 = kt * 64 + 16 * T + 4 * g;
                if (kt * 64 + 63 <= qw) {
#pragma unroll
                    for (int r = 0; r < 4; ++r) s[r] = s[r] * SC2 + (cq2[qt] - ck[r]);
                } else {
#pragma unroll
                    for (int r = 0; r < 4; ++r) s[r] = (k0 + r <= qpos) ? s[r] * SC2 + (cq2[qt] - ck[r]) : -INFINITY;
                }
            });
        }
        const bool done = (m[0] > -1e29f) && (m[1] > -1e29f) && ((qb8[0] + cq[0] - cprev) * LOG2E < m[0] - 40.f) && ((qb8[1] + cq[1] - cprev) * LOG2E < m[1] - 40.f);
        const bool wdone = __ballot(done) == ~0ull;
        if (lane == 0) sF[w] = wdone ? 1 : 0;
    }
#pragma unroll
    for (int qt = 0; qt < 2; ++qt) {
        const float inv = 1.f / attn_ltot(l[qt][0]);
        const size_t tok = (size_t)b * SEQ + qw + 16 * qt + c;
        u32x2 o4[4];
#pragma unroll
        for (int dt = 0; dt < 4; ++dt) o4[dt] = (u32x2){pk2(o[qt][dt][0] * inv, o[qt][dt][1] * inv), pk2(o[qt][dt][2] * inv, o[qt][dt][3] * inv)};
        store_row4(O + tok * OW + O_FOX + h * 64, o4, g);
    }
}

DEVI void dil_item(const Params& p, int layer, char* smem, int blk) {
    const u16* P = (const u16*)(p.ws + OFF_P); u16* O = (u16*)(p.ws + OFF_O);
    const int tid = tid_opaque(), lane = tid & 63, w = tid >> 6, g = lane >> 4, c = lane & 15;
    char* sK = smem + w * (ATT_SK + ATT_SV); char* sV = sK + ATT_SK;
    const int wt = blk * 4 + w, hg = wt & 1, t0r = (wt >> 1) & 15, span = (wt >> 5) & 15, b = wt >> 9;
    const int pbase = 512 * span + t0r;
    float m[2]; f32x4 l[2]; f32x4 o[2][4]; attn_init<2>(m, l, o);
    m[0] = m[1] = logit_bound((const unsigned*)(p.ws + OFF_FLAGS) + layer * 1024 + 720, 5, 1);
#pragma unroll 1
    for (int gi = 0; gi < 3; ++gi) {
        const int sh = 2 * gi, dl = 1 << sh;
        const int head = 2 * gi + hg, rr = t0r & (dl - 1);
        s16x8 qf[2][2]; int uq[2];
#pragma unroll
        for (int qt = 0; qt < 2; ++qt) {
            const int pos = pbase + 16 * (16 * qt + c);
            const size_t tok = (size_t)b * SEQ + pos;
            qf[qt][0] = *(const s16x8*)(P + tok * PW + C_DQ + head * 64 + 8 * g);
            qf[qt][1] = *(const s16x8*)(P + tok * PW + C_DQ + head * 64 + 32 + 8 * g);
            uq[qt] = (pos - rr) >> sh;
        }
        int ulo = ((512 * span) >> sh) - 128; if (ulo < 0) ulo = 0;
        const int uhi = (512 * span + 15 + 496) >> sh;
        const int nt = (uhi - ulo) / 64 + 1;
        const u16* kb = P + (size_t)b * SEQ * PW + C_DK + head * 64 + (lane & 7) * 8;
        const u16* vb = P + (size_t)b * SEQ * PW + C_DV + head * 64 + (lane & 7) * 8;
        u32x4 kr[8], vr[8];
#pragma unroll
        for (int i = 0; i < 8; ++i) {
            int pos = rr + ((ulo + (lane >> 3) + 8 * i) << sh); if (pos > SEQ - 1) pos = SEQ - 1;
            kr[i] = *(const u32x4*)(kb + (size_t)pos * PW); vr[i] = *(const u32x4*)(vb + (size_t)pos * PW);
        }
        for (int kt = 0; kt < nt; ++kt) {
#pragma unroll
            for (int i = 0; i < 8; ++i) {
                const int key = (lane >> 3) + 8 * i, cc = lane & 7;
                *(u32x4*)(sK + key * 128 + ((cc ^ (key & 7)) << 4)) = kr[i];
                *(u32x4*)(sV + key * 144 + cc * 16) = vr[i];
            }
            if (kt + 1 < nt) {
#pragma unroll
                for (int i = 0; i < 8; ++i) {
                    int pos = rr + ((ulo + (kt + 1) * 64 + (lane >> 3) + 8 * i) << sh); if (pos > SEQ - 1) pos = SEQ - 1;
                    kr[i] = *(const u32x4*)(kb + (size_t)pos * PW); vr[i] = *(const u32x4*)(vb + (size_t)pos * PW);
                }
            }
            attn_tile64<2>(sK, sV, qf, m, l, o, lane, [&](int qt, int T, f32x4& s) {
                const int u0 = ulo + kt * 64 + 16 * T + 4 * g;
#pragma unroll
                for (int r = 0; r < 4; ++r) { const int u = u0 + r; s[r] = (u <= uq[qt] && u >= uq[qt] - 128) ? s[r] * SC2 : -INFINITY; }
            }, false, 0.f, 0.f, true);
        }
    }
#pragma unroll
    for (int qt = 0; qt < 2; ++qt) {
        const float inv = 1.f / attn_ltot(l[qt][0]);
        const size_t tok = (size_t)b * SEQ + pbase + 16 * (16 * qt + c);
        u32x2 o4[4];
#pragma unroll
        for (int dt = 0; dt < 4; ++dt) o4[dt] = (u32x2){pk2(o[qt][dt][0] * inv, o[qt][dt][1] * inv), pk2(o[qt][dt][2] * inv, o[qt][dt][3] * inv)};
        store_row4(O + tok * OW + O_DIL + hg * 64, o4, g);
    }
}

DEVI void nsa_item(const Params& p, int layer, char* smem, int blk, int part) {
    constexpr int STG = ATT_SK + ATT_SV;
    float* sImp = (float*)(smem + 2 * STG);
    const u16* P = (const u16*)(p.ws + OFF_P); const u16* NQR = (const u16*)(p.ws + OFF_NQR);
    const u16* KC = (const u16*)(p.ws + OFF_KVC); const u16* VC = KC + (size_t)NB * 512 * 64;
    u16* OC = (u16*)(p.ws + OFF_OC); unsigned* SEL = (unsigned*)(p.ws + OFF_SEL);
    const float* FS = (const float*)(p.ws + OFF_FS); u16* O = (u16*)(p.ws + OFF_O);
    const int tid = tid_opaque(), lane = tid & 63, w = tid >> 6, g = lane >> 4, c = lane & 15;
    const int b = blk >> 7, s0 = (blk & 127) * 64;
    const unsigned* FLk = (const unsigned*)(p.ws + OFF_FLAGS) + layer * 1024 + 720;
    if (part == 0) {
        const int sq = s0 + 16 * w + c;
        const size_t tok = (size_t)b * SEQ + sq;
        block_sync();
        for (int i = tid; i < 64 * 128; i += 256) sImp[i] = 0.f;
        const int ntile = ((s0 + 32) / 16) / 64 + 1;
        const int cmax = (sq - 31) >> 4, cmin = (s0 + 16 * w - 31) >> 4;
        const u16* KCb = KC + ((size_t)b * 512) * 64; const u16* VCb = VC + ((size_t)b * 512) * 64;
        const int J = 4 * ntile;
        s16x8 qf[2][2]; float m[2]; f32x4 l[2]; f32x4 o[2][4]; float linv[2] = {0.f, 0.f}, acur[2] = {0.f, 0.f};
        qf[0][0] = qf[0][1] = qf[1][0] = qf[1][1] = (s16x8){0, 0, 0, 0, 0, 0, 0, 0}; attn_init<2>(m, l, o);
        const float mC = logit_bound(FLk, 6, 10, 11);
        KVPref pf;
        kv_load(pf, KCb, VCb, 64, tid);
        kv_store(smem, smem + ATT_SK, pf, tid);
        { const int k1 = 1 < ntile ? 1 : 0; kv_load(pf, KCb + (size_t)k1 * 64 * 64, VCb + (size_t)k1 * 64 * 64, 64, tid); }
        int hp = 0, jj = 0, cur = 0, kt1 = 1 < ntile ? 1 : 0;
        for (int j = 0; j < J; ++j) {
            block_sync();
            if (j + 1 < J) kv_store(smem + (cur ^ 1) * STG, smem + (cur ^ 1) * STG + ATT_SK, pf, tid);
            int kt2 = kt1 + 1; if (kt2 >= ntile) kt2 = 0;
            if (j + 2 < J) kv_load(pf, KCb + (size_t)kt2 * 64 * 64, VCb + (size_t)kt2 * 64 * 64, 64, tid);
            const char* sK = smem + cur * STG; const char* sV = sK + ATT_SK;
            if (jj == 0) {
#pragma unroll
                for (int q = 0; q < 2; ++q) {
                    qf[q][0] = *(const s16x8*)(P + tok * PW + C_NQ + (2 * hp + q) * 64 + 8 * g); qf[q][1] = *(const s16x8*)(P + tok * PW + C_NQ + (2 * hp + q) * 64 + 32 + 8 * g);
                }
                attn_init<2>(m, l, o); m[0] = m[1] = mC;
            }
            if (jj < ntile) {
                const int kt = jj;
                attn_tile64<2>(sK, sV, qf, m, l, o, lane, [&](int, int T, f32x4& s) {
                    const int c0 = kt * 64 + 16 * T + 4 * g;
#pragma unroll
                    for (int r = 0; r < 4; ++r) s[r] = (c0 + r <= cmax) ? s[r] * SC2 : -INFINITY;
                }, kt * 64 + 63 <= cmin, 0.f, 0.f, true);
                if (jj == ntile - 1) {
#pragma unroll
                    for (int q = 0; q < 2; ++q) {
                        const float lt = attn_ltot(l[q][0]);
                        linv[q] = lt > 0.f ? 1.f / lt : 0.f;
#pragma unroll
                        for (int dt = 0; dt < 4; ++dt) {
                            u32x2 ov = {pk2(o[q][dt][0] * linv[q], o[q][dt][1] * linv[q]), pk2(o[q][dt][2] * linv[q], o[q][dt][3] * linv[q])};
                            *(u32x2*)(OC + tok * 256 + (2 * hp + q) * 64 + 16 * dt + 4 * g) = ov;
                        }
                        acur[q] = 0.f;
                    }
                }
            } else {
                const int kt = jj - ntile;
#pragma unroll
                for (int T = 0; T < 4; ++T) {
                    const int row = 16 * T + c;
                    const s16x8 k0 = *(const s16x8*)(sK + row * 128 + ((g ^ (row & 7)) << 4));
                    const s16x8 k1 = *(const s16x8*)(sK + row * 128 + (((4 + g) ^ (row & 7)) << 4));
                    const int c0 = kt * 64 + 16 * T + 4 * g;
                    float add = 0.f;
#pragma unroll
                    for (int q = 0; q < 2; ++q) {
                        f32x4 z = {0.f, 0.f, 0.f, 0.f}; z = mfma16(k0, qf[q][0], z); z = mfma16(k1, qf[q][1], z);
                        float pr[4];
#pragma unroll
                        for (int r = 0; r < 4; ++r) pr[r] = (c0 + r <= cmax) ? __builtin_amdgcn_exp2f(z[r] * SC2 - m[q]) * linv[q] : 0.f;
                        const float a = __shfl(pr[3], (lane + 48) & 63);
                        const float prev = g > 0 ? a : acur[q];
                        acur[q] = a;
                        add += pr[0] + pr[1] + pr[2] + pr[3] + prev;
                    }
                    sImp[(16 * w + c) * 128 + 16 * kt + 4 * T + g] += add;
                }
            }
            ++jj; if (jj == 2 * ntile) { jj = 0; ++hp; }
            kt1 = kt2; cur ^= 1;
        }
        block_sync();
        for (int tl = 0; tl < 16; ++tl) {
            const int sp = s0 + 16 * w + tl, curb = sp >> 6;
            unsigned k0, k1; bool sel0 = false, sel1 = false;
            {
                const int n0 = lane, n1 = lane + 64;
                float v0 = sImp[(16 * w + tl) * 128 + n0], v1 = sImp[(16 * w + tl) * 128 + n1];
                if (n0 == 0 || n0 == curb || n0 == curb - 1) v0 = 1e6f;
                if (n1 == curb || n1 == curb - 1) v1 = 1e6f;
                k0 = n0 <= curb ? (((__float_as_uint(v0) | 0x80000000u) & ~127u) | (unsigned)(127 - n0)) : 0u;
                k1 = n1 <= curb ? (((__float_as_uint(v1) | 0x80000000u) & ~127u) | (unsigned)(127 - n1)) : 0u;
            }
            if (curb < 16) { sel0 = k0 != 0u; sel1 = k1 != 0u; }
            else {
                unsigned thr = 0x80000000u;
                for (int bit = 30; bit >= 0; --bit) {
                    const unsigned t = thr | (1u << bit);
                    const int cnt = __popcll(__ballot(k0 >= t)) + __popcll(__ballot(k1 >= t));
                    if (cnt >= 16) thr = t;
                }
                sel0 = k0 >= thr; sel1 = k1 >= thr;
            }
            const unsigned long long b0 = __ballot(sel0), b1 = __ballot(sel1);
            if (lane == 0) { u32x4 mk = {(unsigned)b0, (unsigned)(b0 >> 32), (unsigned)b1, (unsigned)(b1 >> 32)}; *(u32x4*)(SEL + ((size_t)b * SEQ + sp) * 4) = mk; }
        }
    }
    const int h = w;
    if (part > 0) {
        const int sub = part - 1;
        const int t0 = s0 + 32 * sub;
        s16x8 qf[2][2]; u32x4 msk[2];
#pragma unroll
        for (int qt = 0; qt < 2; ++qt) {
            const size_t tok = (size_t)b * SEQ + t0 + 16 * qt + c;
            qf[qt][0] = *(const s16x8*)(NQR + tok * 256 + h * 64 + 8 * g);
            qf[qt][1] = *(const s16x8*)(NQR + tok * 256 + h * 64 + 32 + 8 * g);
            msk[qt] = *(const u32x4*)(SEL + tok * 4);
        }
        float m[2]; f32x4 l[2]; f32x4 o[2][4]; attn_init<2>(m, l, o);
        const float mW = logit_bound(FLk, 6, 3), mS = logit_bound(FLk, 6, 2);
        m[0] = m[1] = mW;
        int klo = t0 - 511; if (klo < 0) klo = 0; klo >>= 6;
        const int khi = (t0 + 31) >> 6;
        u32x4 un;
        {
            u32x4 t = {msk[0][0] | msk[1][0], msk[0][1] | msk[1][1], msk[0][2] | msk[1][2], msk[0][3] | msk[1][3]};
#pragma unroll
            for (int o2 = 1; o2 < 16; o2 <<= 1) { t[0] |= (unsigned)__shfl_xor((int)t[0], o2); t[1] |= (unsigned)__shfl_xor((int)t[1], o2); t[2] |= (unsigned)__shfl_xor((int)t[2], o2); t[3] |= (unsigned)__shfl_xor((int)t[3], o2); }
            un = (u32x4){(unsigned)__builtin_amdgcn_readfirstlane((int)t[0]), (unsigned)__builtin_amdgcn_readfirstlane((int)t[1]), (unsigned)__builtin_amdgcn_readfirstlane((int)t[2]), (unsigned)__builtin_amdgcn_readfirstlane((int)t[3])};
        }
        auto next_tag = [&](int tag) -> int {
            if (tag < 256) return tag < khi ? tag + 1 : 256;
            int q = tag - 256 + 1;
            while (q < 128) {
                const unsigned uw = (q < 32 ? un[0] : (q < 64 ? un[1] : (q < 96 ? un[2] : un[3]))) >> (q & 31);
                if (uw) return 256 + q + __builtin_ctz(uw);
                q = (q | 31) + 1;
            }
            return -1;
        };
        auto load_tag = [&](KVPref& q, int tag) {
            if (tag < 256) { const size_t kt0 = (size_t)b * SEQ + tag * 64; kv_load(q, P + kt0 * PW + C_NKW, P + kt0 * PW + C_NVW, PW, tid); }
            else { const size_t kt0 = (size_t)b * SEQ + (tag - 256) * 64; kv_load(q, P + kt0 * PW + C_NKS, P + kt0 * PW + C_NVS, PW, tid); }
        };
        f32x4 ow[2][4];
        KVPref pf;
        int tagA = klo, tagB = next_tag(klo), cur = 0;
        load_tag(pf, tagA);
        block_sync();
        kv_store(smem, smem + ATT_SK, pf, tid);
        load_tag(pf, tagB);
        for (;;) {
            block_sync();
            if (tagB >= 0) kv_store(smem + (cur ^ 1) * STG, smem + (cur ^ 1) * STG + ATT_SK, pf, tid);
            const int tagC = tagB >= 0 ? next_tag(tagB) : -1;
            if (tagC >= 0) load_tag(pf, tagC);
            const char* sK = smem + cur * STG; const char* sV = sK + ATT_SK;
            if (tagA < 256) {
                const int kt = tagA;
                attn_tile64<2>(sK, sV, qf, m, l, o, lane, [&](int qt, int T, f32x4& s) {
                    const int qpos = t0 + 16 * qt + c, k0 = kt * 64 + 16 * T + 4 * g;
#pragma unroll
                    for (int r = 0; r < 4; ++r) s[r] = (k0 + r <= qpos && k0 + r > qpos - 512) ? s[r] * SC2 : -INFINITY;
                }, kt * 64 + 63 <= t0 && kt * 64 > t0 + 31 - 512, 0.f, 0.f, true);
                if (kt == khi) {
#pragma unroll
                    for (int qt = 0; qt < 2; ++qt) {
                        const float inv = 1.f / attn_ltot(l[qt][0]);
#pragma unroll
                        for (int dt = 0; dt < 4; ++dt) ow[qt][dt] = o[qt][dt] * inv;
                    }
                    attn_init<2>(m, l, o); m[0] = m[1] = mS;
                }
            } else {
                const int n = tagA - 256;
                const unsigned w0 = n < 32 ? msk[0][0] : (n < 64 ? msk[0][1] : (n < 96 ? msk[0][2] : msk[0][3]));
                const unsigned w1 = n < 32 ? msk[1][0] : (n < 64 ? msk[1][1] : (n < 96 ? msk[1][2] : msk[1][3]));
                const bool bit0 = (w0 >> (n & 31)) & 1u, bit1 = (w1 >> (n & 31)) & 1u;
                attn_tile64<2>(sK, sV, qf, m, l, o, lane, [&](int qt, int T, f32x4& s) {
                    const int qpos = t0 + 16 * qt + c, k0 = n * 64 + 16 * T + 4 * g;
                    const float lb = (qt == 0 ? bit0 : bit1) ? 0.f : -INFINITY;
#pragma unroll
                    for (int r = 0; r < 4; ++r) s[r] = (k0 + r <= qpos) ? s[r] * SC2 + lb : -INFINITY;
                }, n * 64 + 63 <= t0, bit0 ? 0.f : -INFINITY, bit1 ? 0.f : -INFINITY, true);
            }
            if (tagB < 0) break;
            tagA = tagB; tagB = tagC; cur ^= 1;
        }
#pragma unroll
        for (int qt = 0; qt < 2; ++qt) {
            const float lt = attn_ltot(l[qt][0]); const float inv = lt > 0.f ? 1.f / lt : 0.f;
            const size_t tok = (size_t)b * SEQ + t0 + 16 * qt + c;
            const float g0 = sigmoidf_(FS[tok * 16 + 4 + h * 3 + 0]), g1 = sigmoidf_(FS[tok * 16 + 4 + h * 3 + 1]), g2 = sigmoidf_(FS[tok * 16 + 4 + h * 3 + 2]);
            u32x2 o4[4];
#pragma unroll
            for (int dt = 0; dt < 4; ++dt) {
                const u32x2 oc = *(const u32x2*)(OC + tok * 256 + h * 64 + 16 * dt + 4 * g);
                const float r0 = g0 * bflo(oc[0]) + g1 * o[qt][dt][0] * inv + g2 * ow[qt][dt][0];
                const float r1 = g0 * bfhi(oc[0]) + g1 * o[qt][dt][1] * inv + g2 * ow[qt][dt][1];
                const float r2 = g0 * bflo(oc[1]) + g1 * o[qt][dt][2] * inv + g2 * ow[qt][dt][2];
                const float r3 = g0 * bfhi(oc[1]) + g1 * o[qt][dt][3] * inv + g2 * ow[qt][dt][3];
                o4[dt] = (u32x2){pk2(r0, r1), pk2(r2, r3)};
            }
            store_row4(O + tok * OW + O_NSA + h * 64, o4, g);
        }
    }
}

DEVI void item_signal(unsigned* flag) {
    asm volatile("s_waitcnt vmcnt(0)" ::: "memory");
    block_sync();
    if (threadIdx.x == 0) {
        __builtin_amdgcn_fence(__ATOMIC_RELEASE, "agent");
        asm volatile("s_waitcnt vmcnt(0)" ::: "memory");
        __hip_atomic_fetch_add(flag, 1u, __ATOMIC_RELAXED, __HIP_MEMORY_SCOPE_AGENT);
    }
}
DEVI void item_wait(unsigned* flag, unsigned need) {
    if (threadIdx.x == 0) {
        unsigned sp = 0;
        while (__hip_atomic_load(flag, __ATOMIC_RELAXED, __HIP_MEMORY_SCOPE_AGENT) < need && sp < (1u << 24)) { __builtin_amdgcn_s_sleep(4); ++sp; }
        __builtin_amdgcn_fence(__ATOMIC_ACQUIRE, "agent");
        asm volatile("s_waitcnt vmcnt(0)" ::: "memory");
    }
    block_sync();
}
DEVI void ph_branches(const Params& p, int layer, char* smem, int bid, int nblk, unsigned* qctr) {
    volatile LAS int* sItem = (volatile LAS int*)(smem + SMEM_BYTES - 4);
    unsigned* FL = (unsigned*)(p.ws + OFF_FLAGS) + layer * 1024;
    for (;;) {
        block_sync();
        if (threadIdx.x == 0) *sItem = (int)__hip_atomic_fetch_add(qctr, 1u, __ATOMIC_RELAXED, __HIP_MEMORY_SCOPE_AGENT);
        block_sync();
        int it = *sItem;
        if (it < 64) { ph_cmp(p, layer, smem, it, 64); item_signal(FL + ((it & 31) >> 3)); continue; }
        it -= 64;
        if (it < 16) { ph_foxcum(p, layer, smem, it, 16); item_signal(FL + 600 + it); continue; }
        it -= 16;
        if (it < 512) { ph_lru<0>(p, layer, smem, it, 512); item_signal(FL + 4 + (it >> 7)); continue; }
        it -= 512;
        if (it < 512) { dil_item(p, layer, smem, it); continue; }
        it -= 512;
        if (it < 512) { item_wait(FL + 4 + (it >> 7), 128u); ph_lru<1>(p, layer, smem, it, 512); continue; }
        it -= 512;
        if (it < 512) {
            const int lvl = it >> 3, jj = it & 7, b = jj >> 1, blk = b * 128 + (63 - lvl) * 2 + (jj & 1);
            item_wait(FL + 0, 16u); item_wait(FL + 1, 16u); item_wait(FL + 2, 16u); item_wait(FL + 3, 16u);
            nsa_item(p, layer, smem, blk, 0);
            item_signal(FL + 8 + blk);
            continue;
        }
        it -= 512;
        if (it < 1024) { item_wait(FL + 600 + (it & 15), 1u); fox_item(p, layer, smem, 63 - (it >> 4), it & 15); continue; }
        it -= 1024;
        if (it < 1024) {
            const int lvl = it >> 4, jj = it & 15, b = jj >> 2, blk = b * 128 + (63 - lvl) * 2 + ((jj >> 1) & 1);
            item_wait(FL + 8 + blk, 1u);
            nsa_item(p, layer, smem, blk, 1 + (jj & 1));
            continue;
        }
        break;
    }
}

DEVI void ph_merge(const Params& p, int layer, char* smem, int bid, int nblk) {
    const char* A8 = p.ws + OFF_H1Q; const float* AS = (const float*)(p.ws + OFF_H1S); const u16* O = (const u16*)(p.ws + OFF_O);
    const char* Wg8 = p.ws + OFF_WI8 + ((size_t)layer * WIN_ROWS + WIN_GATE0) * 1024; const float* SWg = (const float*)(p.ws + OFF_SWI) + (size_t)layer * WIN_ROWS + WIN_GATE0;
    const u16* Wbr = (const u16*)(p.ws + OFF_WBR) + (size_t)layer * 1024 * OW;
    u16* MG = (u16*)(p.ws + OFF_MERGED);
    const int tid_ = tid_opaque(), lane = tid_ & 63, w = tid_ >> 6, wm = w >> 1, wn = w & 1, g = lane >> 4, c = lane & 15;
    const TileMap tmp = tile_map(smem, bid, nblk, NTOK / 128, 8);
    const int ntl = tmp.j0 < tmp.jend ? (tmp.jend - 1 - tmp.j0) / tmp.jstep + 1 : 0;
    u32x2 mg[4][4];
    u32x2 sg[4][4];
#pragma unroll
    for (int i = 0; i < 4; ++i)
#pragma unroll
        for (int j = 0; j < 4; ++j) { sg[i][j] = (u32x2){0u, 0u}; mg[i][j] = (u32x2){0u, 0u}; }
    gemm_stream<128, 128, false>(smem, 0, 1, ntl * 8,
        [&](int j) {
            int tm_, tn_; tile_decode(tmp, tmp.j0 + (j >> 3) * tmp.jstep, tm_, tn_);
            const int job = j & 7, br = job >> 1; const bool isy = job & 1;
            const int kb = br == 2 ? 128 : 256, oc = br == 0 ? O_FOX : (br == 1 ? O_LRU : (br == 2 ? O_DIL : O_NSA));
            GJob jb;
            jb.A = isy ? (const char*)(O + oc) : A8; jb.lda = isy ? (size_t)OW * 2 : (size_t)128; jb.aks = isy ? (size_t)128 : (size_t)NTOK * 128;
            jb.Bt = isy ? (const char*)(Wbr + oc) : Wg8 + (size_t)br * 1024 * 1024; jb.ldb = isy ? (size_t)OW * 2 : (size_t)1024;
            jb.nk = isy ? kb / 64 : 8; jb.m0 = tm_ * 128; jb.n0 = tn_ * 128; jb.i8 = !isy;
            return jb;
        },
        [&](int j, f32x4 (&acc)[4][4]) {
            int tm_, tn_; tile_decode(tmp, tmp.j0 + (j >> 3) * tmp.jstep, tm_, tn_);
            const int job = j & 7; const bool isy = job & 1;
            if (!isy) {
#pragma unroll
                for (int mt = 0; mt < 4; ++mt) {
                    const float sa = AS[tm_ * 128 + wm * 64 + 16 * mt + c];
#pragma unroll
                    for (int nt = 0; nt < 4; ++nt) {
                        const i32x4 ai = __builtin_bit_cast(i32x4, acc[mt][nt]);
                        acc[mt][nt] = (f32x4){(float)ai[0] * sa, (float)ai[1] * sa, (float)ai[2] * sa, (float)ai[3] * sa};
                    }
                }
                f32x4 swn = *(const f32x4*)(SWg + (job >> 1) * 1024 + tn_ * 128 + wn * 64 + 4 * g);
#pragma unroll
                for (int nt = 0; nt < 4; ++nt) {
                    const f32x4 sw = swn;
                    if (nt < 3) swn = *(const f32x4*)(SWg + (job >> 1) * 1024 + tn_ * 128 + wn * 64 + 16 * (nt + 1) + 4 * g);
#pragma unroll
                    for (int mt = 0; mt < 4; ++mt)
                        sg[mt][nt] = (u32x2){pk2(sigmoidf_(acc[mt][nt][0] * sw[0]), sigmoidf_(acc[mt][nt][1] * sw[1])), pk2(sigmoidf_(acc[mt][nt][2] * sw[2]), sigmoidf_(acc[mt][nt][3] * sw[3]))};
                    __builtin_amdgcn_sched_barrier(0);
                }
            } else {
#pragma unroll
                for (int nt = 0; nt < 4; ++nt)
#pragma unroll
                    for (int mt = 0; mt < 4; ++mt)
                        mg[mt][nt] = (u32x2){pk2(bflo(mg[mt][nt][0]) + bflo(sg[mt][nt][0]) * acc[mt][nt][0], bfhi(mg[mt][nt][0]) + bfhi(sg[mt][nt][0]) * acc[mt][nt][1]),
                                             pk2(bflo(mg[mt][nt][1]) + bflo(sg[mt][nt][1]) * acc[mt][nt][2], bfhi(mg[mt][nt][1]) + bfhi(sg[mt][nt][1]) * acc[mt][nt][3])};
            }
            if (job == 7) {
                const int m0 = tm_ * 128, n0 = tn_ * 128;
#pragma unroll
                for (int mt = 0; mt < 4; ++mt)
#pragma unroll
                    for (int nt = 0; nt < 4; ++nt) {
                        const int m = m0 + wm * 64 + 16 * mt + c, n = n0 + wn * 64 + 16 * nt + 4 * g;
                        *(u32x2*)(MG + (size_t)m * 1024 + n) = mg[mt][nt];
                        mg[mt][nt] = (u32x2){0u, 0u};
                    }
            }
        });
}
DEVI void ph_wout(const Params& p, int layer, char* smem, int bid, int nblk) {
    const u16* MG = (const u16*)(p.ws + OFF_MERGED);
    const u16* Wt = (const u16*)(p.ws + OFF_WOUT) + (size_t)layer * 1024 * 1024;
    u16* XR = XR_OF(p);
    const int tid_ = tid_opaque(), lane = tid_ & 63, w = tid_ >> 6, wm = w >> 1, wn = w & 1, g = lane >> 4, c = lane & 15;
    const TileMap tmp = tile_map(smem, bid, nblk, NTOK / 128, 8);
    gemm_stream<128, 128, true>(smem, tmp.j0, tmp.jstep, tmp.jend,
        [&](int t) { int tm_, tn_; tile_decode(tmp, t, tm_, tn_); GJob jb; jb.A = (const char*)MG; jb.lda = 2048; jb.aks = 128; jb.Bt = (const char*)Wt; jb.ldb = 2048; jb.nk = 16; jb.m0 = tm_ * 128; jb.n0 = tn_ * 128; jb.i8 = false; return jb; },
        [&](int t, f32x4 (&acc)[4][4]) {
            int tm_, tn_; tile_decode(tmp, t, tm_, tn_);
            const int m0 = tm_ * 128, n0 = tn_ * 128;
#pragma unroll
            for (int mt = 0; mt < 4; ++mt) {
                u32x2 o4[4];
#pragma unroll
                for (int nt = 0; nt < 4; ++nt) {
                    const int m = m0 + wm * 64 + 16 * mt + c, n = n0 + wn * 64 + 16 * nt + 4 * g;
                    f32x4 xv;
                    if (layer == 0) xv = *(const f32x4*)(p.x + (size_t)m * DM + n);
                    else { const u32x2 xb = *(const u32x2*)(XR + (size_t)m * DM + n); xv = (f32x4){bflo(xb[0]), bfhi(xb[0]), bflo(xb[1]), bfhi(xb[1])}; }
                    xv = xv + acc[mt][nt];
                    o4[nt] = (u32x2){pk2(xv[0], xv[1]), pk2(xv[2], xv[3])};
                }
                store_row4(XR + (size_t)(m0 + wm * 64 + 16 * mt + c) * DM + n0 + wn * 64, o4, g);
            }
        });
}
DEVI void ph_peerq(const Params& p, int layer, char* smem, int bid, int nblk) {
    const char* A8 = p.ws + OFF_HQ; const float* AS = (const float*)(p.ws + OFF_HS);
    const char* W8 = p.ws + OFF_WQ8 + (size_t)layer * 2048 * 1024; const float* SW = (const float*)(p.ws + OFF_SWQ) + (size_t)layer * 2048;
    u16* QP = (u16*)(p.ws + OFF_QP);
    const int tid_ = tid_opaque(), lane = tid_ & 63, w = tid_ >> 6, wm = w >> 1, wn = w & 1, g = lane >> 4, c = lane & 15;
    const TileMap tmp = tile_map(smem, bid, nblk, NTOK / 128, 16);
    gemm_stream<128, 128, true>(smem, tmp.j0, tmp.jstep, tmp.jend,
        [&](int t) { int tm_, tn_; tile_decode(tmp, t, tm_, tn_); GJob jb; jb.A = A8; jb.lda = 128; jb.aks = (size_t)NTOK * 128; jb.Bt = W8; jb.ldb = 1024; jb.nk = 8; jb.m0 = tm_ * 128; jb.n0 = tn_ * 128; jb.i8 = true; return jb; },
        [&](int t, f32x4 (&acc)[4][4]) {
            int tm_, tn_; tile_decode(tmp, t, tm_, tn_);
            const int m0 = tm_ * 128, n0 = tn_ * 128;
            float sa4[4]; f32x4 sw4[4];
#pragma unroll
            for (int i = 0; i < 4; ++i) { sa4[i] = AS[m0 + wm * 64 + 16 * i + c]; sw4[i] = *(const f32x4*)(SW + n0 + wn * 64 + 16 * i + 4 * g); }
#pragma unroll
            for (int mt = 0; mt < 4; ++mt) {
                const int m = m0 + wm * 64 + 16 * mt + c;
                const float sa = sa4[mt];
                u32x2 o4[4];
#pragma unroll
                for (int nt = 0; nt < 4; ++nt) {
                    const f32x4 sw = sw4[nt];
                    const i32x4 ai = __builtin_bit_cast(i32x4, acc[mt][nt]);
                    o4[nt] = (u32x2){pk2((float)ai[0] * sa * sw[0], (float)ai[1] * sa * sw[1]), pk2((float)ai[2] * sa * sw[2], (float)ai[3] * sa * sw[3])};
                }
                store_row4(QP + (size_t)m * 2048 + n0 + wn * 64, o4, g);
            }
        });
}
template <int N> DEVI void bitonic_sort_desc(unsigned (&k)[N]) {
#pragma unroll
    for (int sz = 2; sz <= N; sz <<= 1)
#pragma unroll
        for (int st = sz >> 1; st > 0; st >>= 1)
#pragma unroll
            for (int i = 0; i < N; ++i) {
                const int j = i ^ st;
                if (j > i) {
                    const bool desc = (i & sz) == 0;
                    const unsigned a = k[i], b = k[j], hi = a > b ? a : b, lo = a > b ? b : a;
                    k[i] = desc ? hi : lo; k[j] = desc ? lo : hi;
                }
            }
}
template <int N> DEVI void bitonic_merge_desc(unsigned (&k)[N]) {
#pragma unroll
    for (int st = N >> 1; st > 0; st >>= 1)
#pragma unroll
        for (int i = 0; i < N; ++i) {
            const int j = i ^ st;
            if (j > i) { const unsigned a = k[i], b = k[j]; k[i] = a > b ? a : b; k[j] = a > b ? b : a; }
        }
}
struct Net16 { unsigned char a[60], b[60]; };
constexpr Net16 kNet16 = {
    {0, 1, 2, 3, 4, 5, 7, 9,   0, 1, 2, 3, 6, 8, 10, 11,   0, 2, 4, 6, 7, 10, 12, 14,   0, 1, 4, 5, 6, 8, 12, 13,   1, 3, 4, 5, 8, 9, 13,   1, 2, 5, 7, 9, 11,   2, 3, 9, 11,   3, 6, 7, 10,   3, 5, 7, 9, 11,   6, 8},
    {13, 12, 15, 14, 8, 6, 11, 10,   5, 7, 9, 4, 13, 14, 15, 12,   1, 3, 5, 8, 9, 11, 13, 15,   2, 3, 10, 11, 7, 9, 14, 15,   2, 12, 6, 7, 10, 11, 14,   4, 6, 8, 10, 13, 14,   4, 6, 12, 13,   5, 8, 9, 12,   4, 6, 8, 10, 12,   7, 9}};
template <int OFF, int N> DEVI void sort16_net(unsigned (&k)[N]) {
#pragma unroll
    for (int i = 0; i < 60; ++i) {
        const unsigned x = k[OFF + kNet16.a[i]], y = k[OFF + kNet16.b[i]];
        k[OFF + kNet16.a[i]] = x > y ? x : y; k[OFF + kNet16.b[i]] = x > y ? y : x;
    }
}
DEVI void merge_top16_xor(unsigned (&k)[16], int x) {
    unsigned t[16];
#pragma unroll
    for (int i = 0; i < 16; ++i) { const unsigned o = (unsigned)__shfl_xor((int)k[15 - i], x); t[i] = k[i] > o ? k[i] : o; }
    bitonic_merge_desc<16>(t);
#pragma unroll
    for (int i = 0; i < 16; ++i) k[i] = t[i];
}
DEVI unsigned f2ord(float f) { unsigned u = __float_as_uint(f); return u ^ ((u >> 31) ? 0xffffffffu : 0x80000000u); }
DEVI float ord2f(unsigned u) { return __uint_as_float(u ^ ((u >> 31) ? 0x80000000u : 0xffffffffu)); }

struct PairTab { unsigned char i[64], j[64]; };
__host__ __device__ constexpr PairTab make_pairs() {
    PairTab t{};
    int n = 0;
    for (int i = 0; i < 16; ++i) for (int j = 0; j < 16; ++j) if ((i + 1) * (j + 1) <= 16) { t.i[n] = (unsigned char)i; t.j[n] = (unsigned char)j; ++n; }
    for (; n < 64; ++n) { t.i[n] = 255; t.j[n] = 255; }
    return t;
}
constexpr PairTab kPairs = make_pairs();

DEVI void ph_peertop(const Params& p, int layer, char* smem, int bid, int nblk) {
    char* sSK = smem;
    unsigned char (*sIdx)[16][2][16] = (unsigned char (*)[16][2][16])(smem + 65536);
    const u16* QP = (const u16*)(p.ws + OFF_QP);
    const u16* SK = (const u16*)(p.ws + OFF_SUBK) + (size_t)layer * 2 * 128 * 128;
    u16* PIDX = (u16*)(p.ws + OFF_PIDX); float* PGW = (float*)(p.ws + OFF_PGW);
    const int tid = tid_opaque(), lane = tid & 63, w = tid >> 6, g = lane >> 4, c = lane & 15;
    block_sync();
    for (int i = tid; i < 4096; i += 256) { const int r = i >> 4, ch = i & 15; *(u32x4*)(sSK + r * 256 + ((ch ^ (r & 15)) << 4)) = *(const u32x4*)(SK + (size_t)r * 128 + ch * 8); }
    block_sync();
    for (int item = bid * 4 + w; item < (NTOK / 16) * 8; item += nblk * 4) {
        const int hd = item & 7, t0 = (item >> 3) * 16;
        const size_t tok = (size_t)t0 + c;
        unsigned top[2][16];
#pragma unroll
        for (int pp = 0; pp < 2; ++pp) {
            s16x8 qf[4];
#pragma unroll
            for (int ks = 0; ks < 4; ++ks) qf[ks] = *(const s16x8*)(QP + tok * 2048 + hd * 256 + pp * 128 + 32 * ks + 8 * g);
            unsigned key[32];
#pragma unroll
            for (int T = 0; T < 8; ++T) {
                f32x4 z = {0.f, 0.f, 0.f, 0.f};
#pragma unroll
                for (int ks = 0; ks < 4; ++ks) {
                    const int rw = pp * 128 + 16 * T + c; const s16x8 kf = *(const s16x8*)(sSK + rw * 256 + (((4 * ks + g) ^ (rw & 15)) << 4));
                    z = mfma16(kf, qf[ks], z);
                }
#pragma unroll
                for (int r = 0; r < 4; ++r) { const int n = 16 * T + 4 * g + r; key[4 * T + r] = (f2ord(z[r]) & ~127u) | (unsigned)(127 - n); }
            }
            sort16_net<0>(key); sort16_net<16>(key);
#pragma unroll
            for (int i = 0; i < 16; ++i) top[pp][i] = key[i] > key[31 - i] ? key[i] : key[31 - i];
            bitonic_merge_desc<16>(top[pp]);
            merge_top16_xor(top[pp], 16);
            merge_top16_xor(top[pp], 32);
#pragma unroll
            for (int i = 0; i < 16; ++i) if ((i >> 2) == g) sIdx[w][c][pp][i] = (unsigned char)(127 - (top[pp][i] & 127u));
        }
        float v0[16], v1[16];
#pragma unroll
        for (int i = 0; i < 16; ++i) { v0[i] = ord2f(top[0][i] & ~127u); v1[i] = ord2f(top[1][i] & ~127u); }
        unsigned ck[16];
#pragma unroll
        for (int e = 0; e < 16; ++e) {
            float a4[4], b4[4]; unsigned f4[4];
#pragma unroll
            for (int gg = 0; gg < 4; ++gg) {
                const int pi = kPairs.i[gg * 16 + e], pj = kPairs.j[gg * 16 + e];
                a4[gg] = v0[pi < 16 ? pi : 0]; b4[gg] = v1[pj < 16 ? pj : 0];
                f4[gg] = pi < 16 ? (unsigned)(255 - (pi * 16 + pj)) : 0x100u;
            }
            const float av = g < 2 ? (g == 0 ? a4[0] : a4[1]) : (g == 2 ? a4[2] : a4[3]);
            const float bv = g < 2 ? (g == 0 ? b4[0] : b4[1]) : (g == 2 ? b4[2] : b4[3]);
            const unsigned fv = g < 2 ? (g == 0 ? f4[0] : f4[1]) : (g == 2 ? f4[2] : f4[3]);
            ck[e] = fv < 0x100u ? ((f2ord(av + bv) & ~255u) | fv) : 0u;
        }
        sort16_net<0>(ck);
        merge_top16_xor(ck, 16);
        merge_top16_xor(ck, 32);
        const float smax = ord2f(ck[0] & ~255u);
        float ex[16], den = 0.f;
#pragma unroll
        for (int i = 0; i < 16; ++i) { ex[i] = __expf(ord2f(ck[i] & ~255u) - smax); den += ex[i]; }
        const float rden = 1.f / den;
        int eidx[4]; float egw[4];
#pragma unroll
        for (int r = 0; r < 4; ++r) {
            const unsigned kq = g == 0 ? ck[r] : (g == 1 ? ck[4 + r] : (g == 2 ? ck[8 + r] : ck[12 + r]));
            const float eq = g == 0 ? ex[r] : (g == 1 ? ex[4 + r] : (g == 2 ? ex[8 + r] : ex[12 + r]));
            const int flat = 255 - (int)(kq & 255u), pi = flat >> 4, pj = flat & 15;
            eidx[r] = (int)sIdx[w][c][0][pi] * 128 + (int)sIdx[w][c][1][pj];
            egw[r] = eq * rden;
        }
        *(u32x2*)(PIDX + tok * 128 + hd * 16 + 4 * g) = (u32x2){(unsigned)eidx[0] | ((unsigned)eidx[1] << 16), (unsigned)eidx[2] | ((unsigned)eidx[3] << 16)};
        *(f32x4*)(PGW + tok * 128 + hd * 16 + 4 * g) = (f32x4){egw[0], egw[1], egw[2], egw[3]};
    }
}

struct G1Buf { u32x4 ra[8], rb[8]; i32x4 b0, b1; };
DEVI void g1_load(G1Buf& q, const unsigned char* UQ, const unsigned char* HQs, const u16* PIDX, int tok, int lane) {
    const int rr = lane >> 3, pc = lane & 7, g = lane >> 4;
#pragma unroll
    for (int hd = 0; hd < 8; ++hd) {
        const unsigned ew = *(const unsigned*)(PIDX + (size_t)tok * 128 + hd * 16 + 2 * rr);
        const int ea = (int)(ew & 0xffffu), eb = (int)(ew >> 16);
        q.ra[hd] = *(const u32x4*)(UQ + (size_t)ea * 128 + 16 * pc);
        q.rb[hd] = *(const u32x4*)(UQ + (size_t)eb * 128 + 16 * pc);
    }
    const unsigned char* hq = HQs + (size_t)tok * 128 + 32 * g;
    q.b0 = *(const i32x4*)(hq); q.b1 = *(const i32x4*)(hq + 16);
}
DEVI void g1_math(const G1Buf& q, char* sT, u16* part, int lane) {
    const int rr = lane >> 3, pc = lane & 7, g = lane >> 4, c = lane & 15;
#pragma unroll
    for (int hd = 0; hd < 8; ++hd) {
        *(u32x4*)(sT + (2 * rr) * 144 + pc * 16) = q.ra[hd];
        *(u32x4*)(sT + (2 * rr + 1) * 144 + pc * 16) = q.rb[hd];
        const i32x4 a0 = *(const i32x4*)(sT + c * 144 + 32 * g), a1 = *(const i32x4*)(sT + c * 144 + 32 * g + 16);
        i32x4 z = {0, 0, 0, 0};
        z = __builtin_amdgcn_mfma_i32_16x16x64_i8(a0, q.b0, z, 0, 0, 0);
        z = __builtin_amdgcn_mfma_i32_16x16x64_i8(a1, q.b1, z, 0, 0, 0);
        if (c == 0) *(u32x2*)(part + hd * 16 + 4 * g) = (u32x2){pk2((float)z[0], (float)z[1]), pk2((float)z[2], (float)z[3])};
    }
}
DEVI void ph_pg1(const Params& p, int layer, char* smem, int bid, int nblk) {
    const int tid = tid_opaque(), lane = tid & 63, w = tid >> 6;
    const XccInfo xi = xcc_info(smem, bid, nblk);
    char* sT = smem + w * 2304;
    const u16* PIDX = (const u16*)(p.ws + OFF_PIDX); u16* PART = (u16*)(p.ws + OFF_PART);
    const int step = xi.tstep * 4;
    for (int sl = xi.s0; sl < 8; sl += xi.sstep) {
        const unsigned char* UQ = (const unsigned char*)(p.ws + OFF_PUV) + ((size_t)(layer * 2) * 8 + sl) * NEXP * 128;
        const unsigned char* HQs = (const unsigned char*)(p.ws + OFF_HQ) + (size_t)sl * NTOK * 128;
        u16* parts = PART + (size_t)sl * NTOK * 128;
        int tok = xi.t0 * 4 + w;
        if (tok >= NTOK) continue;
        G1Buf qa, qb;
        g1_load(qa, UQ, HQs, PIDX, tok, lane);
        for (;;) {
            const bool v1 = tok + step < NTOK;
            if (v1) g1_load(qb, UQ, HQs, PIDX, tok + step, lane);
            g1_math(qa, sT, parts + (size_t)tok * 128, lane);
            if (!v1) break;
            const bool v2 = tok + 2 * step < NTOK;
            if (v2) g1_load(qa, UQ, HQs, PIDX, tok + 2 * step, lane);
            g1_math(qb, sT, parts + (size_t)(tok + step) * 128, lane);
            if (!v2) break;
            tok += 2 * step;
        }
    }
}
DEVI void ph_pg2(const Params& p, int layer, int bid, int nblk) {
    const u16* PIDX = (const u16*)(p.ws + OFF_PIDX); const float* PGW = (const float*)(p.ws + OFF_PGW); const u16* PART = (const u16*)(p.ws + OFF_PART);
    const float* SU = (const float*)(p.ws + OFF_PSC) + (size_t)(layer * 2) * NEXP; const float* SV = SU + NEXP;
    const float* HS = (const float*)(p.ws + OFF_HS); signed char* PWQ = (signed char*)(p.ws + OFF_PW); float* PWS = (float*)(p.ws + OFF_PWS);
    const int lane = tid_opaque() & 63;
    const int stride = nblk * 4;
    for (int tok0 = bid * 4 + (tid_opaque() >> 6); tok0 < NTOK; tok0 += stride * 4) {
        float wv[4][2], am[4];
        unsigned pw[4][8]; int e0[4], e1[4]; float g0[4], g1[4], hs[4];
#pragma unroll
        for (int r = 0; r < 4; ++r) {
            const int tok = tok0 + r * stride < NTOK ? tok0 + r * stride : tok0;
            const size_t i = (size_t)tok * 128 + 2 * lane;
#pragma unroll
            for (int sl = 0; sl < 8; ++sl) pw[r][sl] = *(const unsigned*)(PART + (size_t)sl * NTOK * 128 + i);
            { const unsigned ew = *(const unsigned*)(PIDX + i); e0[r] = (int)(ew & 0xffffu); e1[r] = (int)(ew >> 16); }
            g0[r] = PGW[i]; g1[r] = PGW[i + 1]; hs[r] = HS[tok];
        }
#pragma unroll
        for (int r = 0; r < 4; ++r) {
            float z0 = 0.f, z1 = 0.f;
#pragma unroll
            for (int sl = 0; sl < 8; ++sl) { z0 += bflo(pw[r][sl]); z1 += bfhi(pw[r][sl]); }
            wv[r][0] = g0[r] * gelu_tanh(z0 * SU[e0[r]] * hs[r]) * SV[e0[r]];
            wv[r][1] = g1[r] * gelu_tanh(z1 * SU[e1[r]] * hs[r]) * SV[e1[r]];
            am[r] = fmaxf(fabsf(wv[r][0]), fabsf(wv[r][1]));
        }
#pragma unroll
        for (int o = 32; o > 0; o >>= 1)
#pragma unroll
            for (int r = 0; r < 4; ++r) am[r] = fmaxf(am[r], __shfl_xor(am[r], o));
#pragma unroll
        for (int r = 0; r < 4; ++r) {
            const int tok = tok0 + r * stride;
            if (tok < NTOK) {
                const float inv = am[r] > 0.f ? 127.f / am[r] : 0.f;
                *(u16*)(PWQ + (size_t)tok * 128 + 2 * lane) = (u16)(((unsigned)(int)rintf(wv[r][0] * inv) & 0xffu) | (((unsigned)(int)rintf(wv[r][1] * inv) & 0xffu) << 8));
                if (lane == 0) PWS[tok] = am[r] * (1.f / 127.f);
            }
        }
    }
}
struct G3Buf { u32x4 vb[16]; i32x4 bop; };
DEVI void g3_load(G3Buf& q, const unsigned char* VQ, const u16* PIDX, const signed char* PWQ, int tok, int lane) {
    const int r = lane >> 3, i8 = lane & 7;
    u32x4 ei[2];
#pragma unroll
    for (int k = 0; k < 2; ++k) ei[k] = *(const u32x4*)(PIDX + (size_t)tok * 128 + 16 * r + 8 * k);
#pragma unroll
    for (int k = 0; k < 16; ++k) { const unsigned e = (ei[k >> 3][(k >> 1) & 3] >> (16 * (k & 1))) & 0xffffu; q.vb[k] = *(const u32x4*)(VQ + (size_t)e * 128 + 16 * i8); }
    const int cB = lane & 15, gB = lane >> 4;
    q.bop = (i32x4){0, 0, 0, 0};
    if (cB < 2) q.bop = *(const i32x4*)(PWQ + (size_t)tok * 128 + 32 * gB + 16 * cB);
}
DEVI void g3_math(const G3Buf& q, u16* xrow, float wscale, char* sOut, int lane) {
    int* so = (int*)sOut;
    const int gD = lane >> 4, cD = lane & 15;
    const bool wr = (cD == 0 && gD < 2) || (cD == 1 && gD >= 2);
    const int par = cD, i80 = 4 * (gD & 1);
#pragma unroll
    for (int qq = 0; qq < 4; ++qq) {
        i32x4 T[4];
#pragma unroll
        for (int kb = 0; kb < 4; ++kb) {
            const unsigned in0 = q.vb[4 * kb + 0][qq], in1 = q.vb[4 * kb + 1][qq], in2 = q.vb[4 * kb + 2][qq], in3 = q.vb[4 * kb + 3][qq];
            const unsigned t0 = __builtin_amdgcn_perm(in1, in0, 0x05010400u), t1 = __builtin_amdgcn_perm(in1, in0, 0x07030602u);
            const unsigned t2 = __builtin_amdgcn_perm(in3, in2, 0x05010400u), t3 = __builtin_amdgcn_perm(in3, in2, 0x07030602u);
            T[0][kb] = (int)__builtin_amdgcn_perm(t2, t0, 0x05040100u); T[1][kb] = (int)__builtin_amdgcn_perm(t2, t0, 0x07060302u);
            T[2][kb] = (int)__builtin_amdgcn_perm(t3, t1, 0x05040100u); T[3][kb] = (int)__builtin_amdgcn_perm(t3, t1, 0x07060302u);
        }
#pragma unroll
        for (int j = 0; j < 4; ++j) {
            i32x4 d = {0, 0, 0, 0};
            d = __builtin_amdgcn_mfma_i32_16x16x64_i8(T[j], q.bop, d, 0, 0, 0);
            if (wr) *(i32x4*)(so + par * 128 + (4 * qq + j) * 8 + i80) = d;
        }
    }
    if (lane < 32) {
        i32x4 a, b2;
#pragma unroll
        for (int e = 0; e < 4; ++e) { a[e] = so[(4 * (lane & 3) + e) * 8 + (lane >> 2)]; b2[e] = so[128 + (4 * (lane & 3) + e) * 8 + (lane >> 2)]; }
        const u32x2 xb = *(const u32x2*)(xrow + 4 * lane);
        const float v0 = bflo(xb[0]) + (float)(a[0] + b2[0]) * wscale, v1 = bfhi(xb[0]) + (float)(a[1] + b2[1]) * wscale;
        const float v2 = bflo(xb[1]) + (float)(a[2] + b2[2]) * wscale, v3 = bfhi(xb[1]) + (float)(a[3] + b2[3]) * wscale;
        *(u32x2*)(xrow + 4 * lane) = (u32x2){pk2(v0, v1), pk2(v2, v3)};
    }
}
DEVI void ph_pg3(const Params& p, int layer, char* smem, int bid, int nblk) {
    const int tid = tid_opaque(), lane = tid & 63, w = tid >> 6;
    const XccInfo xi = xcc_info(smem, bid, nblk);
    const u16* PIDX = (const u16*)(p.ws + OFF_PIDX); const signed char* PWQ = (const signed char*)(p.ws + OFF_PW); const float* PWS = (const float*)(p.ws + OFF_PWS);
    char* sOut = smem + w * 1024;
    const int step = xi.tstep * 4;
    for (int sl = xi.s0; sl < 8; sl += xi.sstep) {
        const unsigned char* VQ = (const unsigned char*)(p.ws + OFF_PUV) + ((size_t)(layer * 2 + 1) * 8 + sl) * NEXP * 128;
        u16* xs = XR_OF(p) + sl * 128;
        int tok = xi.t0 * 4 + w;
        if (tok >= NTOK) continue;
        G3Buf qa, qb;
        g3_load(qa, VQ, PIDX, PWQ, tok, lane);
        for (;;) {
            const bool v1 = tok + step < NTOK;
            if (v1) g3_load(qb, VQ, PIDX, PWQ, tok + step, lane);
            g3_math(qa, xs + (size_t)tok * DM, PWS[tok], sOut, lane);
            if (!v1) break;
            const bool v2 = tok + 2 * step < NTOK;
            if (v2) g3_load(qa, VQ, PIDX, PWQ, tok + 2 * step, lane);
            g3_math(qb, xs + (size_t)(tok + step) * DM, PWS[tok + step], sOut, lane);
            if (!v2) break;
            tok += 2 * step;
        }
    }
}

template <int l>
DEVI void layer_body(char* smem, int bid, int nblk, unsigned& epoch) {
        { const Params p = kp_load(kp_get()); char* ws = p.ws; (void)ws; unsigned* ctrl = (unsigned*)(p.ws + OFF_CTRL); (void)ctrl; ph_proj(p, l, smem, bid, nblk); }
        { const Params p = kp_load(kp_get()); grid_bar(p.ws, smem, epoch); }
        { const Params p = kp_load(kp_get()); char* ws = p.ws; (void)ws; unsigned* ctrl = (unsigned*)(p.ws + OFF_CTRL); (void)ctrl; ph_branches(p, l, smem, bid, nblk, ctrl + 8 + l); }
        { const Params p = kp_load(kp_get()); grid_bar(p.ws, smem, epoch); }
        { const Params p = kp_load(kp_get()); char* ws = p.ws; (void)ws; unsigned* ctrl = (unsigned*)(p.ws + OFF_CTRL); (void)ctrl; ph_merge(p, l, smem, bid, nblk); }
        { const Params p = kp_load(kp_get()); grid_bar(p.ws, smem, epoch); }
        { const Params p = kp_load(kp_get()); char* ws = p.ws; (void)ws; unsigned* ctrl = (unsigned*)(p.ws + OFF_CTRL); (void)ctrl; ph_wout(p, l, smem, bid, nblk); }
        { const Params p = kp_load(kp_get()); grid_bar(p.ws, smem, epoch); }
        { const Params p = kp_load(kp_get()); char* ws = p.ws; (void)ws; unsigned* ctrl = (unsigned*)(p.ws + OFF_CTRL); (void)ctrl; ph_rmsq<true>(XR_OF(p), p.norm2_g + l * 1024, (unsigned char*)(ws + OFF_HQ), (float*)(ws + OFF_HS), bid, nblk); }
        { const Params p = kp_load(kp_get()); grid_bar(p.ws, smem, epoch); }
        { const Params p = kp_load(kp_get()); char* ws = p.ws; (void)ws; unsigned* ctrl = (unsigned*)(p.ws + OFF_CTRL); (void)ctrl; ph_peerq(p, l, smem, bid, nblk); }
        { const Params p = kp_load(kp_get()); grid_bar(p.ws, smem, epoch); }
        { const Params p = kp_load(kp_get()); char* ws = p.ws; (void)ws; unsigned* ctrl = (unsigned*)(p.ws + OFF_CTRL); (void)ctrl; ph_peertop(p, l, smem, bid, nblk); }
        { const Params p = kp_load(kp_get()); grid_bar(p.ws, smem, epoch); }
        { const Params p = kp_load(kp_get()); char* ws = p.ws; (void)ws; unsigned* ctrl = (unsigned*)(p.ws + OFF_CTRL); (void)ctrl; ph_pg1(p, l, smem, bid, nblk); }
        { const Params p = kp_load(kp_get()); grid_bar(p.ws, smem, epoch); }
        { const Params p = kp_load(kp_get()); char* ws = p.ws; (void)ws; unsigned* ctrl = (unsigned*)(p.ws + OFF_CTRL); (void)ctrl; ph_pg2(p, l, bid, nblk); }
        { const Params p = kp_load(kp_get()); grid_bar(p.ws, smem, epoch); }
        { const Params p = kp_load(kp_get()); char* ws = p.ws; (void)ws; unsigned* ctrl = (unsigned*)(p.ws + OFF_CTRL); (void)ctrl; ph_pg3(p, l, smem, bid, nblk); }
        { const Params p = kp_load(kp_get()); grid_bar(p.ws, smem, epoch); }
        if (l + 1 < NLAYER) {
            { const Params p = kp_load(kp_get()); char* ws = p.ws; (void)ws; unsigned* ctrl = (unsigned*)(p.ws + OFF_CTRL); (void)ctrl; ph_rmsq<true>(XR_OF(p), p.norm1_g + (l + 1) * 1024, (unsigned char*)(ws + OFF_H1Q), (float*)(ws + OFF_H1S), bid, nblk); }
            { const Params p = kp_load(kp_get()); grid_bar(p.ws, smem, epoch); }
        }
    }

__global__ void __launch_bounds__(256, 2) mega(Params p) {
    extern __shared__ __attribute__((aligned(16))) char smem[];
    cg::grid_group grid = cg::this_grid();
    const int bid = blockIdx.x, nblk = gridDim.x;
    unsigned epoch = 0;
#if PROBE
    { const Params p = kp_load(kp_get()); if (blockIdx.x == 0 && threadIdx.x == 0) ((unsigned long long*)(p.ws + OFF_CTRL + 64))[62] = wall_clock64(); }
#endif
    { const Params p = kp_load(kp_get());
      if (threadIdx.x == 0) { volatile LAS unsigned* st = (volatile LAS unsigned*)(smem + SMEM_BYTES - 16); st[0] = 0u; st[1] = 0u;
        st[2] = xb_add(&((unsigned*)(p.ws + OFF_XBAR))[XB_XCNT(xb_xcc_id())], 1u); } }
    __syncthreads();
    { const Params p = kp_load(kp_get()); char* ws = p.ws; (void)ws; unsigned* ctrl = (unsigned*)(p.ws + OFF_CTRL); (void)ctrl; ph_tconv(p, smem, bid, nblk); }
    { const Params p = kp_load(kp_get()); char* ws = p.ws; (void)ws; unsigned* ctrl = (unsigned*)(p.ws + OFF_CTRL); (void)ctrl; ph_cvt(p.peer_sub_keys, (u16*)(ws + OFF_SUBK), (size_t)NLAYER * 2 * 128 * 128 / 4, bid, nblk); }
    { const Params p = kp_load(kp_get()); char* ws = p.ws; (void)ws; unsigned* ctrl = (unsigned*)(p.ws + OFF_CTRL); (void)ctrl; ph_misc(p, bid, nblk); }
    { const Params p = kp_load(kp_get()); ph_lrufrag(p, (bid + nblk - 64) % nblk, nblk); }
    { const Params p = kp_load(kp_get()); ph_bias1(p, smem, (bid + nblk - 32) % nblk, nblk); }
    { const Params p = kp_load(kp_get()); ph_quant(p, bid, nblk); }
    { const Params p = kp_load(kp_get()); char* ws = p.ws; (void)ws; unsigned* ctrl = (unsigned*)(p.ws + OFF_CTRL); (void)ctrl; ph_rmsq<false>(p.x, p.norm1_g, (unsigned char*)(ws + OFF_H1Q), (float*)(ws + OFF_H1S), bid, nblk); }
    { const Params p = kp_load(kp_get()); unsigned e1 = 101u; grid_bar(p.ws, smem, e1); }
    { const Params p = kp_load(kp_get()); ph_wquant(p, bid, nblk); }
    if (nblk == 0x7fffffff) grid.sync();
    { const Params p = kp_load(kp_get()); unsigned e0 = 100u; grid_bar(p.ws, smem, e0); }
#if PROBE
    { const Params p = kp_load(kp_get()); if (blockIdx.x == 0 && threadIdx.x == 0) ((unsigned long long*)(p.ws + OFF_CTRL + 64))[0] = wall_clock64(); }
#endif
    layer_body<0>(smem, bid, nblk, epoch);
    layer_body<1>(smem, bid, nblk, epoch);
    { const Params p = kp_load(kp_get()); char* ws = p.ws; (void)ws; unsigned* ctrl = (unsigned*)(p.ws + OFF_CTRL); (void)ctrl; ph_final(p, smem, bid, nblk, epoch);
#if PROBE
      { block_sync();
        const unsigned long long* T = (const unsigned long long*)(p.ws + OFF_CTRL + 64);
        if (bid == 0 && threadIdx.x == 0) { const float us = (float)(T[PROBE_A] - T[PROBE_A0]) * 0.01f / PROBE_DIV; p.out[0] += us * (1.f / 50.f); } }
#endif
    }
}

extern "C" void kernel_launch(void* const* d_in, const int* in_sizes, int n_in, void* d_out, int out_size, void* d_ws, size_t ws_size, hipStream_t stream) {
    (void)in_sizes; (void)n_in; (void)out_size;
    if (ws_size < WS_NEED) { fprintf(stderr, "workspace too small: %zu < %zu\n", ws_size, (size_t)WS_NEED); return; }
    Params p{};
    p.x = (const float*)d_in[0]; p.norm1_g = (const float*)d_in[1]; p.w_in = (const float*)d_in[2]; p.fox_b_f = (const float*)d_in[3];
    p.lru_conv_w = (const float*)d_in[4]; p.lru_conv_b = (const float*)d_in[5]; p.lru_w_a = (const float*)d_in[6]; p.lru_b_a = (const float*)d_in[7];
    p.lru_w_x = (const float*)d_in[8]; p.lru_b_x = (const float*)d_in[9]; p.lru_lambda = (const float*)d_in[10];
    p.nsa_pe_k = (const float*)d_in[11]; p.nsa_pe_v = (const float*)d_in[12]; p.nsa_w1_k = (const float*)d_in[13]; p.nsa_w2_k = (const float*)d_in[14];
    p.nsa_w1_v = (const float*)d_in[15]; p.nsa_w2_v = (const float*)d_in[16];
    p.w_br_fox = (const float*)d_in[17]; p.w_br_lru = (const float*)d_in[18]; p.w_br_dil = (const float*)d_in[19]; p.w_br_nsa = (const float*)d_in[20];
    p.w_out = (const float*)d_in[21]; p.norm2_g = (const float*)d_in[22]; p.peer_w_q = (const float*)d_in[23]; p.peer_sub_keys = (const float*)d_in[24];
    p.peer_u = (const float*)d_in[25]; p.peer_v = (const float*)d_in[26]; p.final_g = (const float*)d_in[27];
    p.out = (float*)d_out; p.ws = (char*)d_ws;
    static int grid_blocks = 0;
    if (!grid_blocks) {
        int dev = 0, cus = 0, per_cu = 0;
        hipGetDevice(&dev);
        hipDeviceGetAttribute(&cus, hipDeviceAttributeMultiprocessorCount, dev);
        hipFuncSetAttribute((const void*)mega, hipFuncAttributeMaxDynamicSharedMemorySize, SMEM_BYTES);
        hipOccupancyMaxActiveBlocksPerMultiprocessor(&per_cu, mega, 256, SMEM_BYTES);
        if (per_cu > 2) per_cu = 2;
        if (per_cu < 1) per_cu = 1;
        grid_blocks = cus * per_cu;
    }
    hipMemsetAsync((char*)d_ws + OFF_CTRL, 0, 1024 + 16384 + 8192, stream);
    void* args[] = {&p};
    hipError_t e = hipLaunchCooperativeKernel((void*)mega, dim3(grid_blocks), dim3(256), args, SMEM_BYTES, stream);
    if (e != hipSuccess) fprintf(stderr, "cooperative launch failed: %s (grid %d)\n", hipGetErrorString(e), grid_blocks);
}
```
